# Optimizing an MI355X kernel written in HIP

```python
import math
import jax, jax.numpy as jnp
from jax import lax
import numpy as np

D_MODEL = 1024
BATCH = 4
SEQ = 4096
DEPTH = 4

ATTN_WIDTH = D_MODEL // 2
CONV_CHANNELS = D_MODEL - ATTN_WIDTH
V_HEAD_DIM = 64
N_HEADS = ATTN_WIDTH // V_HEAD_DIM
QK_NOPE_DIM = 64
QK_ROPE_DIM = 32
QK_HEAD_DIM = QK_NOPE_DIM + QK_ROPE_DIM
Q_LORA_RANK = 384
KV_LORA_RANK = 256
CONV_GROUPS = 8
CONV_KERNEL = 3
D_FF = 4 * D_MODEL
PLE_DIM = 256
ROPE_THETA = 10000.0
Q_BLOCK = 128
EPS = 1e-6
IN_SPLITS = (Q_LORA_RANK, KV_LORA_RANK, QK_ROPE_DIM, CONV_CHANNELS, CONV_CHANNELS, CONV_CHANNELS)
IN_WIDTH = sum(IN_SPLITS)

kernel_name = "hybrid_mla_shortconv_sandwich_encoder"


def rms_norm(x, g):
    xf = x.astype(jnp.float32)
    y = xf * lax.rsqrt(jnp.mean(xf * xf, axis=-1, keepdims=True) + EPS)
    return (y * g.astype(jnp.float32)).astype(x.dtype)


def group_rms_norm(x, g, n_groups):
    b, s, w = x.shape
    y = rms_norm(x.reshape(b, s, n_groups, w // n_groups), g.reshape(n_groups, w // n_groups))
    return y.reshape(b, s, w)


def rope_tables(seq):
    inv_freq = 1.0 / (ROPE_THETA ** (jnp.arange(0, QK_ROPE_DIM, 2, dtype=jnp.float32) / QK_ROPE_DIM))
    ang = jnp.arange(seq, dtype=jnp.float32)[:, None] * inv_freq[None, :]
    return jnp.cos(ang), jnp.sin(ang)


def apply_rope(x, cos, sin):
    half = QK_ROPE_DIM // 2
    c = cos.astype(x.dtype)
    s = sin.astype(x.dtype)
    x1, x2 = x[..., :half], x[..., half:]
    return jnp.concatenate([x1 * c - x2 * s, x2 * c + x1 * s], axis=-1)


def latent_attention(q_nope, q_rope, k_nope, k_rope, v):
    b, s, h, _ = q_nope.shape
    nb = s // Q_BLOCK
    qn = q_nope.reshape(b, nb, Q_BLOCK, h, QK_NOPE_DIM).transpose(1, 0, 2, 3, 4)
    qr = q_rope.reshape(b, nb, Q_BLOCK, h, QK_ROPE_DIM).transpose(1, 0, 2, 3, 4)
    scale = 1.0 / math.sqrt(QK_HEAD_DIM)

    def one_block(args):
        qn_b, qr_b = args
        sc = (jnp.einsum('bqhd,bkhd->bhqk', qn_b, k_nope, preferred_element_type=jnp.float32)
              + jnp.einsum('bqhr,bkr->bhqk', qr_b, k_rope, preferred_element_type=jnp.float32))
        w = jax.nn.softmax(sc * scale, axis=-1)
        return jnp.einsum('bhqk,bkhd->bqhd', w.astype(v.dtype), v)

    o = lax.map(one_block, (qn, qr))
    return o.transpose(1, 0, 2, 3, 4).reshape(b, s, h * V_HEAD_DIM)


def short_conv(u, w):
    return lax.conv_general_dilated(
        u, w[:, None, :].astype(u.dtype), window_strides=(1,), padding=((1, 1),),
        dimension_numbers=('NWC', 'WIO', 'NWC'), feature_group_count=u.shape[-1])


def setup_inputs(seed: int = 0) -> dict:
    key = jax.random.key(seed)
    ks = jax.random.split(key, 24)
    f32 = jnp.float32

    def w(k, shape, fan_in):
        return jax.random.normal(k, shape, f32) * (fan_in ** -0.5)

    def gain(k, dim):
        return 1.0 + 0.02 * jax.random.normal(k, (DEPTH, dim), f32)

    return {
        "x": jax.random.normal(ks[0], (BATCH, SEQ, D_MODEL), f32),
        "p": jax.random.normal(ks[1], (DEPTH, BATCH, SEQ, PLE_DIM), f32),
        "g_pre_mix": gain(ks[2], D_MODEL),
        "w_in": w(ks[3], (DEPTH, D_MODEL, IN_WIDTH), D_MODEL),
        "g_q_a": gain(ks[4], Q_LORA_RANK),
        "w_q_b": w(ks[5], (DEPTH, Q_LORA_RANK, N_HEADS * QK_HEAD_DIM), Q_LORA_RANK),
        "g_kv_a": gain(ks[6], KV_LORA_RANK),
        "w_kv_b": w(ks[7], (DEPTH, KV_LORA_RANK, N_HEADS * (QK_NOPE_DIM + V_HEAD_DIM)), KV_LORA_RANK),
        "w_conv": w(ks[8], (DEPTH, CONV_KERNEL, CONV_CHANNELS), CONV_KERNEL),
        "g_attn_out": gain(ks[9], ATTN_WIDTH),
        "g_conv_out": gain(ks[10], CONV_CHANNELS),
        "w_out": w(ks[11], (DEPTH, ATTN_WIDTH + CONV_CHANNELS, D_MODEL), ATTN_WIDTH + CONV_CHANNELS),
        "g_post_mix": gain(ks[12], D_MODEL),
        "g_pre_mlp": gain(ks[13], D_MODEL),
        "w_mlp_up": w(ks[14], (DEPTH, D_MODEL, D_FF), D_MODEL),
        "w_mlp_down": w(ks[15], (DEPTH, D_FF, D_MODEL), D_FF),
        "g_post_mlp": gain(ks[16], D_MODEL),
        "g_pre_ple": gain(ks[17], D_MODEL),
        "w_ple_gate": w(ks[18], (DEPTH, D_MODEL, D_MODEL), D_MODEL),
        "w_ple_proj": w(ks[19], (DEPTH, PLE_DIM, D_MODEL), PLE_DIM),
        "g_post_ple": gain(ks[20], D_MODEL),
    }


def reference(x, p, g_pre_mix, w_in, g_q_a, w_q_b, g_kv_a, w_kv_b, w_conv, g_attn_out,
              g_conv_out, w_out, g_post_mix, g_pre_mlp, w_mlp_up, w_mlp_down, g_post_mlp,
              g_pre_ple, w_ple_gate, w_ple_proj, g_post_ple):
    b, s, _ = x.shape
    cos, sin = rope_tables(s)
    split_at = list(np.cumsum(IN_SPLITS)[:-1])

    for i in range(DEPTH):
        h = rms_norm(x, g_pre_mix[i])
        z = h @ w_in[i]
        z_qa, z_kva, z_kr, gate_b, gate_c, conv_in = jnp.split(z, split_at, axis=-1)

        q = (rms_norm(z_qa, g_q_a[i]) @ w_q_b[i]).reshape(b, s, N_HEADS, QK_HEAD_DIM)
        q_nope = q[..., :QK_NOPE_DIM]
        q_rope = apply_rope(q[..., QK_NOPE_DIM:], cos[:, None, :], sin[:, None, :])
        kv = (rms_norm(z_kva, g_kv_a[i]) @ w_kv_b[i]).reshape(b, s, N_HEADS, QK_NOPE_DIM + V_HEAD_DIM)
        k_nope = kv[..., :QK_NOPE_DIM]
        v = kv[..., QK_NOPE_DIM:]
        k_rope = apply_rope(z_kr, cos, sin)
        attn = latent_attention(q_nope, q_rope, k_nope, k_rope, v)

        conv = gate_b * short_conv(gate_c * conv_in, w_conv[i])

        mix = jnp.concatenate([group_rms_norm(attn, g_attn_out[i], N_HEADS),
                               group_rms_norm(conv, g_conv_out[i], CONV_GROUPS)], axis=-1)
        x = x + rms_norm(mix @ w_out[i], g_post_mix[i])

        hm = rms_norm(x, g_pre_mlp[i])
        f = jnp.square(jax.nn.relu(hm @ w_mlp_up[i])) @ w_mlp_down[i]
        x = x + rms_norm(f, g_post_mlp[i])

        gate = jax.nn.sigmoid(rms_norm(x, g_pre_ple[i]) @ w_ple_gate[i])
        e = p[i] @ w_ple_proj[i]
        x = x + rms_norm(gate * e, g_post_ple[i])

    return x
```

```cpp
#include <hip/hip_runtime.h>
#include <hip/hip_cooperative_groups.h>
#include <cstdio>
#include <cstdint>
namespace cg = cooperative_groups;

typedef unsigned short bf16_t;
typedef short bf16x8 __attribute__((ext_vector_type(8)));
typedef float f32x16 __attribute__((ext_vector_type(16)));
typedef float f32x4 __attribute__((ext_vector_type(4)));
typedef unsigned u32x4 __attribute__((ext_vector_type(4)));
typedef unsigned u32x2 __attribute__((ext_vector_type(2)));

constexpr int T = 16384, S = 4096, D = 1024, NL = 4, NH = 8, ZW = 2304, FF = 4096;
constexpr float EPS = 1e-6f;
constexpr float QSCALE = 0.10206207261596575f * 1.4426950408889634f;

constexpr size_t MiB = (size_t)1 << 20;
constexpr size_t WS_STAT = 0;
constexpr size_t WS_CNT = 8 * MiB;
constexpr size_t WS_ROPE = 9 * MiB;
constexpr size_t WS_W = 10 * MiB;
constexpr size_t WL_BYTES = 27328512;
constexpr size_t OW_IN = 0, OW_QB = 4718592, OW_KVB = 5308416, OW_OUT = 5832704, OW_UP = 7929856, OW_DOWN = 16318464, OW_G = 24707072, OW_P = 26804224;
constexpr size_t WS_XB = 115 * MiB;
constexpr size_t WS_MIX = 147 * MiB;
constexpr size_t WS_Z = 179 * MiB;
constexpr size_t WS_Q = 251 * MiB;
constexpr size_t WS_K = 275 * MiB;
constexpr size_t WS_VT = 299 * MiB;
constexpr size_t WS_U = 179 * MiB;
constexpr size_t WS_GRAN = 315 * MiB;
constexpr size_t WS_END = 321 * MiB;

enum { ST_X0 = 0, ST_QA = 1, ST_KVA = 2, ST_Y1 = 3, ST_X1 = 4, ST_F = 5, ST_X2 = 6, ST_T = 7 };

constexpr int LROW = 144;
constexpr int TILE_BYTES = 128 * LROW;
constexpr int EP_OFF = 4 * TILE_BYTES;
constexpr int XB_OFF = EP_OFF + 1024;
constexpr int LDS_BYTES = XB_OFF + 64;
constexpr int KROW = 208, VROW = 144;
constexpr int KT_BYTES = 64 * KROW, VT_BYTES = 64 * VROW;

#ifndef PHASES
#define PHASES 511
#endif
#ifndef REPG
#define REPG 1
#endif
#ifndef REPA
#define REPA 1
#endif
#ifndef REPP
#define REPP 1
#endif
#ifndef STOP
#define STOP 0
#endif
struct Params { const float* in[21]; float* out; unsigned char* ws; };

typedef float f32x2_t __attribute__((ext_vector_type(2)));
typedef __bf16 bf16x2_t __attribute__((ext_vector_type(2)));
__device__ __forceinline__ unsigned pk2(float lo, float hi) { const f32x2_t v = {lo, hi}; const bf16x2_t b = __builtin_convertvector(v, bf16x2_t); return __builtin_bit_cast(unsigned, b); }
__device__ __forceinline__ bf16_t f2bf(float f) { return (bf16_t)(pk2(f, 0.f) & 0xffffu); }
__device__ __forceinline__ float bf2f(bf16_t b) { return __uint_as_float(((unsigned)b) << 16); }
__device__ __forceinline__ float bflo(unsigned w) { return __uint_as_float(w << 16); }
__device__ __forceinline__ float bfhi(unsigned w) { return __uint_as_float(w & 0xffff0000u); }
__device__ __forceinline__ int opq(int v) { asm volatile("" : "+v"(v)); return v; }
__device__ __forceinline__ int crow(int r, int hi) { return (r & 3) + 8 * (r >> 2) + 4 * hi; }
__device__ __forceinline__ int vblock() { const int G = gridDim.x, b = blockIdx.x; return (G % 8 == 0) ? (b % 8) * (G / 8) + b / 8 : b; }
__device__ __forceinline__ void st_wt(float* p, float v) { __hip_atomic_store(p, v, __ATOMIC_RELAXED, __HIP_MEMORY_SCOPE_AGENT); }
__device__ __forceinline__ float atomic_ldf(const float* p) { return __hip_atomic_load(p, __ATOMIC_RELAXED, __HIP_MEMORY_SCOPE_AGENT); }
__device__ __forceinline__ float sum_slots(const float* p, int nslot) {
    const f32x4* q = (const f32x4*)p; float s = 0.f;
    for (int i = 0; i < (nslot >> 2); ++i) { const f32x4 a = q[i]; s += (a[0] + a[1]) + (a[2] + a[3]); }
    for (int i = nslot & ~3; i < nslot; ++i) s += p[i];
    return s;
}

__device__ __forceinline__ float rowsum32(const float (&s)[16], int lane) {
    const bool b4 = lane & 16, b3 = lane & 8, b2 = lane & 4, b1 = lane & 2;
    float a[8], b[4], c[2], d;
#pragma unroll
    for (int i = 0; i < 8; ++i) { const float keep = b4 ? s[8 + i] : s[i], send = b4 ? s[i] : s[8 + i]; a[i] = keep + __shfl_xor(send, 16); }
#pragma unroll
    for (int i = 0; i < 4; ++i) { const float keep = b3 ? a[4 + i] : a[i], send = b3 ? a[i] : a[4 + i]; b[i] = keep + __shfl_xor(send, 8); }
#pragma unroll
    for (int i = 0; i < 2; ++i) { const float keep = b2 ? b[2 + i] : b[i], send = b2 ? b[i] : b[2 + i]; c[i] = keep + __shfl_xor(send, 4); }
    { const float keep = b1 ? c[1] : c[0], send = b1 ? c[0] : c[1]; d = keep + __shfl_xor(send, 2); }
    d += __shfl_xor(d, 1);
    return d;
}

template <bool AF32>
__device__ __forceinline__ void gemm_mainloop(const void* __restrict__ Ap, int lda, const bf16_t* __restrict__ Bt, int ldb, int K,
                                              unsigned char* smem, f32x16 (&acc)[2][2]) {
    const int tid = opq(threadIdx.x), lane = tid & 63, wave = __builtin_amdgcn_readfirstlane(tid >> 6), wm = wave >> 1, wn = wave & 1, fm = lane & 31, hi = lane >> 5;
    const int srow = tid >> 3, skc = tid & 7;
    u32x4 ra0[4], rb0[4], ra1[4], rb1[4];
#pragma unroll
    for (int i = 0; i < 2; ++i)
#pragma unroll
        for (int j = 0; j < 2; ++j)
#pragma unroll
            for (int r = 0; r < 16; ++r) acc[i][j][r] = 0.f;
    const int aoff = (wm * 64 + fm) * LROW + hi * 16, boff = (wn * 64 + fm) * LROW + hi * 16;
    const int soff = srow * LROW + skc * 16;
    const unsigned la = (unsigned)(srow * lda + skc * 8), lb = (unsigned)(srow * ldb + skc * 8);
    auto loadt = [&](int k0, u32x4 (&ra)[4], u32x4 (&rb)[4]) __attribute__((always_inline)) {
#pragma unroll
        for (int i = 0; i < 4; ++i) {
            if (AF32) {
                const float* ap = (const float*)Ap + (size_t)(32 * i) * lda + k0;
                const f32x4 v0 = *(const f32x4*)(ap + la), v1 = *(const f32x4*)(ap + la + 4);
                ra[i] = (u32x4){pk2(v0[0], v0[1]), pk2(v0[2], v0[3]), pk2(v1[0], v1[1]), pk2(v1[2], v1[3])};
            } else {
                const bf16_t* ap = (const bf16_t*)Ap + (size_t)(32 * i) * lda + k0;
                ra[i] = *(const u32x4*)(ap + la);
            }
            const bf16_t* bp = Bt + (size_t)(32 * i) * ldb + k0;
            rb[i] = *(const u32x4*)(bp + lb);
        }
    };
    auto storet = [&](int buf, const u32x4 (&ra)[4], const u32x4 (&rb)[4]) __attribute__((always_inline)) {
        unsigned char* a = smem + buf * 2 * TILE_BYTES;
        unsigned char* b = a + TILE_BYTES;
#pragma unroll
        for (int i = 0; i < 4; ++i) { *(u32x4*)(a + soff + i * 32 * LROW) = ra[i]; *(u32x4*)(b + soff + i * 32 * LROW) = rb[i]; }
    };
    auto compute = [&](int buf) __attribute__((always_inline)) {
        const unsigned char* a = smem + buf * 2 * TILE_BYTES;
        const unsigned char* b = a + TILE_BYTES;
        __builtin_amdgcn_s_setprio(1);
#pragma unroll
        for (int kk = 0; kk < 4; ++kk) {
            const bf16x8 a0 = *(const bf16x8*)(a + aoff + kk * 32), a1 = *(const bf16x8*)(a + aoff + 32 * LROW + kk * 32);
            const bf16x8 b0 = *(const bf16x8*)(b + boff + kk * 32), b1 = *(const bf16x8*)(b + boff + 32 * LROW + kk * 32);
            acc[0][0] = __builtin_amdgcn_mfma_f32_32x32x16_bf16(a0, b0, acc[0][0], 0, 0, 0);
            acc[0][1] = __builtin_amdgcn_mfma_f32_32x32x16_bf16(a0, b1, acc[0][1], 0, 0, 0);
            acc[1][0] = __builtin_amdgcn_mfma_f32_32x32x16_bf16(a1, b0, acc[1][0], 0, 0, 0);
            acc[1][1] = __builtin_amdgcn_mfma_f32_32x32x16_bf16(a1, b1, acc[1][1], 0, 0, 0);
        }
        __builtin_amdgcn_s_setprio(0);
    };
    const int nk = K >> 6;
    for (int rep = 0; rep < REPG; ++rep) {
    if (rep) {
#pragma unroll
        for (int i = 0; i < 2; ++i)
#pragma unroll
            for (int j = 0; j < 2; ++j)
#pragma unroll
                for (int r = 0; r < 16; ++r) acc[i][j][r] = 0.f;
    }
    loadt(0, ra0, rb0);
    if (nk > 1) loadt(64, ra1, rb1);
    storet(0, ra0, rb0); __syncthreads();
    for (int kt = 0; kt < nk; kt += 2) {
        if (kt + 2 < nk) loadt((kt + 2) << 6, ra0, rb0);
        __builtin_amdgcn_sched_barrier(0);
        compute(0);
        if (kt + 1 < nk) storet(1, ra1, rb1);
        __syncthreads();
        if (kt + 1 < nk) {
            if (kt + 3 < nk) loadt((kt + 3) << 6, ra1, rb1);
            __builtin_amdgcn_sched_barrier(0);
            compute(1);
            if (kt + 2 < nk) storet(0, ra0, rb0);
            __syncthreads();
        }
    }
    }
}

constexpr int LROW2 = 80;
constexpr int A2_BYTES = 128 * LROW2, B2_BYTES = 256 * LROW2, STAGE2 = A2_BYTES + B2_BYTES;
__device__ __forceinline__ void gemm_mainloop_w(const bf16_t* __restrict__ Ap, int lda, const bf16_t* __restrict__ Bt, int ldb, int K,
                                                unsigned char* smem, f32x16 (&acc)[2][4]) {
    const int tid = opq(threadIdx.x), lane = tid & 63, wave = __builtin_amdgcn_readfirstlane(tid >> 6), wm = wave >> 1, wn = wave & 1, fm = lane & 31, hi = lane >> 5;
    const int srow = tid >> 2, skc = tid & 3;
    u32x4 ra0[2], rb0[4], ra1[2], rb1[4];
#pragma unroll
    for (int i = 0; i < 2; ++i)
#pragma unroll
        for (int j = 0; j < 4; ++j)
#pragma unroll
            for (int r = 0; r < 16; ++r) acc[i][j][r] = 0.f;
    const int aoff = (wm * 64 + fm) * LROW2 + hi * 16, boff = A2_BYTES + (wn * 128 + fm) * LROW2 + hi * 16;
    const int soff = srow * LROW2 + skc * 16;
    const unsigned la = (unsigned)(srow * lda + skc * 8), lb = (unsigned)(srow * ldb + skc * 8);
    auto loadt = [&](int k0, u32x4 (&ra)[2], u32x4 (&rb)[4]) __attribute__((always_inline)) {
#pragma unroll
        for (int i = 0; i < 2; ++i) { const bf16_t* ap = Ap + (size_t)(64 * i) * lda + k0; ra[i] = *(const u32x4*)(ap + la); }
#pragma unroll
        for (int i = 0; i < 4; ++i) { const bf16_t* bp = Bt + (size_t)(64 * i) * ldb + k0; rb[i] = *(const u32x4*)(bp + lb); }
    };
    auto storet = [&](int buf, const u32x4 (&ra)[2], const u32x4 (&rb)[4]) __attribute__((always_inline)) {
        unsigned char* a = smem + buf * STAGE2;
#pragma unroll
        for (int i = 0; i < 2; ++i) *(u32x4*)(a + soff + i * 64 * LROW2) = ra[i];
#pragma unroll
        for (int i = 0; i < 4; ++i) *(u32x4*)(a + A2_BYTES + soff + i * 64 * LROW2) = rb[i];
    };
    auto compute = [&](int buf) __attribute__((always_inline)) {
        const unsigned char* s = smem + buf * STAGE2;
        bf16x8 a[2][2], b[2][4];
#pragma unroll
        for (int kk = 0; kk < 2; ++kk) {
            a[kk][0] = *(const bf16x8*)(s + aoff + kk * 32); a[kk][1] = *(const bf16x8*)(s + aoff + 32 * LROW2 + kk * 32);
#pragma unroll
            for (int nt = 0; nt < 4; ++nt) b[kk][nt] = *(const bf16x8*)(s + boff + nt * 32 * LROW2 + kk * 32);
        }
        __builtin_amdgcn_sched_barrier(0);
        __builtin_amdgcn_s_setprio(1);
#pragma unroll
        for (int kk = 0; kk < 2; ++kk)
#pragma unroll
            for (int nt = 0; nt < 4; ++nt) {
                acc[0][nt] = __builtin_amdgcn_mfma_f32_32x32x16_bf16(a[kk][0], b[kk][nt], acc[0][nt], 0, 0, 0);
                acc[1][nt] = __builtin_amdgcn_mfma_f32_32x32x16_bf16(a[kk][1], b[kk][nt], acc[1][nt], 0, 0, 0);
            }
        __builtin_amdgcn_s_setprio(0);
    };
    const int nk = K >> 5;
    loadt(0, ra0, rb0);
    if (nk > 1) loadt(32, ra1, rb1);
    storet(0, ra0, rb0); __syncthreads();
    for (int kt = 0; kt < nk; kt += 2) {
        if (kt + 2 < nk) loadt((kt + 2) << 5, ra0, rb0);
        __builtin_amdgcn_sched_barrier(0);
        compute(0);
        if (kt + 1 < nk) storet(1, ra1, rb1);
        __syncthreads();
        if (kt + 1 < nk) {
            if (kt + 3 < nk) loadt((kt + 3) << 5, ra1, rb1);
            __builtin_amdgcn_sched_barrier(0);
            compute(1);
            if (kt + 2 < nk) storet(0, ra0, rb0);
            __syncthreads();
        }
    }
}

__device__ __forceinline__ void exch_epilogue(f32x16 (&v)[2][2], int row0, int col0, unsigned long long* gran, unsigned tag, const float* __restrict__ gain,
                                              float* xout, bf16_t* xb, float* part_next, float* ep) {
    const int tid = opq(threadIdx.x), lane = tid & 63, wave = __builtin_amdgcn_readfirstlane(tid >> 6), wm = wave >> 1, wn = wave & 1, fm = lane & 31, hi = lane >> 5;
    const int slot = (col0 >> 7) * 2 + wn;
    float xo[2][2][16];
#pragma unroll
    for (int mt = 0; mt < 2; ++mt)
#pragma unroll
        for (int nt = 0; nt < 2; ++nt) {
            const float* xp = xout + (size_t)(row0 + wm * 64 + mt * 32 + 4 * hi) * D + col0 + wn * 64 + nt * 32 + fm;
#pragma unroll
            for (int r = 0; r < 16; ++r) xo[mt][nt][r] = xp[((r & 3) + 8 * (r >> 2)) * D];
        }
#pragma unroll
    for (int mt = 0; mt < 2; ++mt) {
        float ss[16];
#pragma unroll
        for (int r = 0; r < 16; ++r) ss[r] = v[mt][0][r] * v[mt][0][r] + v[mt][1][r] * v[mt][1][r];
        const float tot = rowsum32(ss, lane);
        if ((lane & 1) == 0) __hip_atomic_store(gran + (size_t)(row0 + wm * 64 + mt * 32 + crow((lane >> 1) & 15, hi)) * 16 + slot, ((unsigned long long)tag << 32) | (unsigned long long)__float_as_uint(tot), __ATOMIC_RELAXED, __HIP_MEMORY_SCOPE_AGENT);
    }
    if (tid < 128) {
        const unsigned long long* g = gran + (size_t)(row0 + tid) * 16;
        float s;
        for (;;) {
            s = 0.f; bool ok = true;
#pragma unroll
            for (int i = 0; i < 16; ++i) { const unsigned long long x = __hip_atomic_load(g + i, __ATOMIC_RELAXED, __HIP_MEMORY_SCOPE_AGENT); ok &= ((unsigned)(x >> 32) == tag); s += __uint_as_float((unsigned)x); }
            if (ok) break;
            __builtin_amdgcn_s_sleep(1);
        }
        ep[128 + tid] = rsqrtf(s * (1.0f / 1024.0f) + EPS);
    }
    __syncthreads();
#pragma unroll
    for (int mt = 0; mt < 2; ++mt) {
        float ss[16], rs[16];
#pragma unroll
        for (int r = 0; r < 16; ++r) { ss[r] = 0.f; rs[r] = ep[128 + wm * 64 + mt * 32 + crow(r, hi)]; }
#pragma unroll
        for (int nt = 0; nt < 2; ++nt) {
            const int col = col0 + wn * 64 + nt * 32 + fm;
            const float g = gain[col];
            float* xp = xout + (size_t)(row0 + wm * 64 + mt * 32 + 4 * hi) * D + col;
            bf16_t* bp = xb + (size_t)(row0 + wm * 64 + mt * 32 + 4 * hi) * D + col;
#pragma unroll
            for (int g4 = 0; g4 < 4; ++g4) {
#pragma unroll
                for (int i = 0; i < 4; ++i) {
                    const int r = 4 * g4 + i, off = (8 * g4 + i) * D;
                    const float xn = xo[mt][nt][r] + v[mt][nt][r] * rs[r] * g;
                    xp[off] = xn; bp[off] = f2bf(xn); ss[r] += xn * xn;
                }
                asm volatile("" ::: "memory");
            }
        }
        const float tot = rowsum32(ss, lane);
        if ((lane & 1) == 0) part_next[(size_t)(row0 + wm * 64 + mt * 32 + crow((lane >> 1) & 15, hi)) * 16 + slot] = tot;
    }
}

__device__ __forceinline__ void exch_epilogue_w(f32x16 (&v)[2][4], int row0, int col0, unsigned long long* gran, unsigned tag, const float* __restrict__ gain,
                                                float* xout, bf16_t* xb, float* part_next, float* ep) {
    const int tid = opq(threadIdx.x), lane = tid & 63, wave = __builtin_amdgcn_readfirstlane(tid >> 6), wm = wave >> 1, wn = wave & 1, fm = lane & 31, hi = lane >> 5;
    const int slot = (col0 >> 8) * 2 + wn;
    float xs[2][16];
    auto ldx = [&](int u, float (&x)[16]) __attribute__((always_inline)) {
        const int lo = opq((4 * hi) * D + fm);
        const float* xp = xout + (size_t)(row0 + wm * 64 + (u >> 2) * 32) * D + col0 + wn * 128 + (u & 3) * 32 + lo;
#pragma unroll
        for (int r = 0; r < 16; ++r) x[r] = xp[((r & 3) + 8 * (r >> 2)) * D];
    };
    ldx(0, xs[0]);
#pragma unroll
    for (int mt = 0; mt < 2; ++mt) {
        float ss[16];
#pragma unroll
        for (int r = 0; r < 16; ++r) ss[r] = (v[mt][0][r] * v[mt][0][r] + v[mt][1][r] * v[mt][1][r]) + (v[mt][2][r] * v[mt][2][r] + v[mt][3][r] * v[mt][3][r]);
        const float tot = rowsum32(ss, lane);
        if ((lane & 1) == 0) __hip_atomic_store(gran + (size_t)(row0 + wm * 64 + mt * 32 + crow((lane >> 1) & 15, hi)) * 16 + slot, ((unsigned long long)tag << 32) | (unsigned long long)__float_as_uint(tot), __ATOMIC_RELAXED, __HIP_MEMORY_SCOPE_AGENT);
    }
    if (tid < 128) {
        const unsigned long long* g = gran + (size_t)(row0 + tid) * 16;
        float s;
        for (;;) {
            s = 0.f; bool ok = true;
#pragma unroll
            for (int i = 0; i < 8; ++i) { const unsigned long long x = __hip_atomic_load(g + i, __ATOMIC_RELAXED, __HIP_MEMORY_SCOPE_AGENT); ok &= ((unsigned)(x >> 32) == tag); s += __uint_as_float((unsigned)x); }
            if (ok) break;
            __builtin_amdgcn_s_sleep(1);
        }
        ep[128 + tid] = rsqrtf(s * (1.0f / 1024.0f) + EPS);
    }
    __syncthreads();
    float ss[16];
#pragma unroll
    for (int u = 0; u < 8; ++u) {
        const int mt = u >> 2, nt = u & 3;
        if (nt == 0) {
#pragma unroll
            for (int r = 0; r < 16; ++r) ss[r] = 0.f;
        }
        if (u + 1 < 8) ldx(u + 1, xs[(u + 1) & 1]);
        const int fmo = opq(fm), hio = opq(hi);
        const int col = col0 + wn * 128 + nt * 32 + fmo;
        const float g = gain[col];
        float* xp = xout + (size_t)(row0 + wm * 64 + mt * 32 + 4 * hio) * D + col;
        bf16_t* bp = xb + (size_t)(row0 + wm * 64 + mt * 32 + 4 * hio) * D + col;
#pragma unroll
        for (int g4 = 0; g4 < 4; ++g4) {
            const f32x4 rs4 = *(const f32x4*)(ep + 128 + wm * 64 + mt * 32 + 8 * g4 + 4 * hio);
#pragma unroll
            for (int i = 0; i < 4; ++i) {
                const int r = 4 * g4 + i, off = (8 * g4 + i) * D;
                const float xn = xs[u & 1][r] + v[mt][nt][r] * rs4[i] * g;
                xp[off] = xn; bp[off] = f2bf(xn); ss[r] += xn * xn;
            }
        }
        asm volatile("" ::: "memory");
        if (nt == 3) {
            const float tot = rowsum32(ss, lane);
            if ((lane & 1) == 0) part_next[(size_t)(row0 + wm * 64 + mt * 32 + crow((lane >> 1) & 15, hi)) * 16 + slot] = tot;
        }
    }
}

__device__ __forceinline__ void gbar(unsigned* ctr, unsigned& epoch, unsigned G) {
    asm volatile("s_waitcnt vmcnt(0)" ::: "memory");
    __syncthreads();
    epoch += 1u;
    if (threadIdx.x == 0) {
        __builtin_amdgcn_fence(__ATOMIC_RELEASE, "agent");
        asm volatile("s_waitcnt vmcnt(0)" ::: "memory");
        __hip_atomic_fetch_add(ctr, 1u, __ATOMIC_RELAXED, __HIP_MEMORY_SCOPE_AGENT);
        const unsigned target = epoch * G;
        while (__hip_atomic_load(ctr, __ATOMIC_RELAXED, __HIP_MEMORY_SCOPE_AGENT) < target) __builtin_amdgcn_s_sleep(1);
        __builtin_amdgcn_fence(__ATOMIC_ACQUIRE, "agent");
        asm volatile("s_waitcnt vmcnt(0)" ::: "memory");
    }
    __syncthreads();
}

#define LAS __attribute__((address_space(3)))
#define XB_TMO      128
#define XB_XCNT(j)  (256  + 64 * (j))
#define XB_XSUB(j)  (1280 + 64 * (j))
#define XB_XGEN(j)  (2304 + 64 * (j))
#define XB_TOP      3328
#define XB_TOPGEN   3392
#define XCD_BAR_WORDS 3456
#define XB_SPIN_CAP (1u << 22)
__device__ __forceinline__ unsigned xb_ld(unsigned* p)              { return __hip_atomic_load(p, __ATOMIC_RELAXED, __HIP_MEMORY_SCOPE_AGENT); }
__device__ __forceinline__ unsigned xb_add(unsigned* p, unsigned v) { return __hip_atomic_fetch_add(p, v, __ATOMIC_RELAXED, __HIP_MEMORY_SCOPE_AGENT); }
__device__ __forceinline__ unsigned xb_xcc_id() { return (unsigned)__builtin_amdgcn_s_getreg((3 << 11) | 20) & 0xFu; }
#define XB_SPIN(cond, bar) do { unsigned _sp = 0; while (cond) { __builtin_amdgcn_s_sleep(1); \
    if ((++_sp & 255u) == 0u) { if (xb_ld(&(bar)[XB_TMO])) break; if (_sp > XB_SPIN_CAP) { atomicAdd(&(bar)[XB_TMO], 1u); break; } } } } while (0)
struct XcdBarrier { unsigned* bar; unsigned x; volatile LAS unsigned* st; };
__device__ __forceinline__ XcdBarrier xcd_barrier_post(unsigned* bar, volatile LAS unsigned* st) {
    XcdBarrier b; b.bar = bar; b.x = xb_xcc_id(); b.st = st;
    if (threadIdx.x == 0) (void)xb_add(&bar[XB_XCNT(b.x)], 1u);
    return b;
}
__device__ __forceinline__ void xcd_barrier_complete(unsigned* bar, unsigned x, unsigned& nloc, unsigned& nx) {
    const unsigned G = gridDim.x * gridDim.y * gridDim.z;
    unsigned sum, cnt, mine, sp = 0u;
    for (;;) {
        sum = 0u; cnt = 0u; mine = 0u;
#pragma unroll
        for (unsigned j = 0; j < 16; ++j) { const unsigned c = xb_ld(&bar[XB_XCNT(j)]); sum += c; cnt += (c > 0u) ? 1u : 0u; mine = (j == x) ? c : mine; }
        if (sum == G) break;
        __builtin_amdgcn_s_sleep(1);
        if ((++sp & 255u) == 0u) { if (xb_ld(&bar[XB_TMO])) break; if (sp > XB_SPIN_CAP) { atomicAdd(&bar[XB_TMO], 1u); break; } }
    }
    nloc = mine > 0u ? mine : 1u; nx = cnt > 0u ? cnt : 1u;
}
__device__ __forceinline__ void xcd_barrier(const XcdBarrier& b) {
    asm volatile("s_waitcnt vmcnt(0)" ::: "memory");
    __syncthreads();
    if (threadIdx.x == 0) {
        unsigned* bar = b.bar;
        __builtin_amdgcn_s_waitcnt(0);
        unsigned nloc = b.st[0], nx = b.st[1];
        if (nloc == 0u) { xcd_barrier_complete(bar, b.x, nloc, nx); b.st[0] = nloc; b.st[1] = nx; }
        const unsigned old = xb_add(&bar[XB_XSUB(b.x)], 1u);
        const unsigned gen = old / nloc;
        if (old + 1u == (gen + 1u) * nloc) {
            __builtin_amdgcn_fence(__ATOMIC_RELEASE, "agent");
            asm volatile("s_waitcnt vmcnt(0)" ::: "memory");
            const unsigned og = xb_add(&bar[XB_TOP], 1u);
            const unsigned tg = og / nx;
            if (og + 1u == (tg + 1u) * nx) xb_add(&bar[XB_TOPGEN], 1u);
            else XB_SPIN(xb_ld(&bar[XB_TOPGEN]) == tg, bar);
            __builtin_amdgcn_fence(__ATOMIC_ACQUIRE, "agent");
            xb_add(&bar[XB_XGEN(b.x)], 1u);
            asm volatile("s_waitcnt vmcnt(0)" ::: "memory");
        } else {
            XB_SPIN(xb_ld(&bar[XB_XGEN(b.x)]) == gen, bar);
            __builtin_amdgcn_fence(__ATOMIC_ACQUIRE, "agent");
            asm volatile("s_waitcnt vmcnt(0)" ::: "memory");
        }
    }
    __syncthreads();
}

__global__ void __launch_bounds__(256, 2) mega(Params P) {
    extern __shared__ __attribute__((aligned(16))) unsigned char lds[];
    cg::grid_group grid = cg::this_grid();
    const int tid = threadIdx.x, lane = tid & 63, wave = __builtin_amdgcn_readfirstlane(tid >> 6), wm = wave >> 1, wn = wave & 1, fm = lane & 31, hi = lane >> 5;
    const int G = gridDim.x, vb = vblock();
    unsigned char* ws = P.ws;
    float* stat = (float*)(ws + WS_STAT);
    unsigned* cnts = (unsigned*)(ws + WS_CNT);
    float* cosT = (float*)(ws + WS_ROPE);
    float* sinT = cosT + S * 16;
    bf16_t* xb = (bf16_t*)(ws + WS_XB);
    bf16_t* mix = (bf16_t*)(ws + WS_MIX);
    bf16_t* ebuf = mix;
    bf16_t* zb = (bf16_t*)(ws + WS_Z);
    bf16_t* Qb = (bf16_t*)(ws + WS_Q);
    bf16_t* Kb = (bf16_t*)(ws + WS_K);
    bf16_t* Vt = (bf16_t*)(ws + WS_VT);
    bf16_t* ub = (bf16_t*)(ws + WS_U);
    float* xout = P.out;
    float* ep = (float*)(lds + EP_OFF);
    unsigned long long* gran = (unsigned long long*)(ws + WS_GRAN);
    unsigned* gctr = cnts + 4096;
    unsigned gepoch = 0u; (void)gepoch; (void)gctr;
    volatile LAS unsigned* xst = (volatile LAS unsigned*)((LAS unsigned char*)lds + XB_OFF);
    if (tid == 0) { xst[0] = 0u; xst[1] = 0u; }

    auto dump_bf = [&](const bf16_t* buf, int pitch) {
        grid.sync();
        for (int i = vb * 256 + tid; i < T * D; i += G * 256) { const int row = i >> 10, col = i & 1023; xout[i] = bf2f(buf[(size_t)row * pitch + col]); }
    };
    if (PHASES & 1) for (int rep = 0; rep < REPP; ++rep) {
        float* tl = (float*)lds;
        for (int t = vb; t < NL * 3336; t += G) {
            const int l = t / 3336; int r = t % 3336;
            const float* src; const float* gA = nullptr; const float* gB = nullptr; int K, N, Np; size_t off;
            if (r < 576) { src = P.in[3] + (size_t)l * 1024 * 2208; gA = P.in[2] + l * 1024; gB = gA + 512; K = 1024; N = 2208; Np = 2304; off = OW_IN; }
            else if ((r -= 576) < 72) { src = P.in[5] + (size_t)l * 384 * 768; gA = P.in[4] + l * 384; gB = gA + 512; K = 384; N = 768; Np = 768; off = OW_QB; }
            else if ((r -= 72) < 64) { src = P.in[7] + (size_t)l * 256 * 1024; gA = P.in[6] + l * 256; gB = gA + 512; K = 256; N = 1024; Np = 1024; off = OW_KVB; }
            else if ((r -= 64) < 256) { src = P.in[11] + (size_t)l * 1024 * 1024; gA = P.in[9] + l * 512; gB = P.in[10] + l * 512; K = 1024; N = 1024; Np = 1024; off = OW_OUT; }
            else if ((r -= 256) < 1024) { src = P.in[14] + (size_t)l * 1024 * 4096; gA = P.in[13] + l * 1024; gB = gA + 512; K = 1024; N = 4096; Np = 4096; off = OW_UP; }
            else if ((r -= 1024) < 1024) { src = P.in[15] + (size_t)l * 4096 * 1024; K = 4096; N = 1024; Np = 1024; off = OW_DOWN; }
            else if ((r -= 1024) < 256) { src = P.in[18] + (size_t)l * 1024 * 1024; gA = P.in[17] + l * 1024; gB = gA + 512; K = 1024; N = 1024; Np = 1024; off = OW_G; }
            else { r -= 256; src = P.in[19] + (size_t)l * 256 * 1024; K = 256; N = 1024; Np = 1024; off = OW_P; }
            bf16_t* dst = (bf16_t*)(ws + WS_W + (size_t)l * WL_BYTES + off);
            const int nct = Np / 64, k0 = (r / nct) * 64, n0 = (r % nct) * 64;
#pragma unroll
            for (int j = 0; j < 4; ++j) {
                const int kr = (tid >> 4) + 16 * j, n4 = (tid & 15) * 4, k = k0 + kr;
                f32x4 v = (f32x4){0.f, 0.f, 0.f, 0.f};
                if (n0 + n4 < N) v = *(const f32x4*)(src + (size_t)k * N + n0 + n4);
                float g = 1.f;
                if (gA) g = (k < 512) ? gA[k] : gB[k - 512];
                tl[kr * 65 + n4 + 0] = v[0] * g; tl[kr * 65 + n4 + 1] = v[1] * g; tl[kr * 65 + n4 + 2] = v[2] * g; tl[kr * 65 + n4 + 3] = v[3] * g;
            }
            __syncthreads();
            {
                const int n = tid >> 2, kq = (tid & 3) * 16;
                unsigned w[8];
#pragma unroll
                for (int i = 0; i < 8; ++i) w[i] = pk2(tl[(kq + 2 * i) * 65 + n], tl[(kq + 2 * i + 1) * 65 + n]);
                bf16_t* dp = dst + (size_t)(n0 + n) * K + k0 + kq;
                *(u32x4*)dp = (u32x4){w[0], w[1], w[2], w[3]};
                *(u32x4*)(dp + 8) = (u32x4){w[4], w[5], w[6], w[7]};
            }
            __syncthreads();
        }
        const float* x = P.in[0];
        for (int row = vb * 4 + wave; row < T; row += G * 4) {
            float ss = 0.f;
#pragma unroll
            for (int j = 0; j < 4; ++j) {
                const size_t idx = (size_t)row * D + j * 256 + lane * 4;
                const f32x4 v = *(const f32x4*)(x + idx);
                *(f32x4*)(xout + idx) = v;
                *(u32x2*)(xb + idx) = (u32x2){pk2(v[0], v[1]), pk2(v[2], v[3])};
                ss += v[0] * v[0] + v[1] * v[1] + v[2] * v[2] + v[3] * v[3];
            }
            ss += __shfl_xor(ss, 32); ss += __shfl_xor(ss, 16); ss += __shfl_xor(ss, 8); ss += __shfl_xor(ss, 4); ss += __shfl_xor(ss, 2); ss += __shfl_xor(ss, 1);
            if (lane < 16) stat[((size_t)ST_X0 * T + row) * 16 + lane] = (lane == 0) ? ss : 0.f;
        }
        for (int idx = vb * 256 + tid; idx < NL * 3 * 128; idx += G * 256) cnts[idx] = 0u;
        if (blockIdx.x == 0 && tid == 0) *gctr = 0u;
        for (int idx = vb * 256 + tid; idx < 3 * T * 16 / 2; idx += G * 256) ((u32x4*)gran)[idx] = (u32x4){0u, 0u, 0u, 0u};
        for (int idx = vb * 256 + tid; idx < XCD_BAR_WORDS; idx += G * 256) cnts[8192 + idx] = 0u;
        for (int idx = vb * 256 + tid; idx < S * 16; idx += G * 256) {
            const int s = idx >> 4, j = idx & 15;
            const double base = sqrt(sqrt(sqrt(sqrt(10000.0))));
            double pw = 1.0;
            for (int q = 0; q < j; ++q) pw *= base;
            const float pwf = (float)pw;
            const float inv_freq = 1.0f / pwf;
            const float angf = (float)s * inv_freq;
            const double a = (double)angf;
            const double n = rint(a * 0.15915494309189535);
            const double rr = a - n * 6.283185307179586;
            const double r2 = rr * rr;
            double sn = 0.0, term = rr;
            for (int k = 0; k < 16; ++k) { sn += term; term *= -r2 / (double)((2 * k + 2) * (2 * k + 3)); }
            double cs = 0.0; term = 1.0;
            for (int k = 0; k < 16; ++k) { cs += term; term *= -r2 / (double)((2 * k + 1) * (2 * k + 2)); }
            cosT[idx] = (float)cs; sinT[idx] = (float)sn;
        }
    }
    grid.sync();
    const XcdBarrier xbar = xcd_barrier_post(cnts + 8192, xst);

    for (int l = 0; l < NL; ++l) {
        const unsigned char* wl = ws + WS_W + (size_t)l * WL_BYTES;
        const bf16_t* WIN = (const bf16_t*)(wl + OW_IN);
        const bf16_t* WQB = (const bf16_t*)(wl + OW_QB);
        const bf16_t* WKVB = (const bf16_t*)(wl + OW_KVB);
        const bf16_t* WOUT = (const bf16_t*)(wl + OW_OUT);
        const bf16_t* WUP = (const bf16_t*)(wl + OW_UP);
        const bf16_t* WDOWN = (const bf16_t*)(wl + OW_DOWN);
        const bf16_t* WG = (const bf16_t*)(wl + OW_G);
        const bf16_t* WP = (const bf16_t*)(wl + OW_P);
        float* st = stat;

        if (PHASES & 2) for (int t = vb; t < 128 * 18; t += G) {
            const int tid = opq(threadIdx.x), lane = tid & 63, wave = __builtin_amdgcn_readfirstlane(tid >> 6), wm = wave >> 1, wn = wave & 1, fm = lane & 31, hi = lane >> 5; (void)wm; (void)wn; (void)fm; (void)hi; (void)wave; (void)lane;
            int panel = t / 18, ct = t % 18;
            if (G == 512) {
                const int i = t >> 9, q = vb & 63, x = vb >> 6;
                if (i < 4) { const int M = i * 8 + x; panel = (M >> 1) * 8 + (q >> 3); ct = (M & 1) * 8 + (q & 7); }
                else { const int u = t - 2048; panel = u >> 1; ct = 16 + (u & 1); }
            }
            const int row0 = panel * 128, col0 = ct * 128;
            if (tid < 128) ep[tid] = rsqrtf(sum_slots(st + ((size_t)ST_X0 * T + row0 + tid) * 16, 16) * (1.0f / 1024.0f) + EPS);
            f32x16 acc[2][2];
            gemm_mainloop<false>(xb + (size_t)row0 * D, D, WIN + (size_t)col0 * D, D, D, lds, acc);
#pragma unroll
            for (int mt = 0; mt < 2; ++mt) {
                float ss[16], rs[16];
#pragma unroll
                for (int r = 0; r < 16; ++r) { ss[r] = 0.f; rs[r] = ep[wm * 64 + mt * 32 + crow(r, hi)]; }
#pragma unroll
                for (int nt = 0; nt < 2; ++nt) {
                    const int col = col0 + wn * 64 + nt * 32 + fm;
#pragma unroll
                    for (int r = 0; r < 16; ++r) {
                        const float v = acc[mt][nt][r] * rs[r];
                        zb[(size_t)(row0 + wm * 64 + mt * 32 + crow(r, hi)) * ZW + col] = f2bf(v);
                        ss[r] += v * v;
                    }
                }
                if (ct < 5) {
                    const float tot = rowsum32(ss, lane);
                    float* pp = st + ((size_t)(ct < 3 ? ST_QA : ST_KVA) * T + row0 + wm * 64 + mt * 32 + crow((lane >> 1) & 15, hi)) * 16 + (ct < 3 ? ct : ct - 3) * 2 + wn;
                    if ((lane & 1) == 0) *pp = tot;
                }
            }
            __syncthreads();
        }
        xcd_barrier(xbar);

        if (STOP == 1) { dump_bf(zb, ZW); return; }
        if (PHASES & 4) for (int t = vb; t < 128 * 14; t += G) {
            const int tid = opq(threadIdx.x), lane = tid & 63, wave = __builtin_amdgcn_readfirstlane(tid >> 6), wm = wave >> 1, wn = wave & 1, fm = lane & 31, hi = lane >> 5; (void)wm; (void)wn; (void)fm; (void)hi; (void)wave; (void)lane;
            f32x16 acc[2][2];
            if (t < 128 * 6) {
                const int panel = t / 6, ct = t % 6, row0 = panel * 128, col0 = ct * 128;
                if (tid < 128) ep[tid] = rsqrtf(sum_slots(st + ((size_t)ST_QA * T + row0 + tid) * 16, 6) * (1.0f / 384.0f) + EPS);
                gemm_mainloop<false>(zb + (size_t)row0 * ZW, ZW, WQB + (size_t)col0 * 384, 384, 384, lds, acc);
#pragma unroll
                for (int mt = 0; mt < 2; ++mt) {
                    float rs[16];
#pragma unroll
                    for (int r = 0; r < 16; ++r) rs[r] = ep[wm * 64 + mt * 32 + crow(r, hi)] * QSCALE;
#pragma unroll
                    for (int nt = 0; nt < 2; ++nt) {
                        const int c32 = col0 + wn * 64 + nt * 32;
                        const int h = c32 / 96, dh = c32 % 96;
                        const bool rope = (dh == 64);
#pragma unroll
                        for (int r = 0; r < 16; ++r) {
                            const int row = row0 + wm * 64 + mt * 32 + crow(r, hi);
                            const int b = row >> 12, s = row & 4095;
                            float v = acc[mt][nt][r] * rs[r];
                            if (rope) {
                                const float pr = __shfl_xor(v, 16);
                                const float c = cosT[s * 16 + (fm & 15)], sn = sinT[s * 16 + (fm & 15)];
                                v = (fm < 16) ? (v * c - pr * sn) : (v * c + pr * sn);
                            }
                            Qb[((size_t)(b * NH + h) * S + s) * 96 + dh + fm] = f2bf(v);
                        }
                    }
                }
            } else {
                const int t2 = t - 128 * 6;
                const int panel = t2 / 8, ct = t2 % 8, row0 = panel * 128, col0 = ct * 128;
                if (tid < 128) ep[tid] = rsqrtf(sum_slots(st + ((size_t)ST_KVA * T + row0 + tid) * 16, 4) * (1.0f / 256.0f) + EPS);
                gemm_mainloop<false>(zb + (size_t)row0 * ZW + 384, ZW, WKVB + (size_t)col0 * 256, 256, 256, lds, acc);
                const int h = ct;
#pragma unroll
                for (int mt = 0; mt < 2; ++mt) {
                    float rs[16];
#pragma unroll
                    for (int r = 0; r < 16; ++r) rs[r] = ep[wm * 64 + mt * 32 + crow(r, hi)];
                    const int rbase = row0 + wm * 64 + mt * 32;
                    const int b = rbase >> 12;
#pragma unroll
                    for (int nt = 0; nt < 2; ++nt) {
                        const int d = nt * 32 + fm;
                        if (wn == 0) {
#pragma unroll
                            for (int r = 0; r < 16; ++r) {
                                const int s = (rbase + crow(r, hi)) & 4095;
                                Kb[((size_t)(b * NH + h) * S + s) * 96 + d] = f2bf(acc[mt][nt][r] * rs[r]);
                            }
                        } else {
#pragma unroll
                            for (int g = 0; g < 4; ++g) {
                                const int s = (rbase + 8 * g + 4 * hi) & 4095;
                                const u32x2 w = (u32x2){pk2(acc[mt][nt][4 * g] * rs[4 * g], acc[mt][nt][4 * g + 1] * rs[4 * g + 1]),
                                                         pk2(acc[mt][nt][4 * g + 2] * rs[4 * g + 2], acc[mt][nt][4 * g + 3] * rs[4 * g + 3])};
                                *(u32x2*)(Vt + ((size_t)(b * NH + h) * 64 + d) * S + s) = w;
                            }
                        }
                    }
                }
            }
            __syncthreads();
        }
        if (PHASES & 8) {
            const float* wc = P.in[8] + (size_t)l * 3 * 512;
            for (int row = vb * 4 + wave; row < T; row += G * 4) {
                const int tid = opq(threadIdx.x), lane = tid & 63, wave_ = 0, wm = 0, wn = 0, fm = lane & 31, hi = lane >> 5; (void)wm; (void)wn; (void)fm; (void)hi; (void)wave_; (void)lane;
                const int s = row & 4095, b = row >> 12;
                const bf16_t* zr = zb + (size_t)row * ZW;
                const int c0 = 8 * lane;
                const u32x4 gbv = *(const u32x4*)(zr + 672 + c0);
                const u32x4 gc1 = *(const u32x4*)(zr + 1184 + c0), ci1 = *(const u32x4*)(zr + 1696 + c0);
                u32x4 gc0 = (u32x4){0, 0, 0, 0}, ci0 = gc0, gc2 = gc0, ci2 = gc0;
                if (s > 0) { gc0 = *(const u32x4*)(zr - ZW + 1184 + c0); ci0 = *(const u32x4*)(zr - ZW + 1696 + c0); }
                if (s < S - 1) { gc2 = *(const u32x4*)(zr + ZW + 1184 + c0); ci2 = *(const u32x4*)(zr + ZW + 1696 + c0); }
                const f32x4 w0a = *(const f32x4*)(wc + c0), w0b = *(const f32x4*)(wc + c0 + 4);
                const f32x4 w1a = *(const f32x4*)(wc + 512 + c0), w1b = *(const f32x4*)(wc + 512 + c0 + 4);
                const f32x4 w2a = *(const f32x4*)(wc + 1024 + c0), w2b = *(const f32x4*)(wc + 1024 + c0 + 4);
                float cv[8]; float ss = 0.f;
#pragma unroll
                for (int i = 0; i < 4; ++i) {
                    const unsigned a0 = gc0[i], a1 = gc1[i], a2 = gc2[i], d0 = ci0[i], d1 = ci1[i], d2 = ci2[i], gw = gbv[i];
                    const float wlo0 = (i < 2) ? w0a[2 * i] : w0b[2 * i - 4], whi0 = (i < 2) ? w0a[2 * i + 1] : w0b[2 * i - 3];
                    const float wlo1 = (i < 2) ? w1a[2 * i] : w1b[2 * i - 4], whi1 = (i < 2) ? w1a[2 * i + 1] : w1b[2 * i - 3];
                    const float wlo2 = (i < 2) ? w2a[2 * i] : w2b[2 * i - 4], whi2 = (i < 2) ? w2a[2 * i + 1] : w2b[2 * i - 3];
                    const float lo = bflo(gw) * (wlo0 * bflo(a0) * bflo(d0) + wlo1 * bflo(a1) * bflo(d1) + wlo2 * bflo(a2) * bflo(d2));
                    const float hv = bfhi(gw) * (whi0 * bfhi(a0) * bfhi(d0) + whi1 * bfhi(a1) * bfhi(d1) + whi2 * bfhi(a2) * bfhi(d2));
                    cv[2 * i] = lo; cv[2 * i + 1] = hv; ss += lo * lo + hv * hv;
                }
                ss += __shfl_xor(ss, 1); ss += __shfl_xor(ss, 2); ss += __shfl_xor(ss, 4);
                const float rn = rsqrtf(ss * (1.0f / 64.0f) + EPS);
                *(u32x4*)(mix + (size_t)row * D + 512 + c0) = (u32x4){pk2(cv[0] * rn, cv[1] * rn), pk2(cv[2] * rn, cv[3] * rn), pk2(cv[4] * rn, cv[5] * rn), pk2(cv[6] * rn, cv[7] * rn)};
                if (lane < 16) {
                    const float a = bf2f(zr[640 + lane]), bb = bf2f(zr[656 + lane]);
                    const float c = cosT[s * 16 + lane], sn = sinT[s * 16 + lane];
                    const bf16_t o1 = f2bf(a * c - bb * sn), o2 = f2bf(bb * c + a * sn);
#pragma unroll
                    for (int h = 0; h < NH; ++h) {
                        bf16_t* kp = Kb + ((size_t)(b * NH + h) * S + s) * 96;
                        kp[64 + lane] = o1; kp[80 + lane] = o2;
                    }
                }
            }
        }
        xcd_barrier(xbar);

        if (STOP == 2) { dump_bf(Qb, 768); return; }
        if (STOP == 12) { dump_bf(Kb, 768); return; }
        if (STOP == 22) { dump_bf(Vt, 512); return; }
        if (STOP == 32) { dump_bf(mix, 1024); return; }
        if (PHASES & 16) for (int rep = 0; rep < REPA; ++rep) for (int it = vb; it < 32 * 16; it += G) {
            const int tid = opq(threadIdx.x), lane = tid & 63, wave = __builtin_amdgcn_readfirstlane(tid >> 6), fm = lane & 31, hi = lane >> 5;
            const int bh = it >> 4, qb = it & 15, b = bh >> 3, h = bh & 7;
            const bf16_t* Qp = Qb + ((size_t)bh * S + qb * 256 + wave * 64 + fm) * 96 + hi * 8;
            const bf16_t* Kp = Kb + (size_t)bh * S * 96;
            const bf16_t* Vp = Vt + (size_t)bh * 64 * S;
            bf16x8 qf[2][6];
#pragma unroll
            for (int u = 0; u < 2; ++u)
#pragma unroll
                for (int d0 = 0; d0 < 6; ++d0) qf[u][d0] = *(const bf16x8*)(Qp + (size_t)u * 32 * 96 + d0 * 16);
            f32x16 o[2][2];
#pragma unroll
            for (int u = 0; u < 2; ++u)
#pragma unroll
                for (int r = 0; r < 16; ++r) { o[u][0][r] = 0.f; o[u][1][r] = 0.f; }
            float mhat[2] = {0.f, 0.f}, lrun[2] = {0.f, 0.f};
            u32x4 kr[3], vr[2];
            const int pim = (fm & ~12) | ((fm & 4) << 1) | ((fm & 8) >> 1);
            const int koff = pim * KROW + hi * 16, voff = fm * VROW + hi * 16;
            auto loadkv = [&](int kv0) __attribute__((always_inline)) {
#pragma unroll
                for (int i = 0; i < 3; ++i) kr[i] = *(const u32x4*)(Kp + (size_t)kv0 * 96 + (tid + 256 * i) * 8);
#pragma unroll
                for (int i = 0; i < 2; ++i) { const int c = tid + 256 * i; vr[i] = *(const u32x4*)(Vp + (size_t)(c >> 3) * S + kv0 + (c & 7) * 8); }
            };
            auto storekv = [&](int buf) __attribute__((always_inline)) {
                unsigned char* kb = lds + buf * (KT_BYTES + VT_BYTES);
                unsigned char* vbp = kb + KT_BYTES;
#pragma unroll
                for (int i = 0; i < 3; ++i) { const int c = tid + 256 * i; *(u32x4*)(kb + (c / 12) * KROW + (c % 12) * 16) = kr[i]; }
#pragma unroll
                for (int i = 0; i < 2; ++i) { const int c = tid + 256 * i; *(u32x4*)(vbp + (c >> 3) * VROW + (c & 7) * 16) = vr[i]; }
            };
            loadkv(0); storekv(0); __syncthreads();
            for (int kt = 0; kt < 64; ++kt) {
                if (kt + 1 < 64) loadkv((kt + 1) * 64);
                __builtin_amdgcn_sched_barrier(0);
                const unsigned char* kb = lds + (kt & 1) * (KT_BYTES + VT_BYTES);
                const unsigned char* vbp = kb + KT_BYTES;
                f32x16 p[2][2];
#pragma unroll
                for (int d0 = 0; d0 < 6; ++d0) {
                    const bf16x8 k0 = *(const bf16x8*)(kb + koff + d0 * 32), k1 = *(const bf16x8*)(kb + koff + 32 * KROW + d0 * 32);
#pragma unroll
                    for (int u = 0; u < 2; ++u) {
                        if (d0 == 0) {
                            p[u][0] = __builtin_amdgcn_mfma_f32_32x32x16_bf16(k0, qf[u][0], (f32x16){0.f,0.f,0.f,0.f,0.f,0.f,0.f,0.f,0.f,0.f,0.f,0.f,0.f,0.f,0.f,0.f}, 0, 0, 0);
                            p[u][1] = __builtin_amdgcn_mfma_f32_32x32x16_bf16(k1, qf[u][0], (f32x16){0.f,0.f,0.f,0.f,0.f,0.f,0.f,0.f,0.f,0.f,0.f,0.f,0.f,0.f,0.f,0.f}, 0, 0, 0);
                        } else {
                            p[u][0] = __builtin_amdgcn_mfma_f32_32x32x16_bf16(k0, qf[u][d0], p[u][0], 0, 0, 0);
                            p[u][1] = __builtin_amdgcn_mfma_f32_32x32x16_bf16(k1, qf[u][d0], p[u][1], 0, 0, 0);
                        }
                    }
                }
#pragma unroll
                for (int u = 0; u < 2; ++u) {
                    float mx = p[u][0][0];
#pragma unroll
                    for (int r = 0; r < 16; ++r) mx = fmaxf(fmaxf(mx, p[u][0][r]), p[u][1][r]);
                    mx = fmaxf(mx, __shfl_xor(mx, 32));
                    if (kt == 0 || __any(mx - mhat[u] > 8.0f)) {
                        const float nm = (kt == 0) ? mx : fmaxf(mx, mhat[u]);
                        const float f = (kt == 0) ? 1.0f : __builtin_amdgcn_exp2f(mhat[u] - nm);
                        mhat[u] = nm; lrun[u] *= f;
#pragma unroll
                        for (int r = 0; r < 16; ++r) { o[u][0][r] *= f; o[u][1][r] *= f; }
                    }
                }
                auto soft = [&](int u, bf16x8 (&pfu)[4]) __attribute__((always_inline)) {
                    const float mh = mhat[u];
#pragma unroll
                    for (int r = 0; r < 16; ++r) { p[u][0][r] = __builtin_amdgcn_exp2f(p[u][0][r] - mh); p[u][1][r] = __builtin_amdgcn_exp2f(p[u][1][r] - mh); }
                    {
                        const f32x16 t = p[u][0] + p[u][1];
                        float rsum = ((t[0] + t[1]) + (t[2] + t[3])) + ((t[4] + t[5]) + (t[6] + t[7]));
                        rsum += ((t[8] + t[9]) + (t[10] + t[11])) + ((t[12] + t[13]) + (t[14] + t[15]));
                        lrun[u] += rsum;
                    }
#pragma unroll
                    for (int c = 0; c < 4; ++c) {
                        const int mt = c >> 1, r0 = (c & 1) * 8;
                        const u32x4 w = (u32x4){pk2(p[u][mt][r0], p[u][mt][r0 + 1]), pk2(p[u][mt][r0 + 2], p[u][mt][r0 + 3]), pk2(p[u][mt][r0 + 4], p[u][mt][r0 + 5]), pk2(p[u][mt][r0 + 6], p[u][mt][r0 + 7])};
                        pfu[c] = __builtin_bit_cast(bf16x8, w);
                    }
                };
                auto pvm = [&](int u, const bf16x8 (&pfu)[4]) __attribute__((always_inline)) {
#pragma unroll
                    for (int c = 0; c < 4; ++c) {
                        const bf16x8 v0 = *(const bf16x8*)(vbp + voff + c * 32), v1 = *(const bf16x8*)(vbp + voff + 32 * VROW + c * 32);
                        o[u][0] = __builtin_amdgcn_mfma_f32_32x32x16_bf16(v0, pfu[c], o[u][0], 0, 0, 0);
                        o[u][1] = __builtin_amdgcn_mfma_f32_32x32x16_bf16(v1, pfu[c], o[u][1], 0, 0, 0);
                    }
                };
                bf16x8 pfa[4], pfb[4];
                soft(0, pfa);
                pvm(0, pfa);
                soft(1, pfb);
#pragma unroll
                for (int i = 0; i < 8; ++i) { __builtin_amdgcn_sched_group_barrier(0x008, 1, 0); __builtin_amdgcn_sched_group_barrier(0x002, 10, 0); }
                pvm(1, pfb);
                if (kt + 1 < 64) storekv((kt + 1) & 1);
                __syncthreads();
            }
#pragma unroll
            for (int u = 0; u < 2; ++u) {
                const float ltot = lrun[u] + __shfl_xor(lrun[u], 32);
                const float inv = 1.0f / ltot;
                float ss = 0.f;
#pragma unroll
                for (int r = 0; r < 16; ++r) { o[u][0][r] *= inv; o[u][1][r] *= inv; ss += o[u][0][r] * o[u][0][r] + o[u][1][r] * o[u][1][r]; }
                ss += __shfl_xor(ss, 32);
                const float rn = rsqrtf(ss * (1.0f / 64.0f) + EPS);
                bf16_t* mp = mix + (size_t)(b * S + qb * 256 + wave * 64 + u * 32 + fm) * D + h * 64 + 4 * hi;
#pragma unroll
                for (int d0 = 0; d0 < 2; ++d0)
#pragma unroll
                    for (int g = 0; g < 4; ++g)
                        *(u32x2*)(mp + d0 * 32 + 8 * g) = (u32x2){pk2(o[u][d0][4 * g] * rn, o[u][d0][4 * g + 1] * rn), pk2(o[u][d0][4 * g + 2] * rn, o[u][d0][4 * g + 3] * rn)};
            }
        }
        xcd_barrier(xbar);

        if (STOP == 3) { dump_bf(mix, 1024); return; }
        if (PHASES & 32) for (int t = vb; t < 128 * 4; t += G) {
            const int panel = t >> 2, ct = t & 3, row0 = panel * 128, col0 = ct * 256;
            f32x16 acc[2][4];
            gemm_mainloop_w(mix + (size_t)row0 * D, D, WOUT + (size_t)col0 * D, D, D, lds, acc);
            exch_epilogue_w(acc, row0, col0, gran + (size_t)0 * T * 16, (unsigned)(l * 4 + 1), P.in[12] + l * D, xout, xb, st + (size_t)ST_X1 * T * 16, ep);
            __syncthreads();
        }
        xcd_barrier(xbar);

        if (STOP == 4) { return; }
        if (PHASES & 64) for (int t = vb; t < 2048 + 1024; t += G) {
            const int tid = opq(threadIdx.x), lane = tid & 63, wave = __builtin_amdgcn_readfirstlane(tid >> 6), wm = wave >> 1, wn = wave & 1, fm = lane & 31, hi = lane >> 5; (void)lane;
            if (t < 2048) {
                int panel = t >> 4, ct = t & 15;
                if (G == 512) { const int M = (t >> 9) * 8 + (vb >> 6), q = vb & 63; panel = (M >> 1) * 8 + (q >> 3); ct = (M & 1) * 8 + (q & 7); }
                const int row0 = panel * 128, col0 = ct * 256;
                if (tid < 128) ep[tid] = rsqrtf(sum_slots(st + ((size_t)ST_X1 * T + row0 + tid) * 16, 8) * (1.0f / 1024.0f) + EPS);
                f32x16 acc[2][4];
                gemm_mainloop_w(xb + (size_t)row0 * D, D, WUP + (size_t)col0 * D, D, D, lds, acc);
#pragma unroll
                for (int mt = 0; mt < 2; ++mt) {
                    float rs[16];
#pragma unroll
                    for (int r = 0; r < 16; ++r) rs[r] = ep[wm * 64 + mt * 32 + crow(r, hi)];
#pragma unroll
                    for (int nt = 0; nt < 4; ++nt) {
                        const int col = col0 + wn * 128 + nt * 32 + fm;
#pragma unroll
                        for (int r = 0; r < 16; ++r) {
                            const float v = fmaxf(acc[mt][nt][r] * rs[r], 0.f);
                            ub[(size_t)(row0 + wm * 64 + mt * 32 + crow(r, hi)) * FF + col] = f2bf(v * v);
                        }
                    }
                }
            } else {
                const int t2 = t - 2048;
                const int panel = t2 >> 3, ct = t2 & 7, row0 = panel * 128, col0 = ct * 128;
                f32x16 acc[2][2];
                gemm_mainloop<true>(P.in[1] + ((size_t)l * T + row0) * 256, 256, WP + (size_t)col0 * 256, 256, 256, lds, acc);
#pragma unroll
                for (int mt = 0; mt < 2; ++mt)
#pragma unroll
                    for (int nt = 0; nt < 2; ++nt) {
                        const int col = col0 + wn * 64 + nt * 32 + fm;
#pragma unroll
                        for (int r = 0; r < 16; ++r) ebuf[(size_t)(row0 + wm * 64 + mt * 32 + crow(r, hi)) * D + col] = f2bf(acc[mt][nt][r]);
                    }
            }
            __syncthreads();
        }
        xcd_barrier(xbar);

        if (STOP == 5) { dump_bf(ub, 4096); return; }
        if (STOP == 15) { dump_bf(ebuf, 1024); return; }
        if (PHASES & 128) for (int t = vb; t < 128 * 4; t += G) {
            const int panel = t >> 2, ct = t & 3, row0 = panel * 128, col0 = ct * 256;
            f32x16 acc[2][4];
            gemm_mainloop_w(ub + (size_t)row0 * FF, FF, WDOWN + (size_t)col0 * FF, FF, FF, lds, acc);
            exch_epilogue_w(acc, row0, col0, gran + (size_t)1 * T * 16, (unsigned)(l * 4 + 2), P.in[16] + l * D, xout, xb, st + (size_t)ST_X2 * T * 16, ep);
            __syncthreads();
        }
        xcd_barrier(xbar);

        if (STOP == 6) { return; }
        if (PHASES & 256) for (int t = vb; t < 128 * 8; t += G) {
            const int tid = opq(threadIdx.x), lane = tid & 63, wave = __builtin_amdgcn_readfirstlane(tid >> 6), wm = wave >> 1, wn = wave & 1, fm = lane & 31, hi = lane >> 5; (void)wm; (void)wn; (void)fm; (void)hi; (void)wave; (void)lane;
            const int panel = t >> 3, ct = t & 7, row0 = panel * 128, col0 = ct * 128;
            if (tid < 128) ep[tid] = rsqrtf(sum_slots(st + ((size_t)ST_X2 * T + row0 + tid) * 16, 8) * (1.0f / 1024.0f) + EPS);
            f32x16 acc[2][2];
            gemm_mainloop<false>(xb + (size_t)row0 * D, D, WG + (size_t)col0 * D, D, D, lds, acc);
#pragma unroll
            for (int mt = 0; mt < 2; ++mt) {
                float rs[16];
#pragma unroll
                for (int r = 0; r < 16; ++r) rs[r] = ep[wm * 64 + mt * 32 + crow(r, hi)];
#pragma unroll
                for (int nt = 0; nt < 2; ++nt) {
                    const int col = col0 + wn * 64 + nt * 32 + fm;
#pragma unroll
                    for (int r = 0; r < 16; ++r) {
                        const float gte = 1.0f / (1.0f + __expf(-acc[mt][nt][r] * rs[r]));
                        acc[mt][nt][r] = gte * bf2f(ebuf[(size_t)(row0 + wm * 64 + mt * 32 + crow(r, hi)) * D + col]);
                    }
                }
            }
            exch_epilogue(acc, row0, col0, gran + (size_t)2 * T * 16, (unsigned)(l * 4 + 3), P.in[20] + l * D, xout, xb, st + (size_t)ST_X0 * T * 16, ep);
            __syncthreads();
        }
        if (STOP == 7) return;
        if (l + 1 < NL) xcd_barrier(xbar);
    }
}

extern "C" void kernel_launch(void* const* d_in, const int* in_sizes, int n_in, void* d_out, int out_size, void* d_ws, size_t ws_size, hipStream_t stream) {
    static int grid = 0;
    if (grid == 0) {
        if (n_in != 21 || out_size != T * D || ws_size < WS_END) { fprintf(stderr, "kernel_launch: unexpected problem (n_in %d out %d ws %zu)\n", n_in, out_size, ws_size); grid = -1; return; }
        int dev = 0, cus = 0, per_cu = 0;
        hipGetDevice(&dev);
        hipDeviceGetAttribute(&cus, hipDeviceAttributeMultiprocessorCount, dev);
        if (hipFuncSetAttribute((const void*)mega, hipFuncAttributeMaxDynamicSharedMemorySize, LDS_BYTES) != hipSuccess) { fprintf(stderr, "hipFuncSetAttribute failed\n"); grid = -1; return; }
        if (hipOccupancyMaxActiveBlocksPerMultiprocessor(&per_cu, (const void*)mega, 256, LDS_BYTES) != hipSuccess || per_cu < 1) { fprintf(stderr, "occupancy query failed (%d)\n", per_cu); per_cu = 1; }
        if (per_cu > 2) per_cu = 2;
        grid = (cus * per_cu) & ~7;
        fprintf(stderr, "kernel_launch: cus %d per_cu %d grid %d\n", cus, per_cu, grid);
    }
    if (grid < 0) return;
    Params p{};
    for (int i = 0; i < 21; ++i) p.in[i] = (const float*)d_in[i];
    p.out = (float*)d_out; p.ws = (unsigned char*)d_ws;
    void* args[] = {&p};
    hipError_t e = hipLaunchCooperativeKernel((const void*)mega, dim3(grid), dim3(256), args, LDS_BYTES, stream);
    if (e != hipSuccess) fprintf(stderr, "cooperative launch failed: %s (grid %d)\n", hipGetErrorString(e), grid);
}
```

```cpp
#include <hip/hip_runtime.h>
#include <hip/hip_cooperative_groups.h>
#include <cstdio>
#include <cstdint>
namespace cg = cooperative_groups;

typedef unsigned short bf16_t;
typedef short bf16x8 __attribute__((ext_vector_type(8)));
typedef float f32x16 __attribute__((ext_vector_type(16)));
typedef float f32x4 __attribute__((ext_vector_type(4)));
typedef unsigned u32x4 __attribute__((ext_vector_type(4)));
typedef unsigned u32x2 __attribute__((ext_vector_type(2)));

constexpr int T = 16384, S = 4096, D = 1024, NL = 4, NH = 8, ZW = 2304, FF = 4096;
constexpr float EPS = 1e-6f;
constexpr float QSCALE = 0.10206207261596575f * 1.4426950408889634f;

constexpr size_t MiB = (size_t)1 << 20;
constexpr size_t WS_STAT = 0;
constexpr size_t WS_CNT = 8 * MiB;
constexpr size_t WS_ROPE = 9 * MiB;
constexpr size_t WS_W = 10 * MiB;
constexpr size_t WL_BYTES = 27328512;
constexpr size_t OW_IN = 0, OW_QB = 4718592, OW_KVB = 5308416, OW_OUT = 5832704, OW_UP = 7929856, OW_DOWN = 16318464, OW_G = 24707072, OW_P = 26804224;
constexpr size_t WS_XB = 115 * MiB;
constexpr size_t WS_MIX = 147 * MiB;
constexpr size_t WS_Z = 179 * MiB;
constexpr size_t WS_Q = 251 * MiB;
constexpr size_t WS_K = 275 * MiB;
constexpr size_t WS_VT = 299 * MiB;
constexpr size_t WS_U = 179 * MiB;
constexpr size_t WS_GRAN = 315 * MiB;
constexpr size_t WS_END = 321 * MiB;

enum { ST_X0 = 0, ST_QA = 1, ST_KVA = 2, ST_Y1 = 3, ST_X1 = 4, ST_F = 5, ST_X2 = 6, ST_T = 7 };

constexpr int LROW = 144;
constexpr int TILE_BYTES = 128 * LROW;
constexpr int EP_OFF = 4 * TILE_BYTES;
constexpr int XB_OFF = EP_OFF + 1024;
constexpr int LDS_BYTES = XB_OFF + 64;
constexpr int KROW = 208, VROW = 144;
constexpr int KT_BYTES = 64 * KROW, VT_BYTES = 64 * VROW;

#ifndef PHASES
#define PHASES 511
#endif
#ifndef REPG
#define REPG 1
#endif
#ifndef REPA
#define REPA 1
#endif
#ifndef REPP
#define REPP 1
#endif
#ifndef STOP
#define STOP 0
#endif
struct Params { const float* in[21]; float* out; unsigned char* ws; };

typedef float f32x2_t __attribute__((ext_vector_type(2)));
typedef __bf16 bf16x2_t __attribute__((ext_vector_type(2)));
__device__ __forceinline__ unsigned pk2(float lo, float hi) { const f32x2_t v = {lo, hi}; const bf16x2_t b = __builtin_convertvector(v, bf16x2_t); return __builtin_bit_cast(unsigned, b); }
__device__ __forceinline__ bf16_t f2bf(float f) { return (bf16_t)(pk2(f, 0.f) & 0xffffu); }
__device__ __forceinline__ float bf2f(bf16_t b) { return __uint_as_float(((unsigned)b) << 16); }
__device__ __forceinline__ float bflo(unsigned w) { return __uint_as_float(w << 16); }
__device__ __forceinline__ float bfhi(unsigned w) { return __uint_as_float(w & 0xffff0000u); }
__device__ __forceinline__ int opq(int v) { asm volatile("" : "+v"(v)); return v; }
__device__ __forceinline__ int crow(int r, int hi) { return (r & 3) + 8 * (r >> 2) + 4 * hi; }
__device__ __forceinline__ int vblock() { const int G = gridDim.x, b = blockIdx.x; return (G % 8 == 0) ? (b % 8) * (G / 8) + b / 8 : b; }
__device__ __forceinline__ void st_wt(float* p, float v) { __hip_atomic_store(p, v, __ATOMIC_RELAXED, __HIP_MEMORY_SCOPE_AGENT); }
__device__ __forceinline__ float atomic_ldf(const float* p) { return __hip_atomic_load(p, __ATOMIC_RELAXED, __HIP_MEMORY_SCOPE_AGENT); }
__device__ __forceinline__ float sum_slots(const float* p, int nslot) {
    const f32x4* q = (const f32x4*)p; float s = 0.f;
    for (int i = 0; i < (nslot >> 2); ++i) { const f32x4 a = q[i]; s += (a[0] + a[1]) + (a[2] + a[3]); }
    for (int i = nslot & ~3; i < nslot; ++i) s += p[i];
    return s;
}

__device__ __forceinline__ float rowsum32(const float (&s)[16], int lane) {
    const bool b4 = lane & 16, b3 = lane & 8, b2 = lane & 4, b1 = lane & 2;
    float a[8], b[4], c[2], d;
#pragma unroll
    for (int i = 0; i < 8; ++i) { const float keep = b4 ? s[8 + i] : s[i], send = b4 ? s[i] : s[8 + i]; a[i] = keep + __shfl_xor(send, 16); }
#pragma unroll
    for (int i = 0; i < 4; ++i) { const float keep = b3 ? a[4 + i] : a[i], send = b3 ? a[i] : a[4 + i]; b[i] = keep + __shfl_xor(send, 8); }
#pragma unroll
    for (int i = 0; i < 2; ++i) { const float keep = b2 ? b[2 + i] : b[i], send = b2 ? b[i] : b[2 + i]; c[i] = keep + __shfl_xor(send, 4); }
    { const float keep = b1 ? c[1] : c[0], send = b1 ? c[0] : c[1]; d = keep + __shfl_xor(send, 2); }
    d += __shfl_xor(d, 1);
    return d;
}

template <bool AF32>
__device__ __forceinline__ void gemm_mainloop(const void* __restrict__ Ap, int lda, const bf16_t* __restrict__ Bt, int ldb, int K,
                                              unsigned char* smem, f32x16 (&acc)[2][2]) {
    const int tid = opq(threadIdx.x), lane = tid & 63, wave = __builtin_amdgcn_readfirstlane(tid >> 6), wm = wave >> 1, wn = wave & 1, fm = lane & 31, hi = lane >> 5;
    const int srow = tid >> 3, skc = tid & 7;
    u32x4 ra0[4], rb0[4], ra1[4], rb1[4];
    u32x4 rx0[AF32 ? 4 : 1], rx1[AF32 ? 4 : 1];
#pragma unroll
    for (int i = 0; i < 2; ++i)
#pragma unroll
        for (int j = 0; j < 2; ++j)
#pragma unroll
            for (int r = 0; r < 16; ++r) acc[i][j][r] = 0.f;
    const int aoff = (wm * 64 + fm) * LROW + hi * 16, boff = (wn * 64 + fm) * LROW + hi * 16;
    const int soff = srow * LROW + skc * 16;
    const unsigned la = (unsigned)(srow * lda + skc * 8), lb = (unsigned)(srow * ldb + skc * 8);
    auto loadt = [&](int k0, u32x4 (&ra)[4], u32x4 (&rx)[AF32 ? 4 : 1], u32x4 (&rb)[4]) __attribute__((always_inline)) {
#pragma unroll
        for (int i = 0; i < 4; ++i) {
            if (AF32) {
                const float* ap = (const float*)Ap + (size_t)(32 * i) * lda + k0;
                ra[i] = *(const u32x4*)(ap + la); rx[i] = *(const u32x4*)(ap + la + 4);
            } else {
                const bf16_t* ap = (const bf16_t*)Ap + (size_t)(32 * i) * lda + k0;
                ra[i] = *(const u32x4*)(ap + la);
            }
            const bf16_t* bp = Bt + (size_t)(32 * i) * ldb + k0;
            rb[i] = *(const u32x4*)(bp + lb);
        }
    };
    auto storet = [&](int buf, const u32x4 (&ra)[4], const u32x4 (&rx)[AF32 ? 4 : 1], const u32x4 (&rb)[4]) __attribute__((always_inline)) {
        unsigned char* a = smem + buf * 2 * TILE_BYTES;
        unsigned char* b = a + TILE_BYTES;
#pragma unroll
        for (int i = 0; i < 4; ++i) {
            u32x4 av = ra[i];
            if (AF32) av = (u32x4){pk2(__uint_as_float(ra[i][0]), __uint_as_float(ra[i][1])), pk2(__uint_as_float(ra[i][2]), __uint_as_float(ra[i][3])),
                                   pk2(__uint_as_float(rx[i][0]), __uint_as_float(rx[i][1])), pk2(__uint_as_float(rx[i][2]), __uint_as_float(rx[i][3]))};
            *(u32x4*)(a + soff + i * 32 * LROW) = av; *(u32x4*)(b + soff + i * 32 * LROW) = rb[i];
        }
    };
    auto compute = [&](int buf) __attribute__((always_inline)) {
        const unsigned char* a = smem + buf * 2 * TILE_BYTES;
        const unsigned char* b = a + TILE_BYTES;
        __builtin_amdgcn_s_setprio(1);
#pragma unroll
        for (int kk = 0; kk < 4; ++kk) {
            const bf16x8 a0 = *(const bf16x8*)(a + aoff + kk * 32), a1 = *(const bf16x8*)(a + aoff + 32 * LROW + kk * 32);
            const bf16x8 b0 = *(const bf16x8*)(b + boff + kk * 32), b1 = *(const bf16x8*)(b + boff + 32 * LROW + kk * 32);
            acc[0][0] = __builtin_amdgcn_mfma_f32_32x32x16_bf16(a0, b0, acc[0][0], 0, 0, 0);
            acc[0][1] = __builtin_amdgcn_mfma_f32_32x32x16_bf16(a0, b1, acc[0][1], 0, 0, 0);
            acc[1][0] = __builtin_amdgcn_mfma_f32_32x32x16_bf16(a1, b0, acc[1][0], 0, 0, 0);
            acc[1][1] = __builtin_amdgcn_mfma_f32_32x32x16_bf16(a1, b1, acc[1][1], 0, 0, 0);
        }
        __builtin_amdgcn_s_setprio(0);
    };
    const int nk = K >> 6;
    for (int rep = 0; rep < REPG; ++rep) {
    if (rep) {
#pragma unroll
        for (int i = 0; i < 2; ++i)
#pragma unroll
            for (int j = 0; j < 2; ++j)
#pragma unroll
                for (int r = 0; r < 16; ++r) acc[i][j][r] = 0.f;
    }
    loadt(0, ra0, rx0, rb0);
    if (nk > 1) loadt(64, ra1, rx1, rb1);
    storet(0, ra0, rx0, rb0); __syncthreads();
    for (int kt = 0; kt < nk; kt += 2) {
        if (kt + 2 < nk) loadt((kt + 2) << 6, ra0, rx0, rb0);
        __builtin_amdgcn_sched_barrier(0);
        compute(0);
        if (kt + 1 < nk) storet(1, ra1, rx1, rb1);
        __syncthreads();
        if (kt + 1 < nk) {
            if (kt + 3 < nk) loadt((kt + 3) << 6, ra1, rx1, rb1);
            __builtin_amdgcn_sched_barrier(0);
            compute(1);
            if (kt + 2 < nk) storet(0, ra0, rx0, rb0);
            __syncthreads();
        }
    }
    }
}

constexpr int LROW2 = 80;
constexpr int A2_BYTES = 128 * LROW2, B2_BYTES = 256 * LROW2, STAGE2 = A2_BYTES + B2_BYTES;
__device__ __forceinline__ void gemm_mainloop_w(const bf16_t* __restrict__ Ap, int lda, const bf16_t* __restrict__ Bt, int ldb, int K,
                                                unsigned char* smem, f32x16 (&acc)[2][4]) {
    const int tid = opq(threadIdx.x), lane = tid & 63, wave = __builtin_amdgcn_readfirstlane(tid >> 6), wm = wave >> 1, wn = wave & 1, fm = lane & 31, hi = lane >> 5;
    const int srow = tid >> 2, skc = tid & 3;
    u32x4 ra0[2], rb0[4], ra1[2], rb1[4];
#pragma unroll
    for (int i = 0; i < 2; ++i)
#pragma unroll
        for (int j = 0; j < 4; ++j)
#pragma unroll
            for (int r = 0; r < 16; ++r) acc[i][j][r] = 0.f;
    const int aoff = (wm * 64 + fm) * LROW2 + hi * 16, boff = A2_BYTES + (wn * 128 + fm) * LROW2 + hi * 16;
    const int soff = srow * LROW2 + skc * 16;
    const unsigned la = (unsigned)(srow * lda + skc * 8), lb = (unsigned)(srow * ldb + skc * 8);
    auto loadt = [&](int k0, u32x4 (&ra)[2], u32x4 (&rb)[4]) __attribute__((always_inline)) {
#pragma unroll
        for (int i = 0; i < 2; ++i) { const bf16_t* ap = Ap + (size_t)(64 * i) * lda + k0; ra[i] = *(const u32x4*)(ap + la); }
#pragma unroll
        for (int i = 0; i < 4; ++i) { const bf16_t* bp = Bt + (size_t)(64 * i) * ldb + k0; rb[i] = *(const u32x4*)(bp + lb); }
    };
    auto storet = [&](int buf, const u32x4 (&ra)[2], const u32x4 (&rb)[4]) __attribute__((always_inline)) {
        unsigned char* a = smem + buf * STAGE2;
#pragma unroll
        for (int i = 0; i < 2; ++i) *(u32x4*)(a + soff + i * 64 * LROW2) = ra[i];
#pragma unroll
        for (int i = 0; i < 4; ++i) *(u32x4*)(a + A2_BYTES + soff + i * 64 * LROW2) = rb[i];
    };
    auto compute = [&](int buf) __attribute__((always_inline)) {
        const unsigned char* s = smem + buf * STAGE2;
        bf16x8 a[2][2], b[2][4];
#pragma unroll
        for (int kk = 0; kk < 2; ++kk) {
            a[kk][0] = *(const bf16x8*)(s + aoff + kk * 32); a[kk][1] = *(const bf16x8*)(s + aoff + 32 * LROW2 + kk * 32);
#pragma unroll
            for (int nt = 0; nt < 4; ++nt) b[kk][nt] = *(const bf16x8*)(s + boff + nt * 32 * LROW2 + kk * 32);
        }
        __builtin_amdgcn_sched_barrier(0);
        __builtin_amdgcn_s_setprio(1);
#pragma unroll
        for (int kk = 0; kk < 2; ++kk)
#pragma unroll
            for (int nt = 0; nt < 4; ++nt) {
                acc[0][nt] = __builtin_amdgcn_mfma_f32_32x32x16_bf16(a[kk][0], b[kk][nt], acc[0][nt], 0, 0, 0);
                acc[1][nt] = __builtin_amdgcn_mfma_f32_32x32x16_bf16(a[kk][1], b[kk][nt], acc[1][nt], 0, 0, 0);
            }
        __builtin_amdgcn_s_setprio(0);
    };
    const int nk = K >> 5;
    loadt(0, ra0, rb0);
    if (nk > 1) loadt(32, ra1, rb1);
    storet(0, ra0, rb0); __syncthreads();
    for (int kt = 0; kt < nk; kt += 2) {
        if (kt + 2 < nk) loadt((kt + 2) << 5, ra0, rb0);
        __builtin_amdgcn_sched_barrier(0);
        compute(0);
        if (kt + 1 < nk) storet(1, ra1, rb1);
        __syncthreads();
        if (kt + 1 < nk) {
            if (kt + 3 < nk) loadt((kt + 3) << 5, ra1, rb1);
            __builtin_amdgcn_sched_barrier(0);
            compute(1);
            if (kt + 2 < nk) storet(0, ra0, rb0);
            __syncthreads();
        }
    }
}

__device__ __forceinline__ void exch_epilogue(f32x16 (&v)[2][2], int row0, int col0, unsigned long long* gran, unsigned tag, const float* __restrict__ gain,
                                              float* xout, bf16_t* xb, float* part_next, float* ep) {
    const int tid = opq(threadIdx.x), lane = tid & 63, wave = __builtin_amdgcn_readfirstlane(tid >> 6), wm = wave >> 1, wn = wave & 1, fm = lane & 31, hi = lane >> 5;
    const int slot = (col0 >> 7) * 2 + wn;
    float xo[2][2][16];
#pragma unroll
    for (int mt = 0; mt < 2; ++mt)
#pragma unroll
        for (int nt = 0; nt < 2; ++nt) {
            const float* xp = xout + (size_t)(row0 + wm * 64 + mt * 32 + 4 * hi) * D + col0 + wn * 64 + nt * 32 + fm;
#pragma unroll
            for (int r = 0; r < 16; ++r) xo[mt][nt][r] = xp[((r & 3) + 8 * (r >> 2)) * D];
        }
#pragma unroll
    for (int mt = 0; mt < 2; ++mt) {
        float ss[16];
#pragma unroll
        for (int r = 0; r < 16; ++r) ss[r] = v[mt][0][r] * v[mt][0][r] + v[mt][1][r] * v[mt][1][r];
        const float tot = rowsum32(ss, lane);
        if ((lane & 1) == 0) __hip_atomic_store(gran + (size_t)(row0 + wm * 64 + mt * 32 + crow((lane >> 1) & 15, hi)) * 16 + slot, ((unsigned long long)tag << 32) | (unsigned long long)__float_as_uint(tot), __ATOMIC_RELAXED, __HIP_MEMORY_SCOPE_AGENT);
    }
    if (tid < 128) {
        const unsigned long long* g = gran + (size_t)(row0 + tid) * 16;
        float s;
        for (;;) {
            s = 0.f; bool ok = true;
#pragma unroll
            for (int i = 0; i < 16; ++i) { const unsigned long long x = __hip_atomic_load(g + i, __ATOMIC_RELAXED, __HIP_MEMORY_SCOPE_AGENT); ok &= ((unsigned)(x >> 32) == tag); s += __uint_as_float((unsigned)x); }
            if (ok) break;
            __builtin_amdgcn_s_sleep(1);
        }
        ep[128 + tid] = rsqrtf(s * (1.0f / 1024.0f) + EPS);
    }
    __syncthreads();
#pragma unroll
    for (int mt = 0; mt < 2; ++mt) {
        float ss[16], rs[16];
#pragma unroll
        for (int r = 0; r < 16; ++r) { ss[r] = 0.f; rs[r] = ep[128 + wm * 64 + mt * 32 + crow(r, hi)]; }
#pragma unroll
        for (int nt = 0; nt < 2; ++nt) {
            const int col = col0 + wn * 64 + nt * 32 + fm;
            const float g = gain[col];
            float* xp = xout + (size_t)(row0 + wm * 64 + mt * 32 + 4 * hi) * D + col;
            bf16_t* bp = xb + (size_t)(row0 + wm * 64 + mt * 32 + 4 * hi) * D + col;
#pragma unroll
            for (int g4 = 0; g4 < 4; ++g4) {
#pragma unroll
                for (int i = 0; i < 4; ++i) {
                    const int r = 4 * g4 + i, off = (8 * g4 + i) * D;
                    const float xn = xo[mt][nt][r] + v[mt][nt][r] * rs[r] * g;
                    xp[off] = xn; bp[off] = f2bf(xn); ss[r] += xn * xn;
                }
                asm volatile("" ::: "memory");
            }
        }
        const float tot = rowsum32(ss, lane);
        if ((lane & 1) == 0) part_next[(size_t)(row0 + wm * 64 + mt * 32 + crow((lane >> 1) & 15, hi)) * 16 + slot] = tot;
    }
}

__device__ __forceinline__ void exch_epilogue_w(f32x16 (&v)[2][4], int row0, int col0, unsigned long long* gran, unsigned tag, const float* __restrict__ gain,
                                                float* xout, bf16_t* xb, float* part_next, float* ep) {
    const int tid = opq(threadIdx.x), lane = tid & 63, wave = __builtin_amdgcn_readfirstlane(tid >> 6), wm = wave >> 1, wn = wave & 1, fm = lane & 31, hi = lane >> 5;
    const int slot = (col0 >> 8) * 2 + wn;
    float xs[2][16];
    auto ldx = [&](int u, float (&x)[16]) __attribute__((always_inline)) {
        const int lo = opq((4 * hi) * D + fm);
        const float* xp = xout + (size_t)(row0 + wm * 64 + (u >> 2) * 32) * D + col0 + wn * 128 + (u & 3) * 32 + lo;
#pragma unroll
        for (int r = 0; r < 16; ++r) x[r] = xp[((r & 3) + 8 * (r >> 2)) * D];
    };
    ldx(0, xs[0]);
#pragma unroll
    for (int mt = 0; mt < 2; ++mt) {
        float ss[16];
#pragma unroll
        for (int r = 0; r < 16; ++r) ss[r] = (v[mt][0][r] * v[mt][0][r] + v[mt][1][r] * v[mt][1][r]) + (v[mt][2][r] * v[mt][2][r] + v[mt][3][r] * v[mt][3][r]);
        const float tot = rowsum32(ss, lane);
        if ((lane & 1) == 0) __hip_atomic_store(gran + (size_t)(row0 + wm * 64 + mt * 32 + crow((lane >> 1) & 15, hi)) * 16 + slot, ((unsigned long long)tag << 32) | (unsigned long long)__float_as_uint(tot), __ATOMIC_RELAXED, __HIP_MEMORY_SCOPE_AGENT);
    }
    if (tid < 128) {
        const unsigned long long* g = gran + (size_t)(row0 + tid) * 16;
        float s;
        for (;;) {
            s = 0.f; bool ok = true;
#pragma unroll
            for (int i = 0; i < 8; ++i) { const unsigned long long x = __hip_atomic_load(g + i, __ATOMIC_RELAXED, __HIP_MEMORY_SCOPE_AGENT); ok &= ((unsigned)(x >> 32) == tag); s += __uint_as_float((unsigned)x); }
            if (ok) break;
            __builtin_amdgcn_s_sleep(1);
        }
        ep[128 + tid] = rsqrtf(s * (1.0f / 1024.0f) + EPS);
    }
    __syncthreads();
    float ss[16];
#pragma unroll
    for (int u = 0; u < 8; ++u) {
        const int mt = u >> 2, nt = u & 3;
        if (nt == 0) {
#pragma unroll
            for (int r = 0; r < 16; ++r) ss[r] = 0.f;
        }
        if (u + 1 < 8) ldx(u + 1, xs[(u + 1) & 1]);
        const int fmo = opq(fm), hio = opq(hi);
        const int col = col0 + wn * 128 + nt * 32 + fmo;
        const float g = gain[col];
        float* xp = xout + (size_t)(row0 + wm * 64 + mt * 32 + 4 * hio) * D + col;
        bf16_t* bp = xb + (size_t)(row0 + wm * 64 + mt * 32 + 4 * hio) * D + col;
#pragma unroll
        for (int g4 = 0; g4 < 4; ++g4) {
            const f32x4 rs4 = *(const f32x4*)(ep + 128 + wm * 64 + mt * 32 + 8 * g4 + 4 * hio);
#pragma unroll
            for (int i = 0; i < 4; ++i) {
                const int r = 4 * g4 + i, off = (8 * g4 + i) * D;
                const float xn = xs[u & 1][r] + v[mt][nt][r] * rs4[i] * g;
                xp[off] = xn; bp[off] = f2bf(xn); ss[r] += xn * xn;
            }
        }
        asm volatile("" ::: "memory");
        if (nt == 3) {
            const float tot = rowsum32(ss, lane);
            if ((lane & 1) == 0) part_next[(size_t)(row0 + wm * 64 + mt * 32 + crow((lane >> 1) & 15, hi)) * 16 + slot] = tot;
        }
    }
}

__device__ __forceinline__ void gbar(unsigned* ctr, unsigned& epoch, unsigned G) {
    asm volatile("s_waitcnt vmcnt(0)" ::: "memory");
    __syncthreads();
    epoch += 1u;
    if (threadIdx.x == 0) {
        __builtin_amdgcn_fence(__ATOMIC_RELEASE, "agent");
        asm volatile("s_waitcnt vmcnt(0)" ::: "memory");
        __hip_atomic_fetch_add(ctr, 1u, __ATOMIC_RELAXED, __HIP_MEMORY_SCOPE_AGENT);
        const unsigned target = epoch * G;
        while (__hip_atomic_load(ctr, __ATOMIC_RELAXED, __HIP_MEMORY_SCOPE_AGENT) < target) __builtin_amdgcn_s_sleep(1);
        __builtin_amdgcn_fence(__ATOMIC_ACQUIRE, "agent");
        asm volatile("s_waitcnt vmcnt(0)" ::: "memory");
    }
    __syncthreads();
}

#define LAS __attribute__((address_space(3)))
#define XB_TMO      128
#define XB_XCNT(j)  (256  + 64 * (j))
#define XB_XSUB(j)  (1280 + 64 * (j))
#define XB_XGEN(j)  (2304 + 64 * (j))
#define XB_TOP      3328
#define XB_TOPGEN   3392
#define XCD_BAR_WORDS 3456
#define XB_SPIN_CAP (1u << 22)
__device__ __forceinline__ unsigned xb_ld(unsigned* p)              { return __hip_atomic_load(p, __ATOMIC_RELAXED, __HIP_MEMORY_SCOPE_AGENT); }
__device__ __forceinline__ unsigned xb_add(unsigned* p, unsigned v) { return __hip_atomic_fetch_add(p, v, __ATOMIC_RELAXED, __HIP_MEMORY_SCOPE_AGENT); }
__device__ __forceinline__ unsigned xb_xcc_id() { return (unsigned)__builtin_amdgcn_s_getreg((3 << 11) | 20) & 0xFu; }
#define XB_SPIN(cond, bar) do { unsigned _sp = 0; while (cond) { __builtin_amdgcn_s_sleep(1); \
    if ((++_sp & 255u) == 0u) { if (xb_ld(&(bar)[XB_TMO])) break; if (_sp > XB_SPIN_CAP) { atomicAdd(&(bar)[XB_TMO], 1u); break; } } } } while (0)
struct XcdBarrier { unsigned* bar; unsigned x; volatile LAS unsigned* st; };
__device__ __forceinline__ XcdBarrier xcd_barrier_post(unsigned* bar, volatile LAS unsigned* st) {
    XcdBarrier b; b.bar = bar; b.x = xb_xcc_id(); b.st = st;
    if (threadIdx.x == 0) (void)xb_add(&bar[XB_XCNT(b.x)], 1u);
    return b;
}
__device__ __forceinline__ void xcd_barrier_complete(unsigned* bar, unsigned x, unsigned& nloc, unsigned& nx) {
    const unsigned G = gridDim.x * gridDim.y * gridDim.z;
    unsigned sum, cnt, mine, sp = 0u;
    for (;;) {
        sum = 0u; cnt = 0u; mine = 0u;
#pragma unroll
        for (unsigned j = 0; j < 16; ++j) { const unsigned c = xb_ld(&bar[XB_XCNT(j)]); sum += c; cnt += (c > 0u) ? 1u : 0u; mine = (j == x) ? c : mine; }
        if (sum == G) break;
        __builtin_amdgcn_s_sleep(1);
        if ((++sp & 255u) == 0u) { if (xb_ld(&bar[XB_TMO])) break; if (sp > XB_SPIN_CAP) { atomicAdd(&bar[XB_TMO], 1u); break; } }
    }
    nloc = mine > 0u ? mine : 1u; nx = cnt > 0u ? cnt : 1u;
}
__device__ __forceinline__ void xcd_barrier(const XcdBarrier& b) {
    asm volatile("s_waitcnt vmcnt(0)" ::: "memory");
    __syncthreads();
    if (threadIdx.x == 0) {
        unsigned* bar = b.bar;
        __builtin_amdgcn_s_waitcnt(0);
        unsigned nloc = b.st[0], nx = b.st[1];
        if (nloc == 0u) { xcd_barrier_complete(bar, b.x, nloc, nx); b.st[0] = nloc; b.st[1] = nx; }
        const unsigned old = xb_add(&bar[XB_XSUB(b.x)], 1u);
        const unsigned gen = old / nloc;
        if (old + 1u == (gen + 1u) * nloc) {
            __builtin_amdgcn_fence(__ATOMIC_RELEASE, "agent");
            asm volatile("s_waitcnt vmcnt(0)" ::: "memory");
            const unsigned og = xb_add(&bar[XB_TOP], 1u);
            const unsigned tg = og / nx;
            if (og + 1u == (tg + 1u) * nx) xb_add(&bar[XB_TOPGEN], 1u);
            else XB_SPIN(xb_ld(&bar[XB_TOPGEN]) == tg, bar);
            __builtin_amdgcn_fence(__ATOMIC_ACQUIRE, "agent");
            xb_add(&bar[XB_XGEN(b.x)], 1u);
            asm volatile("s_waitcnt vmcnt(0)" ::: "memory");
        } else {
            XB_SPIN(xb_ld(&bar[XB_XGEN(b.x)]) == gen, bar);
            __builtin_amdgcn_fence(__ATOMIC_ACQUIRE, "agent");
            asm volatile("s_waitcnt vmcnt(0)" ::: "memory");
        }
    }
    __syncthreads();
}

__global__ void __launch_bounds__(256, 2) mega(Params P) {
    extern __shared__ __attribute__((aligned(16))) unsigned char lds[];
    cg::grid_group grid = cg::this_grid();
    const int tid = threadIdx.x, lane = tid & 63, wave = __builtin_amdgcn_readfirstlane(tid >> 6), wm = wave >> 1, wn = wave & 1, fm = lane & 31, hi = lane >> 5;
    const int G = gridDim.x, vb = vblock();
    unsigned char* ws = P.ws;
    float* stat = (float*)(ws + WS_STAT);
    unsigned* cnts = (unsigned*)(ws + WS_CNT);
    float* cosT = (float*)(ws + WS_ROPE);
    float* sinT = cosT + S * 16;
    bf16_t* xb = (bf16_t*)(ws + WS_XB);
    bf16_t* mix = (bf16_t*)(ws + WS_MIX);
    bf16_t* ebuf = mix;
    bf16_t* zb = (bf16_t*)(ws + WS_Z);
    bf16_t* Qb = (bf16_t*)(ws + WS_Q);
    bf16_t* Kb = (bf16_t*)(ws + WS_K);
    bf16_t* Vt = (bf16_t*)(ws + WS_VT);
    bf16_t* ub = (bf16_t*)(ws + WS_U);
    float* xout = P.out;
    float* ep = (float*)(lds + EP_OFF);
    unsigned long long* gran = (unsigned long long*)(ws + WS_GRAN);
    unsigned* gctr = cnts + 4096;
    unsigned gepoch = 0u; (void)gepoch; (void)gctr;
    volatile LAS unsigned* xst = (volatile LAS unsigned*)((LAS unsigned char*)lds + XB_OFF);
    if (tid == 0) { xst[0] = 0u; xst[1] = 0u; }

    auto dump_bf = [&](const bf16_t* buf, int pitch) {
        grid.sync();
        for (int i = vb * 256 + tid; i < T * D; i += G * 256) { const int row = i >> 10, col = i & 1023; xout[i] = bf2f(buf[(size_t)row * pitch + col]); }
    };
    if (PHASES & 1) for (int rep = 0; rep < REPP; ++rep) {
        float* tl = (float*)lds;
        for (int t = vb; t < NL * 3336; t += G) {
            const int l = t / 3336; int r = t % 3336;
            const float* src; const float* gA = nullptr; const float* gB = nullptr; int K, N, Np; size_t off;
            if (r < 576) { src = P.in[3] + (size_t)l * 1024 * 2208; gA = P.in[2] + l * 1024; gB = gA + 512; K = 1024; N = 2208; Np = 2304; off = OW_IN; }
            else if ((r -= 576) < 72) { src = P.in[5] + (size_t)l * 384 * 768; gA = P.in[4] + l * 384; gB = gA + 512; K = 384; N = 768; Np = 768; off = OW_QB; }
            else if ((r -= 72) < 64) { src = P.in[7] + (size_t)l * 256 * 1024; gA = P.in[6] + l * 256; gB = gA + 512; K = 256; N = 1024; Np = 1024; off = OW_KVB; }
            else if ((r -= 64) < 256) { src = P.in[11] + (size_t)l * 1024 * 1024; gA = P.in[9] + l * 512; gB = P.in[10] + l * 512; K = 1024; N = 1024; Np = 1024; off = OW_OUT; }
            else if ((r -= 256) < 1024) { src = P.in[14] + (size_t)l * 1024 * 4096; gA = P.in[13] + l * 1024; gB = gA + 512; K = 1024; N = 4096; Np = 4096; off = OW_UP; }
            else if ((r -= 1024) < 1024) { src = P.in[15] + (size_t)l * 4096 * 1024; K = 4096; N = 1024; Np = 1024; off = OW_DOWN; }
            else if ((r -= 1024) < 256) { src = P.in[18] + (size_t)l * 1024 * 1024; gA = P.in[17] + l * 1024; gB = gA + 512; K = 1024; N = 1024; Np = 1024; off = OW_G; }
            else { r -= 256; src = P.in[19] + (size_t)l * 256 * 1024; K = 256; N = 1024; Np = 1024; off = OW_P; }
            bf16_t* dst = (bf16_t*)(ws + WS_W + (size_t)l * WL_BYTES + off);
            const int nct = Np / 64, k0 = (r / nct) * 64, n0 = (r % nct) * 64;
#pragma unroll
            for (int j = 0; j < 4; ++j) {
                const int kr = (tid >> 4) + 16 * j, n4 = (tid & 15) * 4, k = k0 + kr;
                f32x4 v = (f32x4){0.f, 0.f, 0.f, 0.f};
                if (n0 + n4 < N) v = *(const f32x4*)(src + (size_t)k * N + n0 + n4);
                float g = 1.f;
                if (gA) g = (k < 512) ? gA[k] : gB[k - 512];
                tl[kr * 65 + n4 + 0] = v[0] * g; tl[kr * 65 + n4 + 1] = v[1] * g; tl[kr * 65 + n4 + 2] = v[2] * g; tl[kr * 65 + n4 + 3] = v[3] * g;
            }
            __syncthreads();
            {
                const int n = tid >> 2, kq = (tid & 3) * 16;
                unsigned w[8];
#pragma unroll
                for (int i = 0; i < 8; ++i) w[i] = pk2(tl[(kq + 2 * i) * 65 + n], tl[(kq + 2 * i + 1) * 65 + n]);
                bf16_t* dp = dst + (size_t)(n0 + n) * K + k0 + kq;
                *(u32x4*)dp = (u32x4){w[0], w[1], w[2], w[3]};
                *(u32x4*)(dp + 8) = (u32x4){w[4], w[5], w[6], w[7]};
            }
            __syncthreads();
        }
        const float* x = P.in[0];
        for (int row = vb * 4 + wave; row < T; row += G * 4) {
            float ss = 0.f;
#pragma unroll
            for (int j = 0; j < 4; ++j) {
                const size_t idx = (size_t)row * D + j * 256 + lane * 4;
                const f32x4 v = *(const f32x4*)(x + idx);
                *(f32x4*)(xout + idx) = v;
                *(u32x2*)(xb + idx) = (u32x2){pk2(v[0], v[1]), pk2(v[2], v[3])};
                ss += v[0] * v[0] + v[1] * v[1] + v[2] * v[2] + v[3] * v[3];
            }
            ss += __shfl_xor(ss, 32); ss += __shfl_xor(ss, 16); ss += __shfl_xor(ss, 8); ss += __shfl_xor(ss, 4); ss += __shfl_xor(ss, 2); ss += __shfl_xor(ss, 1);
            if (lane < 16) stat[((size_t)ST_X0 * T + row) * 16 + lane] = (lane == 0) ? ss : 0.f;
        }
        for (int idx = vb * 256 + tid; idx < NL * 3 * 128; idx += G * 256) cnts[idx] = 0u;
        if (blockIdx.x == 0 && tid == 0) *gctr = 0u;
        for (int idx = vb * 256 + tid; idx < 3 * T * 16 / 2; idx += G * 256) ((u32x4*)gran)[idx] = (u32x4){0u, 0u, 0u, 0u};
        for (int idx = vb * 256 + tid; idx < XCD_BAR_WORDS; idx += G * 256) cnts[8192 + idx] = 0u;
        for (int idx = vb * 256 + tid; idx < S * 16; idx += G * 256) {
            const int s = idx >> 4, j = idx & 15;
            const double base = sqrt(sqrt(sqrt(sqrt(10000.0))));
            double pw = 1.0;
            for (int q = 0; q < j; ++q) pw *= base;
            const float pwf = (float)pw;
            const float inv_freq = 1.0f / pwf;
            const float angf = (float)s * inv_freq;
            const double a = (double)angf;
            const double n = rint(a * 0.15915494309189535);
            const double rr = a - n * 6.283185307179586;
            const double r2 = rr * rr;
            double sn = 0.0, term = rr;
            for (int k = 0; k < 16; ++k) { sn += term; term *= -r2 / (double)((2 * k + 2) * (2 * k + 3)); }
            double cs = 0.0; term = 1.0;
            for (int k = 0; k < 16; ++k) { cs += term; term *= -r2 / (double)((2 * k + 1) * (2 * k + 2)); }
            cosT[idx] = (float)cs; sinT[idx] = (float)sn;
        }
    }
    grid.sync();
    const XcdBarrier xbar = xcd_barrier_post(cnts + 8192, xst);

    for (int l = 0; l < NL; ++l) {
        const unsigned char* wl = ws + WS_W + (size_t)l * WL_BYTES;
        const bf16_t* WIN = (const bf16_t*)(wl + OW_IN);
        const bf16_t* WQB = (const bf16_t*)(wl + OW_QB);
        const bf16_t* WKVB = (const bf16_t*)(wl + OW_KVB);
        const bf16_t* WOUT = (const bf16_t*)(wl + OW_OUT);
        const bf16_t* WUP = (const bf16_t*)(wl + OW_UP);
        const bf16_t* WDOWN = (const bf16_t*)(wl + OW_DOWN);
        const bf16_t* WG = (const bf16_t*)(wl + OW_G);
        const bf16_t* WP = (const bf16_t*)(wl + OW_P);
        float* st = stat;

        if (PHASES & 2) for (int t = vb; t < 128 * 18; t += G) {
            const int tid = opq(threadIdx.x), lane = tid & 63, wave = __builtin_amdgcn_readfirstlane(tid >> 6), wm = wave >> 1, wn = wave & 1, fm = lane & 31, hi = lane >> 5; (void)wm; (void)wn; (void)fm; (void)hi; (void)wave; (void)lane;
            int panel = t / 18, ct = t % 18;
            if (G == 512) {
                const int i = t >> 9, q = vb & 63, x = vb >> 6;
                if (i < 4) { const int M = i * 8 + x; panel = (M >> 1) * 8 + (q >> 3); ct = (M & 1) * 8 + (q & 7); }
                else { const int u = t - 2048; panel = u >> 1; ct = 16 + (u & 1); }
            }
            const int row0 = panel * 128, col0 = ct * 128;
            if (tid < 128) ep[tid] = rsqrtf(sum_slots(st + ((size_t)ST_X0 * T + row0 + tid) * 16, 16) * (1.0f / 1024.0f) + EPS);
            f32x16 acc[2][2];
            gemm_mainloop<false>(xb + (size_t)row0 * D, D, WIN + (size_t)col0 * D, D, D, lds, acc);
#pragma unroll
            for (int mt = 0; mt < 2; ++mt) {
                float ss[16], rs[16];
#pragma unroll
                for (int r = 0; r < 16; ++r) { ss[r] = 0.f; rs[r] = ep[wm * 64 + mt * 32 + crow(r, hi)]; }
#pragma unroll
                for (int nt = 0; nt < 2; ++nt) {
                    const int col = col0 + wn * 64 + nt * 32 + fm;
#pragma unroll
                    for (int r = 0; r < 16; ++r) {
                        const float v = acc[mt][nt][r] * rs[r];
                        zb[(size_t)(row0 + wm * 64 + mt * 32 + crow(r, hi)) * ZW + col] = f2bf(v);
                        ss[r] += v * v;
                    }
                }
                if (ct < 5) {
                    const float tot = rowsum32(ss, lane);
                    float* pp = st + ((size_t)(ct < 3 ? ST_QA : ST_KVA) * T + row0 + wm * 64 + mt * 32 + crow((lane >> 1) & 15, hi)) * 16 + (ct < 3 ? ct : ct - 3) * 2 + wn;
                    if ((lane & 1) == 0) *pp = tot;
                }
            }
            __syncthreads();
        }
        xcd_barrier(xbar);

        if (STOP == 1) { dump_bf(zb, ZW); return; }
        if (PHASES & 4) for (int t = vb; t < 128 * 14; t += G) {
            const int tid = opq(threadIdx.x), lane = tid & 63, wave = __builtin_amdgcn_readfirstlane(tid >> 6), wm = wave >> 1, wn = wave & 1, fm = lane & 31, hi = lane >> 5; (void)wm; (void)wn; (void)fm; (void)hi; (void)wave; (void)lane;
            f32x16 acc[2][2];
            if (t < 128 * 6) {
                const int panel = t / 6, ct = t % 6, row0 = panel * 128, col0 = ct * 128;
                if (tid < 128) ep[tid] = rsqrtf(sum_slots(st + ((size_t)ST_QA * T + row0 + tid) * 16, 6) * (1.0f / 384.0f) + EPS);
                gemm_mainloop<false>(zb + (size_t)row0 * ZW, ZW, WQB + (size_t)col0 * 384, 384, 384, lds, acc);
#pragma unroll
                for (int mt = 0; mt < 2; ++mt) {
                    float rs[16];
#pragma unroll
                    for (int r = 0; r < 16; ++r) rs[r] = ep[wm * 64 + mt * 32 + crow(r, hi)] * QSCALE;
#pragma unroll
                    for (int nt = 0; nt < 2; ++nt) {
                        const int c32 = col0 + wn * 64 + nt * 32;
                        const int h = c32 / 96, dh = c32 % 96;
                        const bool rope = (dh == 64);
#pragma unroll
                        for (int r = 0; r < 16; ++r) {
                            const int row = row0 + wm * 64 + mt * 32 + crow(r, hi);
                            const int b = row >> 12, s = row & 4095;
                            float v = acc[mt][nt][r] * rs[r];
                            if (rope) {
                                const float pr = __shfl_xor(v, 16);
                                const float c = cosT[s * 16 + (fm & 15)], sn = sinT[s * 16 + (fm & 15)];
                                v = (fm < 16) ? (v * c - pr * sn) : (v * c + pr * sn);
                            }
                            Qb[((size_t)(b * NH + h) * S + s) * 96 + dh + fm] = f2bf(v);
                        }
                    }
                }
            } else {
                const int t2 = t - 128 * 6;
                const int panel = t2 / 8, ct = t2 % 8, row0 = panel * 128, col0 = ct * 128;
                if (tid < 128) ep[tid] = rsqrtf(sum_slots(st + ((size_t)ST_KVA * T + row0 + tid) * 16, 4) * (1.0f / 256.0f) + EPS);
                gemm_mainloop<false>(zb + (size_t)row0 * ZW + 384, ZW, WKVB + (size_t)col0 * 256, 256, 256, lds, acc);
                const int h = ct;
#pragma unroll
                for (int mt = 0; mt < 2; ++mt) {
                    float rs[16];
#pragma unroll
                    for (int r = 0; r < 16; ++r) rs[r] = ep[wm * 64 + mt * 32 + crow(r, hi)];
                    const int rbase = row0 + wm * 64 + mt * 32;
                    const int b = rbase >> 12;
#pragma unroll
                    for (int nt = 0; nt < 2; ++nt) {
                        const int d = nt * 32 + fm;
                        if (wn == 0) {
#pragma unroll
                            for (int r = 0; r < 16; ++r) {
                                const int s = (rbase + crow(r, hi)) & 4095;
                                Kb[((size_t)(b * NH + h) * S + s) * 96 + d] = f2bf(acc[mt][nt][r] * rs[r]);
                            }
                        } else {
#pragma unroll
                            for (int g = 0; g < 4; ++g) {
                                const int s = (rbase + 8 * g + 4 * hi) & 4095;
                                const u32x2 w = (u32x2){pk2(acc[mt][nt][4 * g] * rs[4 * g], acc[mt][nt][4 * g + 1] * rs[4 * g + 1]),
                                                         pk2(acc[mt][nt][4 * g + 2] * rs[4 * g + 2], acc[mt][nt][4 * g + 3] * rs[4 * g + 3])};
                                *(u32x2*)(Vt + ((size_t)(b * NH + h) * 64 + d) * S + s) = w;
                            }
                        }
                    }
                }
            }
            __syncthreads();
        }
        if (PHASES & 8) {
            const float* wc = P.in[8] + (size_t)l * 3 * 512;
            for (int row = vb * 4 + wave; row < T; row += G * 4) {
                const int tid = opq(threadIdx.x), lane = tid & 63, wave_ = 0, wm = 0, wn = 0, fm = lane & 31, hi = lane >> 5; (void)wm; (void)wn; (void)fm; (void)hi; (void)wave_; (void)lane;
                const int s = row & 4095, b = row >> 12;
                const bf16_t* zr = zb + (size_t)row * ZW;
                const int c0 = 8 * lane;
                const u32x4 gbv = *(const u32x4*)(zr + 672 + c0);
                const u32x4 gc1 = *(const u32x4*)(zr + 1184 + c0), ci1 = *(const u32x4*)(zr + 1696 + c0);
                u32x4 gc0 = (u32x4){0, 0, 0, 0}, ci0 = gc0, gc2 = gc0, ci2 = gc0;
                if (s > 0) { gc0 = *(const u32x4*)(zr - ZW + 1184 + c0); ci0 = *(const u32x4*)(zr - ZW + 1696 + c0); }
                if (s < S - 1) { gc2 = *(const u32x4*)(zr + ZW + 1184 + c0); ci2 = *(const u32x4*)(zr + ZW + 1696 + c0); }
                const f32x4 w0a = *(const f32x4*)(wc + c0), w0b = *(const f32x4*)(wc + c0 + 4);
                const f32x4 w1a = *(const f32x4*)(wc + 512 + c0), w1b = *(const f32x4*)(wc + 512 + c0 + 4);
                const f32x4 w2a = *(const f32x4*)(wc + 1024 + c0), w2b = *(const f32x4*)(wc + 1024 + c0 + 4);
                float cv[8]; float ss = 0.f;
#pragma unroll
                for (int i = 0; i < 4; ++i) {
                    const unsigned a0 = gc0[i], a1 = gc1[i], a2 = gc2[i], d0 = ci0[i], d1 = ci1[i], d2 = ci2[i], gw = gbv[i];
                    const float wlo0 = (i < 2) ? w0a[2 * i] : w0b[2 * i - 4], whi0 = (i < 2) ? w0a[2 * i + 1] : w0b[2 * i - 3];
                    const float wlo1 = (i < 2) ? w1a[2 * i] : w1b[2 * i - 4], whi1 = (i < 2) ? w1a[2 * i + 1] : w1b[2 * i - 3];
                    const float wlo2 = (i < 2) ? w2a[2 * i] : w2b[2 * i - 4], whi2 = (i < 2) ? w2a[2 * i + 1] : w2b[2 * i - 3];
                    const float lo = bflo(gw) * (wlo0 * bflo(a0) * bflo(d0) + wlo1 * bflo(a1) * bflo(d1) + wlo2 * bflo(a2) * bflo(d2));
                    const float hv = bfhi(gw) * (whi0 * bfhi(a0) * bfhi(d0) + whi1 * bfhi(a1) * bfhi(d1) + whi2 * bfhi(a2) * bfhi(d2));
                    cv[2 * i] = lo; cv[2 * i + 1] = hv; ss += lo * lo + hv * hv;
                }
                ss += __shfl_xor(ss, 1); ss += __shfl_xor(ss, 2); ss += __shfl_xor(ss, 4);
                const float rn = rsqrtf(ss * (1.0f / 64.0f) + EPS);
                *(u32x4*)(mix + (size_t)row * D + 512 + c0) = (u32x4){pk2(cv[0] * rn, cv[1] * rn), pk2(cv[2] * rn, cv[3] * rn), pk2(cv[4] * rn, cv[5] * rn), pk2(cv[6] * rn, cv[7] * rn)};
                if (lane < 16) {
                    const float a = bf2f(zr[640 + lane]), bb = bf2f(zr[656 + lane]);
                    const float c = cosT[s * 16 + lane], sn = sinT[s * 16 + lane];
                    const bf16_t o1 = f2bf(a * c - bb * sn), o2 = f2bf(bb * c + a * sn);
#pragma unroll
                    for (int h = 0; h < NH; ++h) {
                        bf16_t* kp = Kb + ((size_t)(b * NH + h) * S + s) * 96;
                        kp[64 + lane] = o1; kp[80 + lane] = o2;
                    }
                }
            }
        }
        xcd_barrier(xbar);

        if (STOP == 2) { dump_bf(Qb, 768); return; }
        if (STOP == 12) { dump_bf(Kb, 768); return; }
        if (STOP == 22) { dump_bf(Vt, 512); return; }
        if (STOP == 32) { dump_bf(mix, 1024); return; }
        if (PHASES & 16) for (int rep = 0; rep < REPA; ++rep) for (int it = vb; it < 32 * 16; it += G) {
            const int tid = opq(threadIdx.x), lane = tid & 63, wave = __builtin_amdgcn_readfirstlane(tid >> 6), fm = lane & 31, hi = lane >> 5;
            const int bh = it >> 4, qb = it & 15, b = bh >> 3, h = bh & 7;
            const bf16_t* Qp = Qb + ((size_t)bh * S + qb * 256 + wave * 64 + fm) * 96 + hi * 8;
            const bf16_t* Kp = Kb + (size_t)bh * S * 96;
            const bf16_t* Vp = Vt + (size_t)bh * 64 * S;
            bf16x8 qf[2][6];
#pragma unroll
            for (int u = 0; u < 2; ++u)
#pragma unroll
                for (int d0 = 0; d0 < 6; ++d0) qf[u][d0] = *(const bf16x8*)(Qp + (size_t)u * 32 * 96 + d0 * 16);
            f32x16 o[2][2];
#pragma unroll
            for (int u = 0; u < 2; ++u)
#pragma unroll
                for (int r = 0; r < 16; ++r) { o[u][0][r] = 0.f; o[u][1][r] = 0.f; }
            float mhat[2] = {0.f, 0.f}, lrun[2] = {0.f, 0.f};
            u32x4 kr[3], vr[2];
            const int pim = (fm & ~12) | ((fm & 4) << 1) | ((fm & 8) >> 1);
            const int koff = pim * KROW + hi * 16, voff = fm * VROW + hi * 16;
            auto loadkv = [&](int kv0) __attribute__((always_inline)) {
#pragma unroll
                for (int i = 0; i < 3; ++i) kr[i] = *(const u32x4*)(Kp + (size_t)kv0 * 96 + (tid + 256 * i) * 8);
#pragma unroll
                for (int i = 0; i < 2; ++i) { const int c = tid + 256 * i; vr[i] = *(const u32x4*)(Vp + (size_t)(c >> 3) * S + kv0 + (c & 7) * 8); }
            };
            auto storekv = [&](int buf) __attribute__((always_inline)) {
                unsigned char* kb = lds + buf * (KT_BYTES + VT_BYTES);
                unsigned char* vbp = kb + KT_BYTES;
#pragma unroll
                for (int i = 0; i < 3; ++i) { const int c = tid + 256 * i; *(u32x4*)(kb + (c / 12) * KROW + (c % 12) * 16) = kr[i]; }
#pragma unroll
                for (int i = 0; i < 2; ++i) { const int c = tid + 256 * i; *(u32x4*)(vbp + (c >> 3) * VROW + (c & 7) * 16) = vr[i]; }
            };
            loadkv(0); storekv(0); __syncthreads();
            for (int kt = 0; kt < 64; ++kt) {
                if (kt + 1 < 64) loadkv((kt + 1) * 64);
                __builtin_amdgcn_sched_barrier(0);
                const unsigned char* kb = lds + (kt & 1) * (KT_BYTES + VT_BYTES);
                const unsigned char* vbp = kb + KT_BYTES;
                f32x16 p[2][2];
#pragma unroll
                for (int d0 = 0; d0 < 6; ++d0) {
                    const bf16x8 k0 = *(const bf16x8*)(kb + koff + d0 * 32), k1 = *(const bf16x8*)(kb + koff + 32 * KROW + d0 * 32);
#pragma unroll
                    for (int u = 0; u < 2; ++u) {
                        if (d0 == 0) {
                            p[u][0] = __builtin_amdgcn_mfma_f32_32x32x16_bf16(k0, qf[u][0], (f32x16){0.f,0.f,0.f,0.f,0.f,0.f,0.f,0.f,0.f,0.f,0.f,0.f,0.f,0.f,0.f,0.f}, 0, 0, 0);
                            p[u][1] = __builtin_amdgcn_mfma_f32_32x32x16_bf16(k1, qf[u][0], (f32x16){0.f,0.f,0.f,0.f,0.f,0.f,0.f,0.f,0.f,0.f,0.f,0.f,0.f,0.f,0.f,0.f}, 0, 0, 0);
                        } else {
                            p[u][0] = __builtin_amdgcn_mfma_f32_32x32x16_bf16(k0, qf[u][d0], p[u][0], 0, 0, 0);
                            p[u][1] = __builtin_amdgcn_mfma_f32_32x32x16_bf16(k1, qf[u][d0], p[u][1], 0, 0, 0);
                        }
                    }
                }
#pragma unroll
                for (int u = 0; u < 2; ++u) {
                    float mx = p[u][0][0];
#pragma unroll
                    for (int r = 0; r < 16; ++r) mx = fmaxf(fmaxf(mx, p[u][0][r]), p[u][1][r]);
                    mx = fmaxf(mx, __shfl_xor(mx, 32));
                    if (kt == 0 || __any(mx - mhat[u] > 8.0f)) {
                        const float nm = (kt == 0) ? mx : fmaxf(mx, mhat[u]);
                        const float f = (kt == 0) ? 1.0f : __builtin_amdgcn_exp2f(mhat[u] - nm);
                        mhat[u] = nm; lrun[u] *= f;
#pragma unroll
                        for (int r = 0; r < 16; ++r) { o[u][0][r] *= f; o[u][1][r] *= f; }
                    }
                }
                auto soft = [&](int u, bf16x8 (&pfu)[4]) __attribute__((always_inline)) {
                    const float mh = mhat[u];
#pragma unroll
                    for (int r = 0; r < 16; ++r) { p[u][0][r] = __builtin_amdgcn_exp2f(p[u][0][r] - mh); p[u][1][r] = __builtin_amdgcn_exp2f(p[u][1][r] - mh); }
                    {
                        const f32x16 t = p[u][0] + p[u][1];
                        float rsum = ((t[0] + t[1]) + (t[2] + t[3])) + ((t[4] + t[5]) + (t[6] + t[7]));
                        rsum += ((t[8] + t[9]) + (t[10] + t[11])) + ((t[12] + t[13]) + (t[14] + t[15]));
                        lrun[u] += rsum;
                    }
#pragma unroll
                    for (int c = 0; c < 4; ++c) {
                        const int mt = c >> 1, r0 = (c & 1) * 8;
                        const u32x4 w = (u32x4){pk2(p[u][mt][r0], p[u][mt][r0 + 1]), pk2(p[u][mt][r0 + 2], p[u][mt][r0 + 3]), pk2(p[u][mt][r0 + 4], p[u][mt][r0 + 5]), pk2(p[u][mt][r0 + 6], p[u][mt][r0 + 7])};
                        pfu[c] = __builtin_bit_cast(bf16x8, w);
                    }
                };
                auto pvm = [&](int u, const bf16x8 (&pfu)[4]) __attribute__((always_inline)) {
#pragma unroll
                    for (int c = 0; c < 4; ++c) {
                        const bf16x8 v0 = *(const bf16x8*)(vbp + voff + c * 32), v1 = *(const bf16x8*)(vbp + voff + 32 * VROW + c * 32);
                        o[u][0] = __builtin_amdgcn_mfma_f32_32x32x16_bf16(v0, pfu[c], o[u][0], 0, 0, 0);
                        o[u][1] = __builtin_amdgcn_mfma_f32_32x32x16_bf16(v1, pfu[c], o[u][1], 0, 0, 0);
                    }
                };
                bf16x8 pfa[4], pfb[4];
                soft(0, pfa);
                pvm(0, pfa);
                soft(1, pfb);
#pragma unroll
                for (int i = 0; i < 8; ++i) { __builtin_amdgcn_sched_group_barrier(0x008, 1, 0); __builtin_amdgcn_sched_group_barrier(0x002, 10, 0); }
                pvm(1, pfb);
                if (kt + 1 < 64) storekv((kt + 1) & 1);
                __syncthreads();
            }
#pragma unroll
            for (int u = 0; u < 2; ++u) {
                const float ltot = lrun[u] + __shfl_xor(lrun[u], 32);
                const float inv = 1.0f / ltot;
                float ss = 0.f;
#pragma unroll
                for (int r = 0; r < 16; ++r) { o[u][0][r] *= inv; o[u][1][r] *= inv; ss += o[u][0][r] * o[u][0][r] + o[u][1][r] * o[u][1][r]; }
                ss += __shfl_xor(ss, 32);
                const float rn = rsqrtf(ss * (1.0f / 64.0f) + EPS);
                bf16_t* mp = mix + (size_t)(b * S + qb * 256 + wave * 64 + u * 32 + fm) * D + h * 64 + 4 * hi;
#pragma unroll
                for (int d0 = 0; d0 < 2; ++d0)
#pragma unroll
                    for (int g = 0; g < 4; ++g)
                        *(u32x2*)(mp + d0 * 32 + 8 * g) = (u32x2){pk2(o[u][d0][4 * g] * rn, o[u][d0][4 * g + 1] * rn), pk2(o[u][d0][4 * g + 2] * rn, o[u][d0][4 * g + 3] * rn)};
            }
        }
        xcd_barrier(xbar);

        if (STOP == 3) { dump_bf(mix, 1024); return; }
        if (PHASES & 32) for (int t = vb; t < 128 * 4; t += G) {
            const int panel = t >> 2, ct = t & 3, row0 = panel * 128, col0 = ct * 256;
            f32x16 acc[2][4];
            gemm_mainloop_w(mix + (size_t)row0 * D, D, WOUT + (size_t)col0 * D, D, D, lds, acc);
            exch_epilogue_w(acc, row0, col0, gran + (size_t)0 * T * 16, (unsigned)(l * 4 + 1), P.in[12] + l * D, xout, xb, st + (size_t)ST_X1 * T * 16, ep);
            __syncthreads();
        }
        xcd_barrier(xbar);

        if (STOP == 4) { return; }
        if (PHASES & 64) for (int t = vb; t < 2048 + 1024; t += G) {
            const int tid = opq(threadIdx.x), lane = tid & 63, wave = __builtin_amdgcn_readfirstlane(tid >> 6), wm = wave >> 1, wn = wave & 1, fm = lane & 31, hi = lane >> 5; (void)lane;
            if (t < 2048) {
                int panel = t >> 4, ct = t & 15;
                if (G == 512) { const int M = (t >> 9) * 8 + (vb >> 6), q = vb & 63; panel = (M >> 1) * 8 + (q >> 3); ct = (M & 1) * 8 + (q & 7); }
                const int row0 = panel * 128, col0 = ct * 256;
                if (tid < 128) ep[tid] = rsqrtf(sum_slots(st + ((size_t)ST_X1 * T + row0 + tid) * 16, 8) * (1.0f / 1024.0f) + EPS);
                f32x16 acc[2][4];
                gemm_mainloop_w(xb + (size_t)row0 * D, D, WUP + (size_t)col0 * D, D, D, lds, acc);
#pragma unroll
                for (int mt = 0; mt < 2; ++mt) {
                    float rs[16];
#pragma unroll
                    for (int r = 0; r < 16; ++r) rs[r] = ep[wm * 64 + mt * 32 + crow(r, hi)];
#pragma unroll
                    for (int nt = 0; nt < 4; ++nt) {
                        const int col = col0 + wn * 128 + nt * 32 + fm;
#pragma unroll
                        for (int r = 0; r < 16; ++r) {
                            const float v = fmaxf(acc[mt][nt][r] * rs[r], 0.f);
                            ub[(size_t)(row0 + wm * 64 + mt * 32 + crow(r, hi)) * FF + col] = f2bf(v * v);
                        }
                    }
                }
            } else {
                const int t2 = t - 2048;
                const int panel = t2 >> 3, ct = t2 & 7, row0 = panel * 128, col0 = ct * 128;
                f32x16 acc[2][2];
                gemm_mainloop<true>(P.in[1] + ((size_t)l * T + row0) * 256, 256, WP + (size_t)col0 * 256, 256, 256, lds, acc);
#pragma unroll
                for (int mt = 0; mt < 2; ++mt)
#pragma unroll
                    for (int nt = 0; nt < 2; ++nt) {
                        const int col = col0 + wn * 64 + nt * 32 + fm;
#pragma unroll
                        for (int r = 0; r < 16; ++r) ebuf[(size_t)(row0 + wm * 64 + mt * 32 + crow(r, hi)) * D + col] = f2bf(acc[mt][nt][r]);
                    }
            }
            __syncthreads();
        }
        xcd_barrier(xbar);

        if (STOP == 5) { dump_bf(ub, 4096); return; }
        if (STOP == 15) { dump_bf(ebuf, 1024); return; }
        if (PHASES & 128) for (int t = vb; t < 128 * 4; t += G) {
            const int panel = t >> 2, ct = t & 3, row0 = panel * 128, col0 = ct * 256;
            f32x16 acc[2][4];
            gemm_mainloop_w(ub + (size_t)row0 * FF, FF, WDOWN + (size_t)col0 * FF, FF, FF, lds, acc);
            exch_epilogue_w(acc, row0, col0, gran + (size_t)1 * T * 16, (unsigned)(l * 4 + 2), P.in[16] + l * D, xout, xb, st + (size_t)ST_X2 * T * 16, ep);
            __syncthreads();
        }
        xcd_barrier(xbar);

        if (STOP == 6) { return; }
        if (PHASES & 256) for (int t = vb; t < 128 * 8; t += G) {
            const int tid = opq(threadIdx.x), lane = tid & 63, wave = __builtin_amdgcn_readfirstlane(tid >> 6), wm = wave >> 1, wn = wave & 1, fm = lane & 31, hi = lane >> 5; (void)wm; (void)wn; (void)fm; (void)hi; (void)wave; (void)lane;
            const int panel = t >> 3, ct = t & 7, row0 = panel * 128, col0 = ct * 128;
            if (tid < 128) ep[tid] = rsqrtf(sum_slots(st + ((size_t)ST_X2 * T + row0 + tid) * 16, 8) * (1.0f / 1024.0f) + EPS);
            f32x16 acc[2][2];
            gemm_mainloop<false>(xb + (size_t)row0 * D, D, WG + (size_t)col0 * D, D, D, lds, acc);
#pragma unroll
            for (int mt = 0; mt < 2; ++mt) {
                float rs[16];
#pragma unroll
                for (int r = 0; r < 16; ++r) rs[r] = ep[wm * 64 + mt * 32 + crow(r, hi)];
#pragma unroll
                for (int nt = 0; nt < 2; ++nt) {
                    const int col = col0 + wn * 64 + nt * 32 + fm;
#pragma unroll
                    for (int r = 0; r < 16; ++r) {
                        const float gte = 1.0f / (1.0f + __expf(-acc[mt][nt][r] * rs[r]));
                        acc[mt][nt][r] = gte * bf2f(ebuf[(size_t)(row0 + wm * 64 + mt * 32 + crow(r, hi)) * D + col]);
                    }
                }
            }
            exch_epilogue(acc, row0, col0, gran + (size_t)2 * T * 16, (unsigned)(l * 4 + 3), P.in[20] + l * D, xout, xb, st + (size_t)ST_X0 * T * 16, ep);
            __syncthreads();
        }
        if (STOP == 7) return;
        if (l + 1 < NL) xcd_barrier(xbar);
    }
}

extern "C" void kernel_launch(void* const* d_in, const int* in_sizes, int n_in, void* d_out, int out_size, void* d_ws, size_t ws_size, hipStream_t stream) {
    static int grid = 0;
    if (grid == 0) {
        if (n_in != 21 || out_size != T * D || ws_size < WS_END) { fprintf(stderr, "kernel_launch: unexpected problem (n_in %d out %d ws %zu)\n", n_in, out_size, ws_size); grid = -1; return; }
        int dev = 0, cus = 0, per_cu = 0;
        hipGetDevice(&dev);
        hipDeviceGetAttribute(&cus, hipDeviceAttributeMultiprocessorCount, dev);
        if (hipFuncSetAttribute((const void*)mega, hipFuncAttributeMaxDynamicSharedMemorySize, LDS_BYTES) != hipSuccess) { fprintf(stderr, "hipFuncSetAttribute failed\n"); grid = -1; return; }
        if (hipOccupancyMaxActiveBlocksPerMultiprocessor(&per_cu, (const void*)mega, 256, LDS_BYTES) != hipSuccess || per_cu < 1) { fprintf(stderr, "occupancy query failed (%d)\n", per_cu); per_cu = 1; }
        if (per_cu > 2) per_cu = 2;
        grid = (cus * per_cu) & ~7;
        fprintf(stderr, "kernel_launch: cus %d per_cu %d grid %d\n", cus, per_cu, grid);
    }
    if (grid < 0) return;
    Params p{};
    for (int i = 0; i < 21; ++i) p.in[i] = (const float*)d_in[i];
    p.out = (float*)d_out; p.ws = (unsigned char*)d_ws;
    void* args[] = {&p};
    hipError_t e = hipLaunchCooperativeKernel((const void*)mega, dim3(grid), dim3(256), args, LDS_BYTES, stream);
    if (e != hipSuccess) fprintf(stderr, "cooperative launch failed: %s (grid %d)\n", hipGetErrorString(e), grid);
}
```

```cpp
#include <hip/hip_runtime.h>
#include <hip/hip_cooperative_groups.h>
#include <cstdio>
#include <cstdint>
namespace cg = cooperative_groups;

typedef unsigned short bf16_t;
typedef short bf16x8 __attribute__((ext_vector_type(8)));
typedef float f32x16 __attribute__((ext_vector_type(16)));
typedef float f32x4 __attribute__((ext_vector_type(4)));
typedef unsigned u32x4 __attribute__((ext_vector_type(4)));
typedef unsigned u32x2 __attribute__((ext_vector_type(2)));

constexpr int T = 16384, S = 4096, D = 1024, NL = 4, NH = 8, ZW = 2304, FF = 4096;
constexpr float EPS = 1e-6f;
constexpr float QSCALE = 0.10206207261596575f * 1.4426950408889634f;

constexpr size_t MiB = (size_t)1 << 20;
constexpr size_t WS_STAT = 0;
constexpr size_t WS_CNT = 8 * MiB;
constexpr size_t WS_ROPE = 9 * MiB;
constexpr size_t WS_W = 10 * MiB;
constexpr size_t WL_BYTES = 27328512;
constexpr size_t OW_IN = 0, OW_QB = 4718592, OW_KVB = 5308416, OW_OUT = 5832704, OW_UP = 7929856, OW_DOWN = 16318464, OW_G = 24707072, OW_P = 26804224;
constexpr size_t WS_XB = 115 * MiB;
constexpr size_t WS_MIX = 147 * MiB;
constexpr size_t WS_Z = 179 * MiB;
constexpr size_t WS_Q = 251 * MiB;
constexpr size_t WS_K = 275 * MiB;
constexpr size_t WS_VT = 299 * MiB;
constexpr size_t WS_U = 179 * MiB;
constexpr size_t WS_GRAN = 315 * MiB;
constexpr size_t WS_END = 321 * MiB;

enum { ST_X0 = 0, ST_QA = 1, ST_KVA = 2, ST_Y1 = 3, ST_X1 = 4, ST_F = 5, ST_X2 = 6, ST_T = 7 };

constexpr int LROW = 144;
constexpr int TILE_BYTES = 128 * LROW;
constexpr int EP_OFF = 4 * TILE_BYTES;
constexpr int XB_OFF = EP_OFF + 1024;
constexpr int LDS_BYTES = XB_OFF + 64;
constexpr int KROW = 208, VROW = 144;
constexpr int KT_BYTES = 64 * KROW, VT_BYTES = 64 * VROW;

#ifndef PHASES
#define PHASES 511
#endif
#ifndef REPG
#define REPG 1
#endif
#ifndef REPA
#define REPA 1
#endif
#ifndef REPP
#define REPP 1
#endif
#ifndef STOP
#define STOP 0
#endif
struct Params { const float* in[21]; float* out; unsigned char* ws; };

typedef float f32x2_t __attribute__((ext_vector_type(2)));
typedef __bf16 bf16x2_t __attribute__((ext_vector_type(2)));
__device__ __forceinline__ unsigned pk2(float lo, float hi) { const f32x2_t v = {lo, hi}; const bf16x2_t b = __builtin_convertvector(v, bf16x2_t); return __builtin_bit_cast(unsigned, b); }
__device__ __forceinline__ bf16_t f2bf(float f) { return (bf16_t)(pk2(f, 0.f) & 0xffffu); }
__device__ __forceinline__ float bf2f(bf16_t b) { return __uint_as_float(((unsigned)b) << 16); }
__device__ __forceinline__ float bflo(unsigned w) { return __uint_as_float(w << 16); }
__device__ __forceinline__ float bfhi(unsigned w) { return __uint_as_float(w & 0xffff0000u); }
__device__ __forceinline__ int opq(int v) { asm volatile("" : "+v"(v)); return v; }
__device__ __forceinline__ int crow(int r, int hi) { return (r & 3) + 8 * (r >> 2) + 4 * hi; }
__device__ __forceinline__ int vblock() { const int G = gridDim.x, b = blockIdx.x; return (G % 8 == 0) ? (b % 8) * (G / 8) + b / 8 : b; }
__device__ __forceinline__ void st_wt(float* p, float v) { __hip_atomic_store(p, v, __ATOMIC_RELAXED, __HIP_MEMORY_SCOPE_AGENT); }
__device__ __forceinline__ float atomic_ldf(const float* p) { return __hip_atomic_load(p, __ATOMIC_RELAXED, __HIP_MEMORY_SCOPE_AGENT); }
__device__ __forceinline__ float sum_slots(const float* p, int nslot) {
    const f32x4* q = (const f32x4*)p; float s = 0.f;
    for (int i = 0; i < (nslot >> 2); ++i) { const f32x4 a = q[i]; s += (a[0] + a[1]) + (a[2] + a[3]); }
    for (int i = nslot & ~3; i < nslot; ++i) s += p[i];
    return s;
}

__device__ __forceinline__ float rowsum32(const float (&s)[16], int lane) {
    const bool b4 = lane & 16, b3 = lane & 8, b2 = lane & 4, b1 = lane & 2;
    float a[8], b[4], c[2], d;
#pragma unroll
    for (int i = 0; i < 8; ++i) { const float keep = b4 ? s[8 + i] : s[i], send = b4 ? s[i] : s[8 + i]; a[i] = keep + __shfl_xor(send, 16); }
#pragma unroll
    for (int i = 0; i < 4; ++i) { const float keep = b3 ? a[4 + i] : a[i], send = b3 ? a[i] : a[4 + i]; b[i] = keep + __shfl_xor(send, 8); }
#pragma unroll
    for (int i = 0; i < 2; ++i) { const float keep = b2 ? b[2 + i] : b[i], send = b2 ? b[i] : b[2 + i]; c[i] = keep + __shfl_xor(send, 4); }
    { const float keep = b1 ? c[1] : c[0], send = b1 ? c[0] : c[1]; d = keep + __shfl_xor(send, 2); }
    d += __shfl_xor(d, 1);
    return d;
}

template <bool AF32>
__device__ __forceinline__ void gemm_mainloop(const void* __restrict__ Ap, int lda, const bf16_t* __restrict__ Bt, int ldb, int K,
                                              unsigned char* smem, f32x16 (&acc)[2][2]) {
    const int tid = opq(threadIdx.x), lane = tid & 63, wave = __builtin_amdgcn_readfirstlane(tid >> 6), wm = wave >> 1, wn = wave & 1, fm = lane & 31, hi = lane >> 5;
    const int srow = tid >> 3, skc = tid & 7;
    u32x4 ra0[4], rb0[4], ra1[4], rb1[4];
    u32x4 rx0[AF32 ? 4 : 1], rx1[AF32 ? 4 : 1];
#pragma unroll
    for (int i = 0; i < 2; ++i)
#pragma unroll
        for (int j = 0; j < 2; ++j)
#pragma unroll
            for (int r = 0; r < 16; ++r) acc[i][j][r] = 0.f;
    const int aoff = (wm * 64 + fm) * LROW + hi * 16, boff = (wn * 64 + fm) * LROW + hi * 16;
    const int soff = srow * LROW + skc * 16;
    const unsigned la = (unsigned)(srow * lda + skc * 8), lb = (unsigned)(srow * ldb + skc * 8);
    auto loadt = [&](int k0, u32x4 (&ra)[4], u32x4 (&rx)[AF32 ? 4 : 1], u32x4 (&rb)[4]) __attribute__((always_inline)) {
#pragma unroll
        for (int i = 0; i < 4; ++i) {
            if (AF32) {
                const float* ap = (const float*)Ap + (size_t)(32 * i) * lda + k0;
                ra[i] = *(const u32x4*)(ap + la); rx[i] = *(const u32x4*)(ap + la + 4);
            } else {
                const bf16_t* ap = (const bf16_t*)Ap + (size_t)(32 * i) * lda + k0;
                ra[i] = *(const u32x4*)(ap + la);
            }
            const bf16_t* bp = Bt + (size_t)(32 * i) * ldb + k0;
            rb[i] = *(const u32x4*)(bp + lb);
        }
    };
    auto storet = [&](int buf, const u32x4 (&ra)[4], const u32x4 (&rx)[AF32 ? 4 : 1], const u32x4 (&rb)[4]) __attribute__((always_inline)) {
        unsigned char* a = smem + buf * 2 * TILE_BYTES;
        unsigned char* b = a + TILE_BYTES;
#pragma unroll
        for (int i = 0; i < 4; ++i) {
            u32x4 av = ra[i];
            if (AF32) av = (u32x4){pk2(__uint_as_float(ra[i][0]), __uint_as_float(ra[i][1])), pk2(__uint_as_float(ra[i][2]), __uint_as_float(ra[i][3])),
                                   pk2(__uint_as_float(rx[i][0]), __uint_as_float(rx[i][1])), pk2(__uint_as_float(rx[i][2]), __uint_as_float(rx[i][3]))};
            *(u32x4*)(a + soff + i * 32 * LROW) = av; *(u32x4*)(b + soff + i * 32 * LROW) = rb[i];
        }
    };
    auto compute = [&](int buf) __attribute__((always_inline)) {
        const unsigned char* a = smem + buf * 2 * TILE_BYTES;
        const unsigned char* b = a + TILE_BYTES;
        __builtin_amdgcn_s_setprio(1);
#pragma unroll
        for (int kk = 0; kk < 4; ++kk) {
            const bf16x8 a0 = *(const bf16x8*)(a + aoff + kk * 32), a1 = *(const bf16x8*)(a + aoff + 32 * LROW + kk * 32);
            const bf16x8 b0 = *(const bf16x8*)(b + boff + kk * 32), b1 = *(const bf16x8*)(b + boff + 32 * LROW + kk * 32);
            acc[0][0] = __builtin_amdgcn_mfma_f32_32x32x16_bf16(a0, b0, acc[0][0], 0, 0, 0);
            acc[0][1] = __builtin_amdgcn_mfma_f32_32x32x16_bf16(a0, b1, acc[0][1], 0, 0, 0);
            acc[1][0] = __builtin_amdgcn_mfma_f32_32x32x16_bf16(a1, b0, acc[1][0], 0, 0, 0);
            acc[1][1] = __builtin_amdgcn_mfma_f32_32x32x16_bf16(a1, b1, acc[1][1], 0, 0, 0);
        }
        __builtin_amdgcn_s_setprio(0);
    };
    const int nk = K >> 6;
    for (int rep = 0; rep < REPG; ++rep) {
    if (rep) {
#pragma unroll
        for (int i = 0; i < 2; ++i)
#pragma unroll
            for (int j = 0; j < 2; ++j)
#pragma unroll
                for (int r = 0; r < 16; ++r) acc[i][j][r] = 0.f;
    }
    loadt(0, ra0, rx0, rb0);
    if (nk > 1) loadt(64, ra1, rx1, rb1);
    storet(0, ra0, rx0, rb0); __syncthreads();
    for (int kt = 0; kt < nk; kt += 2) {
        if (kt + 2 < nk) loadt((kt + 2) << 6, ra0, rx0, rb0);
        __builtin_amdgcn_sched_barrier(0);
        compute(0);
        if (kt + 1 < nk) storet(1, ra1, rx1, rb1);
        __syncthreads();
        if (kt + 1 < nk) {
            if (kt + 3 < nk) loadt((kt + 3) << 6, ra1, rx1, rb1);
            __builtin_amdgcn_sched_barrier(0);
            compute(1);
            if (kt + 2 < nk) storet(0, ra0, rx0, rb0);
            __syncthreads();
        }
    }
    }
}

constexpr int LROW2 = 80;
constexpr int A2_BYTES = 128 * LROW2, B2_BYTES = 256 * LROW2, STAGE2 = A2_BYTES + B2_BYTES;
__device__ __forceinline__ void gemm_mainloop_w(const bf16_t* __restrict__ Ap, int lda, const bf16_t* __restrict__ Bt, int ldb, int K,
                                                unsigned char* smem, f32x16 (&acc)[2][4]) {
    const int tid = opq(threadIdx.x), lane = tid & 63, wave = __builtin_amdgcn_readfirstlane(tid >> 6), wm = wave >> 1, wn = wave & 1, fm = lane & 31, hi = lane >> 5;
    const int srow = tid >> 2, skc = tid & 3;
    u32x4 ra0[2], rb0[4], ra1[2], rb1[4];
#pragma unroll
    for (int i = 0; i < 2; ++i)
#pragma unroll
        for (int j = 0; j < 4; ++j)
#pragma unroll
            for (int r = 0; r < 16; ++r) acc[i][j][r] = 0.f;
    const int aoff = (wm * 64 + fm) * LROW2 + hi * 16, boff = A2_BYTES + (wn * 128 + fm) * LROW2 + hi * 16;
    const int soff = srow * LROW2 + skc * 16;
    const unsigned la = (unsigned)(srow * lda + skc * 8), lb = (unsigned)(srow * ldb + skc * 8);
    auto loadt = [&](int k0, u32x4 (&ra)[2], u32x4 (&rb)[4]) __attribute__((always_inline)) {
#pragma unroll
        for (int i = 0; i < 2; ++i) { const bf16_t* ap = Ap + (size_t)(64 * i) * lda + k0; ra[i] = *(const u32x4*)(ap + la); }
#pragma unroll
        for (int i = 0; i < 4; ++i) { const bf16_t* bp = Bt + (size_t)(64 * i) * ldb + k0; rb[i] = *(const u32x4*)(bp + lb); }
    };
    auto storet = [&](int buf, const u32x4 (&ra)[2], const u32x4 (&rb)[4]) __attribute__((always_inline)) {
        unsigned char* a = smem + buf * STAGE2;
#pragma unroll
        for (int i = 0; i < 2; ++i) *(u32x4*)(a + soff + i * 64 * LROW2) = ra[i];
#pragma unroll
        for (int i = 0; i < 4; ++i) *(u32x4*)(a + A2_BYTES + soff + i * 64 * LROW2) = rb[i];
    };
    auto compute = [&](int buf) __attribute__((always_inline)) {
        const unsigned char* s = smem + buf * STAGE2;
        bf16x8 a[2][2], b[2][4];
#pragma unroll
        for (int kk = 0; kk < 2; ++kk) {
            a[kk][0] = *(const bf16x8*)(s + aoff + kk * 32); a[kk][1] = *(const bf16x8*)(s + aoff + 32 * LROW2 + kk * 32);
#pragma unroll
            for (int nt = 0; nt < 4; ++nt) b[kk][nt] = *(const bf16x8*)(s + boff + nt * 32 * LROW2 + kk * 32);
        }
        __builtin_amdgcn_sched_barrier(0);
        __builtin_amdgcn_s_setprio(1);
#pragma unroll
        for (int kk = 0; kk < 2; ++kk)
#pragma unroll
            for (int nt = 0; nt < 4; ++nt) {
                acc[0][nt] = __builtin_amdgcn_mfma_f32_32x32x16_bf16(a[kk][0], b[kk][nt], acc[0][nt], 0, 0, 0);
                acc[1][nt] = __builtin_amdgcn_mfma_f32_32x32x16_bf16(a[kk][1], b[kk][nt], acc[1][nt], 0, 0, 0);
            }
        __builtin_amdgcn_s_setprio(0);
    };
    const int nk = K >> 5;
    loadt(0, ra0, rb0);
    if (nk > 1) loadt(32, ra1, rb1);
    storet(0, ra0, rb0); __syncthreads();
    for (int kt = 0; kt < nk; kt += 2) {
        if (kt + 2 < nk) loadt((kt + 2) << 5, ra0, rb0);
        __builtin_amdgcn_sched_barrier(0);
        compute(0);
        if (kt + 1 < nk) storet(1, ra1, rb1);
        __syncthreads();
        if (kt + 1 < nk) {
            if (kt + 3 < nk) loadt((kt + 3) << 5, ra1, rb1);
            __builtin_amdgcn_sched_barrier(0);
            compute(1);
            if (kt + 2 < nk) storet(0, ra0, rb0);
            __syncthreads();
        }
    }
}

__device__ __forceinline__ void exch_epilogue(f32x16 (&v)[2][2], int row0, int col0, unsigned long long* gran, unsigned tag, const float* __restrict__ gain,
                                              float* xout, bf16_t* xb, float* part_next, float* ep) {
    const int tid = opq(threadIdx.x), lane = tid & 63, wave = __builtin_amdgcn_readfirstlane(tid >> 6), wm = wave >> 1, wn = wave & 1, fm = lane & 31, hi = lane >> 5;
    const int slot = (col0 >> 7) * 2 + wn;
    float xo[2][2][16];
#pragma unroll
    for (int mt = 0; mt < 2; ++mt)
#pragma unroll
        for (int nt = 0; nt < 2; ++nt) {
            const bf16_t* xp = xb + (size_t)(row0 + wm * 64 + mt * 32 + 4 * hi) * D + col0 + wn * 64 + nt * 32 + fm;
#pragma unroll
            for (int r = 0; r < 16; ++r) xo[mt][nt][r] = bf2f(xp[((r & 3) + 8 * (r >> 2)) * D]);
        }
#pragma unroll
    for (int mt = 0; mt < 2; ++mt) {
        float ss[16];
#pragma unroll
        for (int r = 0; r < 16; ++r) ss[r] = v[mt][0][r] * v[mt][0][r] + v[mt][1][r] * v[mt][1][r];
        const float tot = rowsum32(ss, lane);
        if ((lane & 1) == 0) __hip_atomic_store(gran + (size_t)(row0 + wm * 64 + mt * 32 + crow((lane >> 1) & 15, hi)) * 16 + slot, ((unsigned long long)tag << 32) | (unsigned long long)__float_as_uint(tot), __ATOMIC_RELAXED, __HIP_MEMORY_SCOPE_AGENT);
    }
    if (tid < 128) {
        const unsigned long long* g = gran + (size_t)(row0 + tid) * 16;
        float s;
        for (;;) {
            s = 0.f; bool ok = true;
#pragma unroll
            for (int i = 0; i < 16; ++i) { const unsigned long long x = __hip_atomic_load(g + i, __ATOMIC_RELAXED, __HIP_MEMORY_SCOPE_AGENT); ok &= ((unsigned)(x >> 32) == tag); s += __uint_as_float((unsigned)x); }
            if (ok) break;
            __builtin_amdgcn_s_sleep(1);
        }
        ep[128 + tid] = rsqrtf(s * (1.0f / 1024.0f) + EPS);
    }
    __syncthreads();
#pragma unroll
    for (int mt = 0; mt < 2; ++mt) {
        float ss[16], rs[16];
#pragma unroll
        for (int r = 0; r < 16; ++r) { ss[r] = 0.f; rs[r] = ep[128 + wm * 64 + mt * 32 + crow(r, hi)]; }
#pragma unroll
        for (int nt = 0; nt < 2; ++nt) {
            const int col = col0 + wn * 64 + nt * 32 + fm;
            const float g = gain[col];
            float* xp = xout + (size_t)(row0 + wm * 64 + mt * 32 + 4 * hi) * D + col;
            bf16_t* bp = xb + (size_t)(row0 + wm * 64 + mt * 32 + 4 * hi) * D + col;
#pragma unroll
            for (int g4 = 0; g4 < 4; ++g4) {
#pragma unroll
                for (int i = 0; i < 4; ++i) {
                    const int r = 4 * g4 + i, off = (8 * g4 + i) * D;
                    const float xf = xo[mt][nt][r] + v[mt][nt][r] * rs[r] * g;
                    const bf16_t xq = f2bf(xf);
                    const float xn = bf2f(xq);
                    bp[off] = xq; if (xout) xp[off] = xf; ss[r] += xn * xn;
                }
                asm volatile("" ::: "memory");
            }
        }
        const float tot = rowsum32(ss, lane);
        if ((lane & 1) == 0) part_next[(size_t)(row0 + wm * 64 + mt * 32 + crow((lane >> 1) & 15, hi)) * 16 + slot] = tot;
    }
}

__device__ __forceinline__ void exch_epilogue_w(f32x16 (&v)[2][4], int row0, int col0, unsigned long long* gran, unsigned tag, const float* __restrict__ gain,
                                                float* xout, bf16_t* xb, float* part_next, float* ep) {
    const int tid = opq(threadIdx.x), lane = tid & 63, wave = __builtin_amdgcn_readfirstlane(tid >> 6), wm = wave >> 1, wn = wave & 1, fm = lane & 31, hi = lane >> 5;
    const int slot = (col0 >> 8) * 2 + wn;
    float xs[2][16];
    auto ldx = [&](int u, float (&x)[16]) __attribute__((always_inline)) {
        const int lo = opq((4 * hi) * D + fm);
        const bf16_t* xp = xb + (size_t)(row0 + wm * 64 + (u >> 2) * 32) * D + col0 + wn * 128 + (u & 3) * 32 + lo;
#pragma unroll
        for (int r = 0; r < 16; ++r) x[r] = bf2f(xp[((r & 3) + 8 * (r >> 2)) * D]);
    };
    ldx(0, xs[0]);
#pragma unroll
    for (int mt = 0; mt < 2; ++mt) {
        float ss[16];
#pragma unroll
        for (int r = 0; r < 16; ++r) ss[r] = (v[mt][0][r] * v[mt][0][r] + v[mt][1][r] * v[mt][1][r]) + (v[mt][2][r] * v[mt][2][r] + v[mt][3][r] * v[mt][3][r]);
        const float tot = rowsum32(ss, lane);
        if ((lane & 1) == 0) __hip_atomic_store(gran + (size_t)(row0 + wm * 64 + mt * 32 + crow((lane >> 1) & 15, hi)) * 16 + slot, ((unsigned long long)tag << 32) | (unsigned long long)__float_as_uint(tot), __ATOMIC_RELAXED, __HIP_MEMORY_SCOPE_AGENT);
    }
    if (tid < 128) {
        const unsigned long long* g = gran + (size_t)(row0 + tid) * 16;
        float s;
        for (;;) {
            s = 0.f; bool ok = true;
#pragma unroll
            for (int i = 0; i < 8; ++i) { const unsigned long long x = __hip_atomic_load(g + i, __ATOMIC_RELAXED, __HIP_MEMORY_SCOPE_AGENT); ok &= ((unsigned)(x >> 32) == tag); s += __uint_as_float((unsigned)x); }
            if (ok) break;
            __builtin_amdgcn_s_sleep(1);
        }
        ep[128 + tid] = rsqrtf(s * (1.0f / 1024.0f) + EPS);
    }
    __syncthreads();
    float ss[16];
#pragma unroll
    for (int u = 0; u < 8; ++u) {
        const int mt = u >> 2, nt = u & 3;
        if (nt == 0) {
#pragma unroll
            for (int r = 0; r < 16; ++r) ss[r] = 0.f;
        }
        if (u + 1 < 8) ldx(u + 1, xs[(u + 1) & 1]);
        const int fmo = opq(fm), hio = opq(hi);
        const int col = col0 + wn * 128 + nt * 32 + fmo;
        const float g = gain[col];
        bf16_t* bp = xb + (size_t)(row0 + wm * 64 + mt * 32 + 4 * hio) * D + col;
#pragma unroll
        for (int g4 = 0; g4 < 4; ++g4) {
            const f32x4 rs4 = *(const f32x4*)(ep + 128 + wm * 64 + mt * 32 + 8 * g4 + 4 * hio);
#pragma unroll
            for (int i = 0; i < 4; ++i) {
                const int r = 4 * g4 + i, off = (8 * g4 + i) * D;
                const bf16_t xq = f2bf(xs[u & 1][r] + v[mt][nt][r] * rs4[i] * g);
                const float xn = bf2f(xq);
                bp[off] = xq; ss[r] += xn * xn;
            }
        }
        asm volatile("" ::: "memory");
        if (nt == 3) {
            const float tot = rowsum32(ss, lane);
            if ((lane & 1) == 0) part_next[(size_t)(row0 + wm * 64 + mt * 32 + crow((lane >> 1) & 15, hi)) * 16 + slot] = tot;
        }
    }
}

__device__ __forceinline__ void gbar(unsigned* ctr, unsigned& epoch, unsigned G) {
    asm volatile("s_waitcnt vmcnt(0)" ::: "memory");
    __syncthreads();
    epoch += 1u;
    if (threadIdx.x == 0) {
        __builtin_amdgcn_fence(__ATOMIC_RELEASE, "agent");
        asm volatile("s_waitcnt vmcnt(0)" ::: "memory");
        __hip_atomic_fetch_add(ctr, 1u, __ATOMIC_RELAXED, __HIP_MEMORY_SCOPE_AGENT);
        const unsigned target = epoch * G;
        while (__hip_atomic_load(ctr, __ATOMIC_RELAXED, __HIP_MEMORY_SCOPE_AGENT) < target) __builtin_amdgcn_s_sleep(1);
        __builtin_amdgcn_fence(__ATOMIC_ACQUIRE, "agent");
        asm volatile("s_waitcnt vmcnt(0)" ::: "memory");
    }
    __syncthreads();
}

#define LAS __attribute__((address_space(3)))
#define XB_TMO      128
#define XB_XCNT(j)  (256  + 64 * (j))
#define XB_XSUB(j)  (1280 + 64 * (j))
#define XB_XGEN(j)  (2304 + 64 * (j))
#define XB_TOP      3328
#define XB_TOPGEN   3392
#define XCD_BAR_WORDS 3456
#define XB_SPIN_CAP (1u << 22)
__device__ __forceinline__ unsigned xb_ld(unsigned* p)              { return __hip_atomic_load(p, __ATOMIC_RELAXED, __HIP_MEMORY_SCOPE_AGENT); }
__device__ __forceinline__ unsigned xb_add(unsigned* p, unsigned v) { return __hip_atomic_fetch_add(p, v, __ATOMIC_RELAXED, __HIP_MEMORY_SCOPE_AGENT); }
__device__ __forceinline__ unsigned xb_xcc_id() { return (unsigned)__builtin_amdgcn_s_getreg((3 << 11) | 20) & 0xFu; }
#define XB_SPIN(cond, bar) do { unsigned _sp = 0; while (cond) { __builtin_amdgcn_s_sleep(1); \
    if ((++_sp & 255u) == 0u) { if (xb_ld(&(bar)[XB_TMO])) break; if (_sp > XB_SPIN_CAP) { atomicAdd(&(bar)[XB_TMO], 1u); break; } } } } while (0)
struct XcdBarrier { unsigned* bar; unsigned x; volatile LAS unsigned* st; };
__device__ __forceinline__ XcdBarrier xcd_barrier_post(unsigned* bar, volatile LAS unsigned* st) {
    XcdBarrier b; b.bar = bar; b.x = xb_xcc_id(); b.st = st;
    if (threadIdx.x == 0) (void)xb_add(&bar[XB_XCNT(b.x)], 1u);
    return b;
}
__device__ __forceinline__ void xcd_barrier_complete(unsigned* bar, unsigned x, unsigned& nloc, unsigned& nx) {
    const unsigned G = gridDim.x * gridDim.y * gridDim.z;
    unsigned sum, cnt, mine, sp = 0u;
    for (;;) {
        sum = 0u; cnt = 0u; mine = 0u;
#pragma unroll
        for (unsigned j = 0; j < 16; ++j) { const unsigned c = xb_ld(&bar[XB_XCNT(j)]); sum += c; cnt += (c > 0u) ? 1u : 0u; mine = (j == x) ? c : mine; }
        if (sum == G) break;
        __builtin_amdgcn_s_sleep(1);
        if ((++sp & 255u) == 0u) { if (xb_ld(&bar[XB_TMO])) break; if (sp > XB_SPIN_CAP) { atomicAdd(&bar[XB_TMO], 1u); break; } }
    }
    nloc = mine > 0u ? mine : 1u; nx = cnt > 0u ? cnt : 1u;
}
__device__ __forceinline__ void xcd_barrier(const XcdBarrier& b) {
    asm volatile("s_waitcnt vmcnt(0)" ::: "memory");
    __syncthreads();
    if (threadIdx.x == 0) {
        unsigned* bar = b.bar;
        __builtin_amdgcn_s_waitcnt(0);
        unsigned nloc = b.st[0], nx = b.st[1];
        if (nloc == 0u) { xcd_barrier_complete(bar, b.x, nloc, nx); b.st[0] = nloc; b.st[1] = nx; }
        const unsigned old = xb_add(&bar[XB_XSUB(b.x)], 1u);
        const unsigned gen = old / nloc;
        if (old + 1u == (gen + 1u) * nloc) {
            __builtin_amdgcn_fence(__ATOMIC_RELEASE, "agent");
            asm volatile("s_waitcnt vmcnt(0)" ::: "memory");
            const unsigned og = xb_add(&bar[XB_TOP], 1u);
            const unsigned tg = og / nx;
            if (og + 1u == (tg + 1u) * nx) xb_add(&bar[XB_TOPGEN], 1u);
            else XB_SPIN(xb_ld(&bar[XB_TOPGEN]) == tg, bar);
            __builtin_amdgcn_fence(__ATOMIC_ACQUIRE, "agent");
            xb_add(&bar[XB_XGEN(b.x)], 1u);
            asm volatile("s_waitcnt vmcnt(0)" ::: "memory");
        } else {
            XB_SPIN(xb_ld(&bar[XB_XGEN(b.x)]) == gen, bar);
            __builtin_amdgcn_fence(__ATOMIC_ACQUIRE, "agent");
            asm volatile("s_waitcnt vmcnt(0)" ::: "memory");
        }
    }
    __syncthreads();
}

__global__ void __launch_bounds__(256, 2) mega(Params P) {
    extern __shared__ __attribute__((aligned(16))) unsigned char lds[];
    cg::grid_group grid = cg::this_grid();
    const int tid = threadIdx.x, lane = tid & 63, wave = __builtin_amdgcn_readfirstlane(tid >> 6), wm = wave >> 1, wn = wave & 1, fm = lane & 31, hi = lane >> 5;
    const int G = gridDim.x, vb = vblock();
    unsigned char* ws = P.ws;
    float* stat = (float*)(ws + WS_STAT);
    unsigned* cnts = (unsigned*)(ws + WS_CNT);
    float* cosT = (float*)(ws + WS_ROPE);
    float* sinT = cosT + S * 16;
    bf16_t* xb = (bf16_t*)(ws + WS_XB);
    bf16_t* mix = (bf16_t*)(ws + WS_MIX);
    bf16_t* ebuf = mix;
    bf16_t* zb = (bf16_t*)(ws + WS_Z);
    bf16_t* Qb = (bf16_t*)(ws + WS_Q);
    bf16_t* Kb = (bf16_t*)(ws + WS_K);
    bf16_t* Vt = (bf16_t*)(ws + WS_VT);
    bf16_t* ub = (bf16_t*)(ws + WS_U);
    float* xout = P.out;
    float* ep = (float*)(lds + EP_OFF);
    unsigned long long* gran = (unsigned long long*)(ws + WS_GRAN);
    unsigned* gctr = cnts + 4096;
    unsigned gepoch = 0u; (void)gepoch; (void)gctr;
    volatile LAS unsigned* xst = (volatile LAS unsigned*)((LAS unsigned char*)lds + XB_OFF);
    if (tid == 0) { xst[0] = 0u; xst[1] = 0u; }

    auto dump_bf = [&](const bf16_t* buf, int pitch) {
        grid.sync();
        for (int i = vb * 256 + tid; i < T * D; i += G * 256) { const int row = i >> 10, col = i & 1023; xout[i] = bf2f(buf[(size_t)row * pitch + col]); }
    };
    if (PHASES & 1) for (int rep = 0; rep < REPP; ++rep) {
        float* tl = (float*)lds;
        for (int t = vb; t < NL * 3336; t += G) {
            const int l = t / 3336; int r = t % 3336;
            const float* src; const float* gA = nullptr; const float* gB = nullptr; int K, N, Np; size_t off;
            if (r < 576) { src = P.in[3] + (size_t)l * 1024 * 2208; gA = P.in[2] + l * 1024; gB = gA + 512; K = 1024; N = 2208; Np = 2304; off = OW_IN; }
            else if ((r -= 576) < 72) { src = P.in[5] + (size_t)l * 384 * 768; gA = P.in[4] + l * 384; gB = gA + 512; K = 384; N = 768; Np = 768; off = OW_QB; }
            else if ((r -= 72) < 64) { src = P.in[7] + (size_t)l * 256 * 1024; gA = P.in[6] + l * 256; gB = gA + 512; K = 256; N = 1024; Np = 1024; off = OW_KVB; }
            else if ((r -= 64) < 256) { src = P.in[11] + (size_t)l * 1024 * 1024; gA = P.in[9] + l * 512; gB = P.in[10] + l * 512; K = 1024; N = 1024; Np = 1024; off = OW_OUT; }
            else if ((r -= 256) < 1024) { src = P.in[14] + (size_t)l * 1024 * 4096; gA = P.in[13] + l * 1024; gB = gA + 512; K = 1024; N = 4096; Np = 4096; off = OW_UP; }
            else if ((r -= 1024) < 1024) { src = P.in[15] + (size_t)l * 4096 * 1024; K = 4096; N = 1024; Np = 1024; off = OW_DOWN; }
            else if ((r -= 1024) < 256) { src = P.in[18] + (size_t)l * 1024 * 1024; gA = P.in[17] + l * 1024; gB = gA + 512; K = 1024; N = 1024; Np = 1024; off = OW_G; }
            else { r -= 256; src = P.in[19] + (size_t)l * 256 * 1024; K = 256; N = 1024; Np = 1024; off = OW_P; }
            bf16_t* dst = (bf16_t*)(ws + WS_W + (size_t)l * WL_BYTES + off);
            const int nct = Np / 64, k0 = (r / nct) * 64, n0 = (r % nct) * 64;
#pragma unroll
            for (int j = 0; j < 4; ++j) {
                const int kr = (tid >> 4) + 16 * j, n4 = (tid & 15) * 4, k = k0 + kr;
                f32x4 v = (f32x4){0.f, 0.f, 0.f, 0.f};
                if (n0 + n4 < N) v = *(const f32x4*)(src + (size_t)k * N + n0 + n4);
                float g = 1.f;
                if (gA) g = (k < 512) ? gA[k] : gB[k - 512];
                tl[kr * 65 + n4 + 0] = v[0] * g; tl[kr * 65 + n4 + 1] = v[1] * g; tl[kr * 65 + n4 + 2] = v[2] * g; tl[kr * 65 + n4 + 3] = v[3] * g;
            }
            __syncthreads();
            {
                const int n = tid >> 2, kq = (tid & 3) * 16;
                unsigned w[8];
#pragma unroll
                for (int i = 0; i < 8; ++i) w[i] = pk2(tl[(kq + 2 * i) * 65 + n], tl[(kq + 2 * i + 1) * 65 + n]);
                bf16_t* dp = dst + (size_t)(n0 + n) * K + k0 + kq;
                *(u32x4*)dp = (u32x4){w[0], w[1], w[2], w[3]};
                *(u32x4*)(dp + 8) = (u32x4){w[4], w[5], w[6], w[7]};
            }
            __syncthreads();
        }
        const float* x = P.in[0];
        for (int row = vb * 4 + wave; row < T; row += G * 4) {
            float ss = 0.f;
#pragma unroll
            for (int j = 0; j < 4; ++j) {
                const size_t idx = (size_t)row * D + j * 256 + lane * 4;
                const f32x4 v = *(const f32x4*)(x + idx);
                *(u32x2*)(xb + idx) = (u32x2){pk2(v[0], v[1]), pk2(v[2], v[3])};
                ss += v[0] * v[0] + v[1] * v[1] + v[2] * v[2] + v[3] * v[3];
            }
            ss += __shfl_xor(ss, 32); ss += __shfl_xor(ss, 16); ss += __shfl_xor(ss, 8); ss += __shfl_xor(ss, 4); ss += __shfl_xor(ss, 2); ss += __shfl_xor(ss, 1);
            if (lane < 16) stat[((size_t)ST_X0 * T + row) * 16 + lane] = (lane == 0) ? ss : 0.f;
        }
        for (int idx = vb * 256 + tid; idx < NL * 3 * 128; idx += G * 256) cnts[idx] = 0u;
        if (blockIdx.x == 0 && tid == 0) *gctr = 0u;
        for (int idx = vb * 256 + tid; idx < 3 * T * 16 / 2; idx += G * 256) ((u32x4*)gran)[idx] = (u32x4){0u, 0u, 0u, 0u};
        for (int idx = vb * 256 + tid; idx < XCD_BAR_WORDS; idx += G * 256) cnts[8192 + idx] = 0u;
        for (int idx = vb * 256 + tid; idx < S * 16; idx += G * 256) {
            const int s = idx >> 4, j = idx & 15;
            const double base = sqrt(sqrt(sqrt(sqrt(10000.0))));
            double pw = 1.0;
            for (int q = 0; q < j; ++q) pw *= base;
            const float pwf = (float)pw;
            const float inv_freq = 1.0f / pwf;
            const float angf = (float)s * inv_freq;
            const double a = (double)angf;
            const double n = rint(a * 0.15915494309189535);
            const double rr = a - n * 6.283185307179586;
            const double r2 = rr * rr;
            double sn = 0.0, term = rr;
            for (int k = 0; k < 16; ++k) { sn += term; term *= -r2 / (double)((2 * k + 2) * (2 * k + 3)); }
            double cs = 0.0; term = 1.0;
            for (int k = 0; k < 16; ++k) { cs += term; term *= -r2 / (double)((2 * k + 1) * (2 * k + 2)); }
            cosT[idx] = (float)cs; sinT[idx] = (float)sn;
        }
    }
    grid.sync();
    const XcdBarrier xbar = xcd_barrier_post(cnts + 8192, xst);

    for (int l = 0; l < NL; ++l) {
        const unsigned char* wl = ws + WS_W + (size_t)l * WL_BYTES;
        const bf16_t* WIN = (const bf16_t*)(wl + OW_IN);
        const bf16_t* WQB = (const bf16_t*)(wl + OW_QB);
        const bf16_t* WKVB = (const bf16_t*)(wl + OW_KVB);
        const bf16_t* WOUT = (const bf16_t*)(wl + OW_OUT);
        const bf16_t* WUP = (const bf16_t*)(wl + OW_UP);
        const bf16_t* WDOWN = (const bf16_t*)(wl + OW_DOWN);
        const bf16_t* WG = (const bf16_t*)(wl + OW_G);
        const bf16_t* WP = (const bf16_t*)(wl + OW_P);
        float* st = stat;

        if (PHASES & 2) for (int t = vb; t < 128 * 18; t += G) {
            const int tid = opq(threadIdx.x), lane = tid & 63, wave = __builtin_amdgcn_readfirstlane(tid >> 6), wm = wave >> 1, wn = wave & 1, fm = lane & 31, hi = lane >> 5; (void)wm; (void)wn; (void)fm; (void)hi; (void)wave; (void)lane;
            int panel = t / 18, ct = t % 18;
            if (G == 512) {
                const int i = t >> 9, q = vb & 63, x = vb >> 6;
                if (i < 4) { const int M = i * 8 + x; panel = (M >> 1) * 8 + (q >> 3); ct = (M & 1) * 8 + (q & 7); }
                else { const int u = t - 2048; panel = u >> 1; ct = 16 + (u & 1); }
            }
            const int row0 = panel * 128, col0 = ct * 128;
            if (tid < 128) ep[tid] = rsqrtf(sum_slots(st + ((size_t)ST_X0 * T + row0 + tid) * 16, 16) * (1.0f / 1024.0f) + EPS);
            f32x16 acc[2][2];
            gemm_mainloop<false>(xb + (size_t)row0 * D, D, WIN + (size_t)col0 * D, D, D, lds, acc);
#pragma unroll
            for (int mt = 0; mt < 2; ++mt) {
                float ss[16], rs[16];
#pragma unroll
                for (int r = 0; r < 16; ++r) { ss[r] = 0.f; rs[r] = ep[wm * 64 + mt * 32 + crow(r, hi)]; }
#pragma unroll
                for (int nt = 0; nt < 2; ++nt) {
                    const int col = col0 + wn * 64 + nt * 32 + fm;
#pragma unroll
                    for (int r = 0; r < 16; ++r) {
                        const float v = acc[mt][nt][r] * rs[r];
                        zb[(size_t)(row0 + wm * 64 + mt * 32 + crow(r, hi)) * ZW + col] = f2bf(v);
                        ss[r] += v * v;
                    }
                }
                if (ct < 5) {
                    const float tot = rowsum32(ss, lane);
                    float* pp = st + ((size_t)(ct < 3 ? ST_QA : ST_KVA) * T + row0 + wm * 64 + mt * 32 + crow((lane >> 1) & 15, hi)) * 16 + (ct < 3 ? ct : ct - 3) * 2 + wn;
                    if ((lane & 1) == 0) *pp = tot;
                }
            }
            __syncthreads();
        }
        xcd_barrier(xbar);

        if (STOP == 1) { dump_bf(zb, ZW); return; }
        if (PHASES & 4) for (int t = vb; t < 128 * 14; t += G) {
            const int tid = opq(threadIdx.x), lane = tid & 63, wave = __builtin_amdgcn_readfirstlane(tid >> 6), wm = wave >> 1, wn = wave & 1, fm = lane & 31, hi = lane >> 5; (void)wm; (void)wn; (void)fm; (void)hi; (void)wave; (void)lane;
            f32x16 acc[2][2];
            if (t < 128 * 6) {
                const int panel = t / 6, ct = t % 6, row0 = panel * 128, col0 = ct * 128;
                if (tid < 128) ep[tid] = rsqrtf(sum_slots(st + ((size_t)ST_QA * T + row0 + tid) * 16, 6) * (1.0f / 384.0f) + EPS);
                gemm_mainloop<false>(zb + (size_t)row0 * ZW, ZW, WQB + (size_t)col0 * 384, 384, 384, lds, acc);
#pragma unroll
                for (int mt = 0; mt < 2; ++mt) {
                    float rs[16];
#pragma unroll
                    for (int r = 0; r < 16; ++r) rs[r] = ep[wm * 64 + mt * 32 + crow(r, hi)] * QSCALE;
#pragma unroll
                    for (int nt = 0; nt < 2; ++nt) {
                        const int c32 = col0 + wn * 64 + nt * 32;
                        const int h = c32 / 96, dh = c32 % 96;
                        const bool rope = (dh == 64);
#pragma unroll
                        for (int r = 0; r < 16; ++r) {
                            const int row = row0 + wm * 64 + mt * 32 + crow(r, hi);
                            const int b = row >> 12, s = row & 4095;
                            float v = acc[mt][nt][r] * rs[r];
                            if (rope) {
                                const float pr = __shfl_xor(v, 16);
                                const float c = cosT[s * 16 + (fm & 15)], sn = sinT[s * 16 + (fm & 15)];
                                v = (fm < 16) ? (v * c - pr * sn) : (v * c + pr * sn);
                            }
                            Qb[((size_t)(b * NH + h) * S + s) * 96 + dh + fm] = f2bf(v);
                        }
                    }
                }
            } else {
                const int t2 = t - 128 * 6;
                const int panel = t2 / 8, ct = t2 % 8, row0 = panel * 128, col0 = ct * 128;
                if (tid < 128) ep[tid] = rsqrtf(sum_slots(st + ((size_t)ST_KVA * T + row0 + tid) * 16, 4) * (1.0f / 256.0f) + EPS);
                gemm_mainloop<false>(zb + (size_t)row0 * ZW + 384, ZW, WKVB + (size_t)col0 * 256, 256, 256, lds, acc);
                const int h = ct;
#pragma unroll
                for (int mt = 0; mt < 2; ++mt) {
                    float rs[16];
#pragma unroll
                    for (int r = 0; r < 16; ++r) rs[r] = ep[wm * 64 + mt * 32 + crow(r, hi)];
                    const int rbase = row0 + wm * 64 + mt * 32;
                    const int b = rbase >> 12;
#pragma unroll
                    for (int nt = 0; nt < 2; ++nt) {
                        const int d = nt * 32 + fm;
                        if (wn == 0) {
#pragma unroll
                            for (int r = 0; r < 16; ++r) {
                                const int s = (rbase + crow(r, hi)) & 4095;
                                Kb[((size_t)(b * NH + h) * S + s) * 96 + d] = f2bf(acc[mt][nt][r] * rs[r]);
                            }
                        } else {
#pragma unroll
                            for (int g = 0; g < 4; ++g) {
                                const int s = (rbase + 8 * g + 4 * hi) & 4095;
                                const u32x2 w = (u32x2){pk2(acc[mt][nt][4 * g] * rs[4 * g], acc[mt][nt][4 * g + 1] * rs[4 * g + 1]),
                                                         pk2(acc[mt][nt][4 * g + 2] * rs[4 * g + 2], acc[mt][nt][4 * g + 3] * rs[4 * g + 3])};
                                *(u32x2*)(Vt + ((size_t)(b * NH + h) * 64 + d) * S + s) = w;
                            }
                        }
                    }
                }
            }
            __syncthreads();
        }
        if (PHASES & 8) {
            const float* wc = P.in[8] + (size_t)l * 3 * 512;
            for (int row = vb * 4 + wave; row < T; row += G * 4) {
                const int tid = opq(threadIdx.x), lane = tid & 63, wave_ = 0, wm = 0, wn = 0, fm = lane & 31, hi = lane >> 5; (void)wm; (void)wn; (void)fm; (void)hi; (void)wave_; (void)lane;
                const int s = row & 4095, b = row >> 12;
                const bf16_t* zr = zb + (size_t)row * ZW;
                const int c0 = 8 * lane;
                const u32x4 gbv = *(const u32x4*)(zr + 672 + c0);
                const u32x4 gc1 = *(const u32x4*)(zr + 1184 + c0), ci1 = *(const u32x4*)(zr + 1696 + c0);
                u32x4 gc0 = (u32x4){0, 0, 0, 0}, ci0 = gc0, gc2 = gc0, ci2 = gc0;
                if (s > 0) { gc0 = *(const u32x4*)(zr - ZW + 1184 + c0); ci0 = *(const u32x4*)(zr - ZW + 1696 + c0); }
                if (s < S - 1) { gc2 = *(const u32x4*)(zr + ZW + 1184 + c0); ci2 = *(const u32x4*)(zr + ZW + 1696 + c0); }
                const f32x4 w0a = *(const f32x4*)(wc + c0), w0b = *(const f32x4*)(wc + c0 + 4);
                const f32x4 w1a = *(const f32x4*)(wc + 512 + c0), w1b = *(const f32x4*)(wc + 512 + c0 + 4);
                const f32x4 w2a = *(const f32x4*)(wc + 1024 + c0), w2b = *(const f32x4*)(wc + 1024 + c0 + 4);
                float cv[8]; float ss = 0.f;
#pragma unroll
                for (int i = 0; i < 4; ++i) {
                    const unsigned a0 = gc0[i], a1 = gc1[i], a2 = gc2[i], d0 = ci0[i], d1 = ci1[i], d2 = ci2[i], gw = gbv[i];
                    const float wlo0 = (i < 2) ? w0a[2 * i] : w0b[2 * i - 4], whi0 = (i < 2) ? w0a[2 * i + 1] : w0b[2 * i - 3];
                    const float wlo1 = (i < 2) ? w1a[2 * i] : w1b[2 * i - 4], whi1 = (i < 2) ? w1a[2 * i + 1] : w1b[2 * i - 3];
                    const float wlo2 = (i < 2) ? w2a[2 * i] : w2b[2 * i - 4], whi2 = (i < 2) ? w2a[2 * i + 1] : w2b[2 * i - 3];
                    const float lo = bflo(gw) * (wlo0 * bflo(a0) * bflo(d0) + wlo1 * bflo(a1) * bflo(d1) + wlo2 * bflo(a2) * bflo(d2));
                    const float hv = bfhi(gw) * (whi0 * bfhi(a0) * bfhi(d0) + whi1 * bfhi(a1) * bfhi(d1) + whi2 * bfhi(a2) * bfhi(d2));
                    cv[2 * i] = lo; cv[2 * i + 1] = hv; ss += lo * lo + hv * hv;
                }
                ss += __shfl_xor(ss, 1); ss += __shfl_xor(ss, 2); ss += __shfl_xor(ss, 4);
                const float rn = rsqrtf(ss * (1.0f / 64.0f) + EPS);
                *(u32x4*)(mix + (size_t)row * D + 512 + c0) = (u32x4){pk2(cv[0] * rn, cv[1] * rn), pk2(cv[2] * rn, cv[3] * rn), pk2(cv[4] * rn, cv[5] * rn), pk2(cv[6] * rn, cv[7] * rn)};
                if (lane < 16) {
                    const float a = bf2f(zr[640 + lane]), bb = bf2f(zr[656 + lane]);
                    const float c = cosT[s * 16 + lane], sn = sinT[s * 16 + lane];
                    const bf16_t o1 = f2bf(a * c - bb * sn), o2 = f2bf(bb * c + a * sn);
#pragma unroll
                    for (int h = 0; h < NH; ++h) {
                        bf16_t* kp = Kb + ((size_t)(b * NH + h) * S + s) * 96;
                        kp[64 + lane] = o1; kp[80 + lane] = o2;
                    }
                }
            }
        }
        xcd_barrier(xbar);

        if (STOP == 2) { dump_bf(Qb, 768); return; }
        if (STOP == 12) { dump_bf(Kb, 768); return; }
        if (STOP == 22) { dump_bf(Vt, 512); return; }
        if (STOP == 32) { dump_bf(mix, 1024); return; }
        if (PHASES & 16) for (int rep = 0; rep < REPA; ++rep) for (int it = vb; it < 32 * 16; it += G) {
            const int tid = opq(threadIdx.x), lane = tid & 63, wave = __builtin_amdgcn_readfirstlane(tid >> 6), fm = lane & 31, hi = lane >> 5;
            const int bh = it >> 4, qb = it & 15, b = bh >> 3, h = bh & 7;
            const bf16_t* Qp = Qb + ((size_t)bh * S + qb * 256 + wave * 64 + fm) * 96 + hi * 8;
            const bf16_t* Kp = Kb + (size_t)bh * S * 96;
            const bf16_t* Vp = Vt + (size_t)bh * 64 * S;
            bf16x8 qf[2][6];
#pragma unroll
            for (int u = 0; u < 2; ++u)
#pragma unroll
                for (int d0 = 0; d0 < 6; ++d0) qf[u][d0] = *(const bf16x8*)(Qp + (size_t)u * 32 * 96 + d0 * 16);
            f32x16 o[2][2];
#pragma unroll
            for (int u = 0; u < 2; ++u)
#pragma unroll
                for (int r = 0; r < 16; ++r) { o[u][0][r] = 0.f; o[u][1][r] = 0.f; }
            float mhat[2] = {0.f, 0.f}, lrun[2] = {0.f, 0.f};
            u32x4 kr[3], vr[2];
            const int pim = (fm & ~12) | ((fm & 4) << 1) | ((fm & 8) >> 1);
            const int koff = pim * KROW + hi * 16, voff = fm * VROW + hi * 16;
            auto loadkv = [&](int kv0) __attribute__((always_inline)) {
#pragma unroll
                for (int i = 0; i < 3; ++i) kr[i] = *(const u32x4*)(Kp + (size_t)kv0 * 96 + (tid + 256 * i) * 8);
#pragma unroll
                for (int i = 0; i < 2; ++i) { const int c = tid + 256 * i; vr[i] = *(const u32x4*)(Vp + (size_t)(c >> 3) * S + kv0 + (c & 7) * 8); }
            };
            auto storekv = [&](int buf) __attribute__((always_inline)) {
                unsigned char* kb = lds + buf * (KT_BYTES + VT_BYTES);
                unsigned char* vbp = kb + KT_BYTES;
#pragma unroll
                for (int i = 0; i < 3; ++i) { const int c = tid + 256 * i; *(u32x4*)(kb + (c / 12) * KROW + (c % 12) * 16) = kr[i]; }
#pragma unroll
                for (int i = 0; i < 2; ++i) { const int c = tid + 256 * i; *(u32x4*)(vbp + (c >> 3) * VROW + (c & 7) * 16) = vr[i]; }
            };
            loadkv(0); storekv(0); __syncthreads();
            for (int kt = 0; kt < 64; ++kt) {
                if (kt + 1 < 64) loadkv((kt + 1) * 64);
                __builtin_amdgcn_sched_barrier(0);
                const unsigned char* kb = lds + (kt & 1) * (KT_BYTES + VT_BYTES);
                const unsigned char* vbp = kb + KT_BYTES;
                f32x16 p[2][2];
#pragma unroll
                for (int d0 = 0; d0 < 6; ++d0) {
                    const bf16x8 k0 = *(const bf16x8*)(kb + koff + d0 * 32), k1 = *(const bf16x8*)(kb + koff + 32 * KROW + d0 * 32);
#pragma unroll
                    for (int u = 0; u < 2; ++u) {
                        if (d0 == 0) {
                            p[u][0] = __builtin_amdgcn_mfma_f32_32x32x16_bf16(k0, qf[u][0], (f32x16){0.f,0.f,0.f,0.f,0.f,0.f,0.f,0.f,0.f,0.f,0.f,0.f,0.f,0.f,0.f,0.f}, 0, 0, 0);
                            p[u][1] = __builtin_amdgcn_mfma_f32_32x32x16_bf16(k1, qf[u][0], (f32x16){0.f,0.f,0.f,0.f,0.f,0.f,0.f,0.f,0.f,0.f,0.f,0.f,0.f,0.f,0.f,0.f}, 0, 0, 0);
                        } else {
                            p[u][0] = __builtin_amdgcn_mfma_f32_32x32x16_bf16(k0, qf[u][d0], p[u][0], 0, 0, 0);
                            p[u][1] = __builtin_amdgcn_mfma_f32_32x32x16_bf16(k1, qf[u][d0], p[u][1], 0, 0, 0);
                        }
                    }
                }
#pragma unroll
                for (int u = 0; u < 2; ++u) {
                    float mx = p[u][0][0];
#pragma unroll
                    for (int r = 0; r < 16; ++r) mx = fmaxf(fmaxf(mx, p[u][0][r]), p[u][1][r]);
                    mx = fmaxf(mx, __shfl_xor(mx, 32));
                    if (kt == 0 || __any(mx - mhat[u] > 8.0f)) {
                        const float nm = (kt == 0) ? mx : fmaxf(mx, mhat[u]);
                        const float f = (kt == 0) ? 1.0f : __builtin_amdgcn_exp2f(mhat[u] - nm);
                        mhat[u] = nm; lrun[u] *= f;
#pragma unroll
                        for (int r = 0; r < 16; ++r) { o[u][0][r] *= f; o[u][1][r] *= f; }
                    }
                }
                auto soft = [&](int u, bf16x8 (&pfu)[4]) __attribute__((always_inline)) {
                    const float mh = mhat[u];
#pragma unroll
                    for (int r = 0; r < 16; ++r) { p[u][0][r] = __builtin_amdgcn_exp2f(p[u][0][r] - mh); p[u][1][r] = __builtin_amdgcn_exp2f(p[u][1][r] - mh); }
                    {
                        const f32x16 t = p[u][0] + p[u][1];
                        float rsum = ((t[0] + t[1]) + (t[2] + t[3])) + ((t[4] + t[5]) + (t[6] + t[7]));
                        rsum += ((t[8] + t[9]) + (t[10] + t[11])) + ((t[12] + t[13]) + (t[14] + t[15]));
                        lrun[u] += rsum;
                    }
#pragma unroll
                    for (int c = 0; c < 4; ++c) {
                        const int mt = c >> 1, r0 = (c & 1) * 8;
                        const u32x4 w = (u32x4){pk2(p[u][mt][r0], p[u][mt][r0 + 1]), pk2(p[u][mt][r0 + 2], p[u][mt][r0 + 3]), pk2(p[u][mt][r0 + 4], p[u][mt][r0 + 5]), pk2(p[u][mt][r0 + 6], p[u][mt][r0 + 7])};
                        pfu[c] = __builtin_bit_cast(bf16x8, w);
                    }
                };
                auto pvm = [&](int u, const bf16x8 (&pfu)[4]) __attribute__((always_inline)) {
#pragma unroll
                    for (int c = 0; c < 4; ++c) {
                        const bf16x8 v0 = *(const bf16x8*)(vbp + voff + c * 32), v1 = *(const bf16x8*)(vbp + voff + 32 * VROW + c * 32);
                        o[u][0] = __builtin_amdgcn_mfma_f32_32x32x16_bf16(v0, pfu[c], o[u][0], 0, 0, 0);
                        o[u][1] = __builtin_amdgcn_mfma_f32_32x32x16_bf16(v1, pfu[c], o[u][1], 0, 0, 0);
                    }
                };
                bf16x8 pfa[4], pfb[4];
                soft(0, pfa);
                pvm(0, pfa);
                soft(1, pfb);
#pragma unroll
                for (int i = 0; i < 8; ++i) { __builtin_amdgcn_sched_group_barrier(0x008, 1, 0); __builtin_amdgcn_sched_group_barrier(0x002, 10, 0); }
                pvm(1, pfb);
                if (kt + 1 < 64) storekv((kt + 1) & 1);
                __syncthreads();
            }
#pragma unroll
            for (int u = 0; u < 2; ++u) {
                const float ltot = lrun[u] + __shfl_xor(lrun[u], 32);
                const float inv = 1.0f / ltot;
                float ss = 0.f;
#pragma unroll
                for (int r = 0; r < 16; ++r) { o[u][0][r] *= inv; o[u][1][r] *= inv; ss += o[u][0][r] * o[u][0][r] + o[u][1][r] * o[u][1][r]; }
                ss += __shfl_xor(ss, 32);
                const float rn = rsqrtf(ss * (1.0f / 64.0f) + EPS);
                bf16_t* mp = mix + (size_t)(b * S + qb * 256 + wave * 64 + u * 32 + fm) * D + h * 64 + 4 * hi;
#pragma unroll
                for (int d0 = 0; d0 < 2; ++d0)
#pragma unroll
                    for (int g = 0; g < 4; ++g)
                        *(u32x2*)(mp + d0 * 32 + 8 * g) = (u32x2){pk2(o[u][d0][4 * g] * rn, o[u][d0][4 * g + 1] * rn), pk2(o[u][d0][4 * g + 2] * rn, o[u][d0][4 * g + 3] * rn)};
            }
        }
        xcd_barrier(xbar);

        if (STOP == 3) { dump_bf(mix, 1024); return; }
        if (PHASES & 32) for (int t = vb; t < 128 * 4; t += G) {
            const int panel = t >> 2, ct = t & 3, row0 = panel * 128, col0 = ct * 256;
            f32x16 acc[2][4];
            gemm_mainloop_w(mix + (size_t)row0 * D, D, WOUT + (size_t)col0 * D, D, D, lds, acc);
            exch_epilogue_w(acc, row0, col0, gran + (size_t)0 * T * 16, (unsigned)(l * 4 + 1), P.in[12] + l * D, xout, xb, st + (size_t)ST_X1 * T * 16, ep);
            __syncthreads();
        }
        xcd_barrier(xbar);

        if (STOP == 4) { return; }
        if (PHASES & 64) for (int t = vb; t < 2048 + 1024; t += G) {
            const int tid = opq(threadIdx.x), lane = tid & 63, wave = __builtin_amdgcn_readfirstlane(tid >> 6), wm = wave >> 1, wn = wave & 1, fm = lane & 31, hi = lane >> 5; (void)lane;
            if (t < 2048) {
                int panel = t >> 4, ct = t & 15;
                if (G == 512) { const int M = (t >> 9) * 8 + (vb >> 6), q = vb & 63; panel = (M >> 1) * 8 + (q >> 3); ct = (M & 1) * 8 + (q & 7); }
                const int row0 = panel * 128, col0 = ct * 256;
                if (tid < 128) ep[tid] = rsqrtf(sum_slots(st + ((size_t)ST_X1 * T + row0 + tid) * 16, 8) * (1.0f / 1024.0f) + EPS);
                f32x16 acc[2][4];
                gemm_mainloop_w(xb + (size_t)row0 * D, D, WUP + (size_t)col0 * D, D, D, lds, acc);
#pragma unroll
                for (int mt = 0; mt < 2; ++mt) {
                    float rs[16];
#pragma unroll
                    for (int r = 0; r < 16; ++r) rs[r] = ep[wm * 64 + mt * 32 + crow(r, hi)];
#pragma unroll
                    for (int nt = 0; nt < 4; ++nt) {
                        const int col = col0 + wn * 128 + nt * 32 + fm;
#pragma unroll
                        for (int r = 0; r < 16; ++r) {
                            const float v = fmaxf(acc[mt][nt][r] * rs[r], 0.f);
                            ub[(size_t)(row0 + wm * 64 + mt * 32 + crow(r, hi)) * FF + col] = f2bf(v * v);
                        }
                    }
                }
            } else {
                const int t2 = t - 2048;
                const int panel = t2 >> 3, ct = t2 & 7, row0 = panel * 128, col0 = ct * 128;
                f32x16 acc[2][2];
                gemm_mainloop<true>(P.in[1] + ((size_t)l * T + row0) * 256, 256, WP + (size_t)col0 * 256, 256, 256, lds, acc);
#pragma unroll
                for (int mt = 0; mt < 2; ++mt)
#pragma unroll
                    for (int nt = 0; nt < 2; ++nt) {
                        const int col = col0 + wn * 64 + nt * 32 + fm;
#pragma unroll
                        for (int r = 0; r < 16; ++r) ebuf[(size_t)(row0 + wm * 64 + mt * 32 + crow(r, hi)) * D + col] = f2bf(acc[mt][nt][r]);
                    }
            }
            __syncthreads();
        }
        xcd_barrier(xbar);

        if (STOP == 5) { dump_bf(ub, 4096); return; }
        if (STOP == 15) { dump_bf(ebuf, 1024); return; }
        if (PHASES & 128) for (int t = vb; t < 128 * 4; t += G) {
            const int panel = t >> 2, ct = t & 3, row0 = panel * 128, col0 = ct * 256;
            f32x16 acc[2][4];
            gemm_mainloop_w(ub + (size_t)row0 * FF, FF, WDOWN + (size_t)col0 * FF, FF, FF, lds, acc);
            exch_epilogue_w(acc, row0, col0, gran + (size_t)1 * T * 16, (unsigned)(l * 4 + 2), P.in[16] + l * D, xout, xb, st + (size_t)ST_X2 * T * 16, ep);
            __syncthreads();
        }
        xcd_barrier(xbar);

        if (STOP == 6) { return; }
        if (PHASES & 256) for (int t = vb; t < 128 * 8; t += G) {
            const int tid = opq(threadIdx.x), lane = tid & 63, wave = __builtin_amdgcn_readfirstlane(tid >> 6), wm = wave >> 1, wn = wave & 1, fm = lane & 31, hi = lane >> 5; (void)wm; (void)wn; (void)fm; (void)hi; (void)wave; (void)lane;
            const int panel = t >> 3, ct = t & 7, row0 = panel * 128, col0 = ct * 128;
            if (tid < 128) ep[tid] = rsqrtf(sum_slots(st + ((size_t)ST_X2 * T + row0 + tid) * 16, 8) * (1.0f / 1024.0f) + EPS);
            f32x16 acc[2][2];
            gemm_mainloop<false>(xb + (size_t)row0 * D, D, WG + (size_t)col0 * D, D, D, lds, acc);
#pragma unroll
            for (int mt = 0; mt < 2; ++mt) {
                float rs[16];
#pragma unroll
                for (int r = 0; r < 16; ++r) rs[r] = ep[wm * 64 + mt * 32 + crow(r, hi)];
#pragma unroll
                for (int nt = 0; nt < 2; ++nt) {
                    const int col = col0 + wn * 64 + nt * 32 + fm;
#pragma unroll
                    for (int r = 0; r < 16; ++r) {
                        const float gte = 1.0f / (1.0f + __expf(-acc[mt][nt][r] * rs[r]));
                        acc[mt][nt][r] = gte * bf2f(ebuf[(size_t)(row0 + wm * 64 + mt * 32 + crow(r, hi)) * D + col]);
                    }
                }
            }
            exch_epilogue(acc, row0, col0, gran + (size_t)2 * T * 16, (unsigned)(l * 4 + 3), P.in[20] + l * D, (l == NL - 1) ? xout : nullptr, xb, st + (size_t)ST_X0 * T * 16, ep);
            __syncthreads();
        }
        if (STOP == 7) return;
        if (l + 1 < NL) xcd_barrier(xbar);
    }
}

extern "C" void kernel_launch(void* const* d_in, const int* in_sizes, int n_in, void* d_out, int out_size, void* d_ws, size_t ws_size, hipStream_t stream) {
    static int grid = 0;
    if (grid == 0) {
        if (n_in != 21 || out_size != T * D || ws_size < WS_END) { fprintf(stderr, "kernel_launch: unexpected problem (n_in %d out %d ws %zu)\n", n_in, out_size, ws_size); grid = -1; return; }
        int dev = 0, cus = 0, per_cu = 0;
        hipGetDevice(&dev);
        hipDeviceGetAttribute(&cus, hipDeviceAttributeMultiprocessorCount, dev);
        if (hipFuncSetAttribute((const void*)mega, hipFuncAttributeMaxDynamicSharedMemorySize, LDS_BYTES) != hipSuccess) { fprintf(stderr, "hipFuncSetAttribute failed\n"); grid = -1; return; }
        if (hipOccupancyMaxActiveBlocksPerMultiprocessor(&per_cu, (const void*)mega, 256, LDS_BYTES) != hipSuccess || per_cu < 1) { fprintf(stderr, "occupancy query failed (%d)\n", per_cu); per_cu = 1; }
        if (per_cu > 2) per_cu = 2;
        grid = (cus * per_cu) & ~7;
        fprintf(stderr, "kernel_launch: cus %d per_cu %d grid %d\n", cus, per_cu, grid);
    }
    if (grid < 0) return;
    Params p{};
    for (int i = 0; i < 21; ++i) p.in[i] = (const float*)d_in[i];
    p.out = (float*)d_out; p.ws = (unsigned char*)d_ws;
    void* args[] = {&p};
    hipError_t e = hipLaunchCooperativeKernel((const void*)mega, dim3(grid), dim3(256), args, LDS_BYTES, stream);
    if (e != hipSuccess) fprintf(stderr, "cooperative launch failed: %s (grid %d)\n", hipGetErrorString(e), grid);
}
```

```cpp
#include <hip/hip_runtime.h>
#include <hip/hip_cooperative_groups.h>
#include <cstdio>
#include <cstdint>
namespace cg = cooperative_groups;

typedef unsigned short bf16_t;
typedef short bf16x8 __attribute__((ext_vector_type(8)));
typedef float f32x16 __attribute__((ext_vector_type(16)));
typedef float f32x4 __attribute__((ext_vector_type(4)));
typedef unsigned u32x4 __attribute__((ext_vector_type(4)));
typedef unsigned u32x2 __attribute__((ext_vector_type(2)));

constexpr int T = 16384, S = 4096, D = 1024, NL = 4, NH = 8, ZW = 2304, FF = 4096;
constexpr float EPS = 1e-6f;
constexpr float QSCALE = 0.10206207261596575f * 1.4426950408889634f;

constexpr size_t MiB = (size_t)1 << 20;
constexpr size_t WS_STAT = 0;
constexpr size_t WS_CNT = 8 * MiB;
constexpr size_t WS_ROPE = 9 * MiB;
constexpr size_t WS_W = 10 * MiB;
constexpr size_t WL_BYTES = 27328512;
constexpr size_t OW_IN = 0, OW_QB = 4718592, OW_KVB = 5308416, OW_OUT = 5832704, OW_UP = 7929856, OW_DOWN = 16318464, OW_G = 24707072, OW_P = 26804224;
constexpr size_t WS_XB = 115 * MiB;
constexpr size_t WS_MIX = 147 * MiB;
constexpr size_t WS_Z = 179 * MiB;
constexpr size_t WS_Q = 251 * MiB;
constexpr size_t WS_K = 275 * MiB;
constexpr size_t WS_VT = 299 * MiB;
constexpr size_t WS_U = 179 * MiB;
constexpr size_t WS_GRAN = 315 * MiB;
constexpr size_t WS_END = 321 * MiB;

enum { ST_X0 = 0, ST_QA = 1, ST_KVA = 2, ST_Y1 = 3, ST_X1 = 4, ST_F = 5, ST_X2 = 6, ST_T = 7 };

constexpr int LROW = 144;
constexpr int TILE_BYTES = 128 * LROW;
constexpr int EP_OFF = 4 * TILE_BYTES;
constexpr int XB_OFF = EP_OFF + 1024;
constexpr int LDS_BYTES = XB_OFF + 64;
constexpr int KROW = 208, VROW = 144;
constexpr int KT_BYTES = 64 * KROW, VT_BYTES = 64 * VROW;

#ifndef PHASES
#define PHASES 511
#endif
#ifndef REPG
#define REPG 1
#endif
#ifndef REPA
#define REPA 1
#endif
#ifndef REPP
#define REPP 1
#endif
#ifndef STOP
#define STOP 0
#endif
struct Params { const float* in[21]; float* out; unsigned char* ws; };

typedef float f32x2_t __attribute__((ext_vector_type(2)));
typedef __bf16 bf16x2_t __attribute__((ext_vector_type(2)));
__device__ __forceinline__ unsigned pk2(float lo, float hi) { const f32x2_t v = {lo, hi}; const bf16x2_t b = __builtin_convertvector(v, bf16x2_t); return __builtin_bit_cast(unsigned, b); }
__device__ __forceinline__ bf16_t f2bf(float f) { return (bf16_t)(pk2(f, 0.f) & 0xffffu); }
__device__ __forceinline__ float bf2f(bf16_t b) { return __uint_as_float(((unsigned)b) << 16); }
__device__ __forceinline__ float bflo(unsigned w) { return __uint_as_float(w << 16); }
__device__ __forceinline__ float bfhi(unsigned w) { return __uint_as_float(w & 0xffff0000u); }
__device__ __forceinline__ int opq(int v) { asm volatile("" : "+v"(v)); return v; }
__device__ __forceinline__ int crow(int r, int hi) { return (r & 3) + 8 * (r >> 2) + 4 * hi; }
__device__ __forceinline__ int vblock() { const int G = gridDim.x, b = blockIdx.x; return (G % 8 == 0) ? (b % 8) * (G / 8) + b / 8 : b; }
__device__ __forceinline__ void st_wt(float* p, float v) { __hip_atomic_store(p, v, __ATOMIC_RELAXED, __HIP_MEMORY_SCOPE_AGENT); }
__device__ __forceinline__ float atomic_ldf(const float* p) { return __hip_atomic_load(p, __ATOMIC_RELAXED, __HIP_MEMORY_SCOPE_AGENT); }
__device__ __forceinline__ float sum_slots(const float* p, int nslot) {
    const f32x4* q = (const f32x4*)p; float s = 0.f;
    for (int i = 0; i < (nslot >> 2); ++i) { const f32x4 a = q[i]; s += (a[0] + a[1]) + (a[2] + a[3]); }
    for (int i = nslot & ~3; i < nslot; ++i) s += p[i];
    return s;
}

__device__ __forceinline__ float rowsum32(const float (&s)[16], int lane) {
    const bool b4 = lane & 16, b3 = lane & 8, b2 = lane & 4, b1 = lane & 2;
    float a[8], b[4], c[2], d;
#pragma unroll
    for (int i = 0; i < 8; ++i) { const float keep = b4 ? s[8 + i] : s[i], send = b4 ? s[i] : s[8 + i]; a[i] = keep + __shfl_xor(send, 16); }
#pragma unroll
    for (int i = 0; i < 4; ++i) { const float keep = b3 ? a[4 + i] : a[i], send = b3 ? a[i] : a[4 + i]; b[i] = keep + __shfl_xor(send, 8); }
#pragma unroll
    for (int i = 0; i < 2; ++i) { const float keep = b2 ? b[2 + i] : b[i], send = b2 ? b[i] : b[2 + i]; c[i] = keep + __shfl_xor(send, 4); }
    { const float keep = b1 ? c[1] : c[0], send = b1 ? c[0] : c[1]; d = keep + __shfl_xor(send, 2); }
    d += __shfl_xor(d, 1);
    return d;
}

template <bool AF32>
__device__ __forceinline__ void gemm_mainloop(const void* __restrict__ Ap, int lda, const bf16_t* __restrict__ Bt, int ldb, int K,
                                              unsigned char* smem, f32x16 (&acc)[2][2]) {
    const int tid = opq(threadIdx.x), lane = tid & 63, wave = __builtin_amdgcn_readfirstlane(tid >> 6), wm = wave >> 1, wn = wave & 1, fm = lane & 31, hi = lane >> 5;
    const int srow = tid >> 3, skc = tid & 7;
    u32x4 ra0[4], rb0[4], ra1[4], rb1[4];
    u32x4 rx0[AF32 ? 4 : 1], rx1[AF32 ? 4 : 1];
#pragma unroll
    for (int i = 0; i < 2; ++i)
#pragma unroll
        for (int j = 0; j < 2; ++j)
#pragma unroll
            for (int r = 0; r < 16; ++r) acc[i][j][r] = 0.f;
    const int aoff = (wm * 64 + fm) * LROW + hi * 16, boff = (wn * 64 + fm) * LROW + hi * 16;
    const int soff = srow * LROW + skc * 16;
    const unsigned la = (unsigned)(srow * lda + skc * 8), lb = (unsigned)(srow * ldb + skc * 8);
    auto loadt = [&](int k0, u32x4 (&ra)[4], u32x4 (&rx)[AF32 ? 4 : 1], u32x4 (&rb)[4]) __attribute__((always_inline)) {
#pragma unroll
        for (int i = 0; i < 4; ++i) {
            if (AF32) {
                const float* ap = (const float*)Ap + (size_t)(32 * i) * lda + k0;
                ra[i] = *(const u32x4*)(ap + la); rx[i] = *(const u32x4*)(ap + la + 4);
            } else {
                const bf16_t* ap = (const bf16_t*)Ap + (size_t)(32 * i) * lda + k0;
                ra[i] = *(const u32x4*)(ap + la);
            }
            const bf16_t* bp = Bt + (size_t)(32 * i) * ldb + k0;
            rb[i] = *(const u32x4*)(bp + lb);
        }
    };
    auto storet = [&](int buf, const u32x4 (&ra)[4], const u32x4 (&rx)[AF32 ? 4 : 1], const u32x4 (&rb)[4]) __attribute__((always_inline)) {
        unsigned char* a = smem + buf * 2 * TILE_BYTES;
        unsigned char* b = a + TILE_BYTES;
#pragma unroll
        for (int i = 0; i < 4; ++i) {
            u32x4 av = ra[i];
            if (AF32) av = (u32x4){pk2(__uint_as_float(ra[i][0]), __uint_as_float(ra[i][1])), pk2(__uint_as_float(ra[i][2]), __uint_as_float(ra[i][3])),
                                   pk2(__uint_as_float(rx[i][0]), __uint_as_float(rx[i][1])), pk2(__uint_as_float(rx[i][2]), __uint_as_float(rx[i][3]))};
            *(u32x4*)(a + soff + i * 32 * LROW) = av; *(u32x4*)(b + soff + i * 32 * LROW) = rb[i];
        }
    };
    auto compute = [&](int buf) __attribute__((always_inline)) {
        const unsigned char* a = smem + buf * 2 * TILE_BYTES;
        const unsigned char* b = a + TILE_BYTES;
        __builtin_amdgcn_s_setprio(1);
#pragma unroll
        for (int kk = 0; kk < 4; ++kk) {
            const bf16x8 a0 = *(const bf16x8*)(a + aoff + kk * 32), a1 = *(const bf16x8*)(a + aoff + 32 * LROW + kk * 32);
            const bf16x8 b0 = *(const bf16x8*)(b + boff + kk * 32), b1 = *(const bf16x8*)(b + boff + 32 * LROW + kk * 32);
            acc[0][0] = __builtin_amdgcn_mfma_f32_32x32x16_bf16(a0, b0, acc[0][0], 0, 0, 0);
            acc[0][1] = __builtin_amdgcn_mfma_f32_32x32x16_bf16(a0, b1, acc[0][1], 0, 0, 0);
            acc[1][0] = __builtin_amdgcn_mfma_f32_32x32x16_bf16(a1, b0, acc[1][0], 0, 0, 0);
            acc[1][1] = __builtin_amdgcn_mfma_f32_32x32x16_bf16(a1, b1, acc[1][1], 0, 0, 0);
        }
        __builtin_amdgcn_s_setprio(0);
    };
    const int nk = K >> 6;
    for (int rep = 0; rep < REPG; ++rep) {
    if (rep) {
#pragma unroll
        for (int i = 0; i < 2; ++i)
#pragma unroll
            for (int j = 0; j < 2; ++j)
#pragma unroll
                for (int r = 0; r < 16; ++r) acc[i][j][r] = 0.f;
    }
    loadt(0, ra0, rx0, rb0);
    if (nk > 1) loadt(64, ra1, rx1, rb1);
    storet(0, ra0, rx0, rb0); __syncthreads();
    for (int kt = 0; kt < nk; kt += 2) {
        if (kt + 2 < nk) loadt((kt + 2) << 6, ra0, rx0, rb0);
        __builtin_amdgcn_sched_barrier(0);
        compute(0);
        if (kt + 1 < nk) storet(1, ra1, rx1, rb1);
        __syncthreads();
        if (kt + 1 < nk) {
            if (kt + 3 < nk) loadt((kt + 3) << 6, ra1, rx1, rb1);
            __builtin_amdgcn_sched_barrier(0);
            compute(1);
            if (kt + 2 < nk) storet(0, ra0, rx0, rb0);
            __syncthreads();
        }
    }
    }
}

constexpr int LROW2 = 80;
constexpr int A2_BYTES = 128 * LROW2, B2_BYTES = 256 * LROW2, STAGE2 = A2_BYTES + B2_BYTES;
__device__ __forceinline__ void gemm_mainloop_w(const bf16_t* __restrict__ Ap, int lda, const bf16_t* __restrict__ Bt, int ldb, int K,
                                                unsigned char* smem, f32x16 (&acc)[2][4]) {
    const int tid = opq(threadIdx.x), lane = tid & 63, wave = __builtin_amdgcn_readfirstlane(tid >> 6), wm = wave >> 1, wn = wave & 1, fm = lane & 31, hi = lane >> 5;
    const int srow = tid >> 2, skc = tid & 3;
    u32x4 ra0[2], rb0[4], ra1[2], rb1[4];
#pragma unroll
    for (int i = 0; i < 2; ++i)
#pragma unroll
        for (int j = 0; j < 4; ++j)
#pragma unroll
            for (int r = 0; r < 16; ++r) acc[i][j][r] = 0.f;
    const int aoff = (wm * 64 + fm) * LROW2 + hi * 16, boff = A2_BYTES + (wn * 128 + fm) * LROW2 + hi * 16;
    const int soff = srow * LROW2 + skc * 16;
    const unsigned la = (unsigned)(srow * lda + skc * 8), lb = (unsigned)(srow * ldb + skc * 8);
    auto loadt = [&](int k0, u32x4 (&ra)[2], u32x4 (&rb)[4]) __attribute__((always_inline)) {
#pragma unroll
        for (int i = 0; i < 2; ++i) { const bf16_t* ap = Ap + (size_t)(64 * i) * lda + k0; ra[i] = *(const u32x4*)(ap + la); }
#pragma unroll
        for (int i = 0; i < 4; ++i) { const bf16_t* bp = Bt + (size_t)(64 * i) * ldb + k0; rb[i] = *(const u32x4*)(bp + lb); }
    };
    auto storet = [&](int buf, const u32x4 (&ra)[2], const u32x4 (&rb)[4]) __attribute__((always_inline)) {
        unsigned char* a = smem + buf * STAGE2;
#pragma unroll
        for (int i = 0; i < 2; ++i) *(u32x4*)(a + soff + i * 64 * LROW2) = ra[i];
#pragma unroll
        for (int i = 0; i < 4; ++i) *(u32x4*)(a + A2_BYTES + soff + i * 64 * LROW2) = rb[i];
    };
    auto compute = [&](int buf) __attribute__((always_inline)) {
        const unsigned char* s = smem + buf * STAGE2;
        bf16x8 a[2][2], b[2][4];
#pragma unroll
        for (int kk = 0; kk < 2; ++kk) {
            a[kk][0] = *(const bf16x8*)(s + aoff + kk * 32); a[kk][1] = *(const bf16x8*)(s + aoff + 32 * LROW2 + kk * 32);
#pragma unroll
            for (int nt = 0; nt < 4; ++nt) b[kk][nt] = *(const bf16x8*)(s + boff + nt * 32 * LROW2 + kk * 32);
        }
        __builtin_amdgcn_sched_barrier(0);
        __builtin_amdgcn_s_setprio(1);
#pragma unroll
        for (int kk = 0; kk < 2; ++kk)
#pragma unroll
            for (int nt = 0; nt < 4; ++nt) {
                acc[0][nt] = __builtin_amdgcn_mfma_f32_32x32x16_bf16(a[kk][0], b[kk][nt], acc[0][nt], 0, 0, 0);
                acc[1][nt] = __builtin_amdgcn_mfma_f32_32x32x16_bf16(a[kk][1], b[kk][nt], acc[1][nt], 0, 0, 0);
            }
        __builtin_amdgcn_s_setprio(0);
    };
    const int nk = K >> 5;
    loadt(0, ra0, rb0);
    if (nk > 1) loadt(32, ra1, rb1);
    storet(0, ra0, rb0); __syncthreads();
    for (int kt = 0; kt < nk; kt += 2) {
        if (kt + 2 < nk) loadt((kt + 2) << 5, ra0, rb0);
        __builtin_amdgcn_sched_barrier(0);
        compute(0);
        if (kt + 1 < nk) storet(1, ra1, rb1);
        __syncthreads();
        if (kt + 1 < nk) {
            if (kt + 3 < nk) loadt((kt + 3) << 5, ra1, rb1);
            __builtin_amdgcn_sched_barrier(0);
            compute(1);
            if (kt + 2 < nk) storet(0, ra0, rb0);
            __syncthreads();
        }
    }
}

__device__ __forceinline__ void gemm_mainloop_w3(const bf16_t* __restrict__ Ap, int lda, const bf16_t* __restrict__ Bt, int ldb, int K,
                                                unsigned char* smem, f32x16 (&acc)[2][3]) {
    const int tid = opq(threadIdx.x), lane = tid & 63, wave = __builtin_amdgcn_readfirstlane(tid >> 6), wm = wave >> 1, wn = wave & 1, fm = lane & 31, hi = lane >> 5;
    const int srow = tid >> 2, skc = tid & 3;
    u32x4 ra0[2], rb0[3], ra1[2], rb1[3];
#pragma unroll
    for (int i = 0; i < 2; ++i)
#pragma unroll
        for (int j = 0; j < 3; ++j)
#pragma unroll
            for (int r = 0; r < 16; ++r) acc[i][j][r] = 0.f;
    const int aoff = (wm * 64 + fm) * LROW2 + hi * 16, boff = A2_BYTES + (wn * 96 + fm) * LROW2 + hi * 16;
    const int soff = srow * LROW2 + skc * 16;
    const unsigned la = (unsigned)(srow * lda + skc * 8), lb = (unsigned)(srow * ldb + skc * 8);
    auto loadt = [&](int k0, u32x4 (&ra)[2], u32x4 (&rb)[3]) __attribute__((always_inline)) {
#pragma unroll
        for (int i = 0; i < 2; ++i) { const bf16_t* ap = Ap + (size_t)(64 * i) * lda + k0; ra[i] = *(const u32x4*)(ap + la); }
#pragma unroll
        for (int i = 0; i < 3; ++i) { const bf16_t* bp = Bt + (size_t)(64 * i) * ldb + k0; rb[i] = *(const u32x4*)(bp + lb); }
    };
    auto storet = [&](int buf, const u32x4 (&ra)[2], const u32x4 (&rb)[3]) __attribute__((always_inline)) {
        unsigned char* a = smem + buf * STAGE2;
#pragma unroll
        for (int i = 0; i < 2; ++i) *(u32x4*)(a + soff + i * 64 * LROW2) = ra[i];
#pragma unroll
        for (int i = 0; i < 3; ++i) *(u32x4*)(a + A2_BYTES + soff + i * 64 * LROW2) = rb[i];
    };
    auto compute = [&](int buf) __attribute__((always_inline)) {
        const unsigned char* s = smem + buf * STAGE2;
        bf16x8 a[2][2], b[2][3];
#pragma unroll
        for (int kk = 0; kk < 2; ++kk) {
            a[kk][0] = *(const bf16x8*)(s + aoff + kk * 32); a[kk][1] = *(const bf16x8*)(s + aoff + 32 * LROW2 + kk * 32);
#pragma unroll
            for (int nt = 0; nt < 3; ++nt) b[kk][nt] = *(const bf16x8*)(s + boff + nt * 32 * LROW2 + kk * 32);
        }
        __builtin_amdgcn_sched_barrier(0);
        __builtin_amdgcn_s_setprio(1);
#pragma unroll
        for (int kk = 0; kk < 2; ++kk)
#pragma unroll
            for (int nt = 0; nt < 3; ++nt) {
                acc[0][nt] = __builtin_amdgcn_mfma_f32_32x32x16_bf16(a[kk][0], b[kk][nt], acc[0][nt], 0, 0, 0);
                acc[1][nt] = __builtin_amdgcn_mfma_f32_32x32x16_bf16(a[kk][1], b[kk][nt], acc[1][nt], 0, 0, 0);
            }
        __builtin_amdgcn_s_setprio(0);
    };
    const int nk = K >> 5;
    loadt(0, ra0, rb0);
    if (nk > 1) loadt(32, ra1, rb1);
    storet(0, ra0, rb0); __syncthreads();
    for (int kt = 0; kt < nk; kt += 2) {
        if (kt + 2 < nk) loadt((kt + 2) << 5, ra0, rb0);
        __builtin_amdgcn_sched_barrier(0);
        compute(0);
        if (kt + 1 < nk) storet(1, ra1, rb1);
        __syncthreads();
        if (kt + 1 < nk) {
            if (kt + 3 < nk) loadt((kt + 3) << 5, ra1, rb1);
            __builtin_amdgcn_sched_barrier(0);
            compute(1);
            if (kt + 2 < nk) storet(0, ra0, rb0);
            __syncthreads();
        }
    }
}

__device__ __forceinline__ void exch_epilogue(f32x16 (&v)[2][2], int row0, int col0, unsigned long long* gran, unsigned tag, const float* __restrict__ gain,
                                              float* xout, bf16_t* xb, float* part_next, float* ep) {
    const int tid = opq(threadIdx.x), lane = tid & 63, wave = __builtin_amdgcn_readfirstlane(tid >> 6), wm = wave >> 1, wn = wave & 1, fm = lane & 31, hi = lane >> 5;
    const int slot = (col0 >> 7) * 2 + wn;
    float xo[2][2][16];
#pragma unroll
    for (int mt = 0; mt < 2; ++mt)
#pragma unroll
        for (int nt = 0; nt < 2; ++nt) {
            const bf16_t* xp = xb + (size_t)(row0 + wm * 64 + mt * 32 + 4 * hi) * D + col0 + wn * 64 + nt * 32 + fm;
#pragma unroll
            for (int r = 0; r < 16; ++r) xo[mt][nt][r] = bf2f(xp[((r & 3) + 8 * (r >> 2)) * D]);
        }
#pragma unroll
    for (int mt = 0; mt < 2; ++mt) {
        float ss[16];
#pragma unroll
        for (int r = 0; r < 16; ++r) ss[r] = v[mt][0][r] * v[mt][0][r] + v[mt][1][r] * v[mt][1][r];
        const float tot = rowsum32(ss, lane);
        if ((lane & 1) == 0) __hip_atomic_store(gran + (size_t)(row0 + wm * 64 + mt * 32 + crow((lane >> 1) & 15, hi)) * 16 + slot, ((unsigned long long)tag << 32) | (unsigned long long)__float_as_uint(tot), __ATOMIC_RELAXED, __HIP_MEMORY_SCOPE_AGENT);
    }
    if (tid < 128) {
        const unsigned long long* g = gran + (size_t)(row0 + tid) * 16;
        float s;
        for (;;) {
            s = 0.f; bool ok = true;
#pragma unroll
            for (int i = 0; i < 16; ++i) { const unsigned long long x = __hip_atomic_load(g + i, __ATOMIC_RELAXED, __HIP_MEMORY_SCOPE_AGENT); ok &= ((unsigned)(x >> 32) == tag); s += __uint_as_float((unsigned)x); }
            if (ok) break;
            __builtin_amdgcn_s_sleep(1);
        }
        ep[128 + tid] = rsqrtf(s * (1.0f / 1024.0f) + EPS);
    }
    __syncthreads();
#pragma unroll
    for (int mt = 0; mt < 2; ++mt) {
        float ss[16], rs[16];
#pragma unroll
        for (int r = 0; r < 16; ++r) { ss[r] = 0.f; rs[r] = ep[128 + wm * 64 + mt * 32 + crow(r, hi)]; }
#pragma unroll
        for (int nt = 0; nt < 2; ++nt) {
            const int col = col0 + wn * 64 + nt * 32 + fm;
            const float g = gain[col];
            float* xp = xout + (size_t)(row0 + wm * 64 + mt * 32 + 4 * hi) * D + col;
            bf16_t* bp = xb + (size_t)(row0 + wm * 64 + mt * 32 + 4 * hi) * D + col;
#pragma unroll
            for (int g4 = 0; g4 < 4; ++g4) {
#pragma unroll
                for (int i = 0; i < 4; ++i) {
                    const int r = 4 * g4 + i, off = (8 * g4 + i) * D;
                    const float xf = xo[mt][nt][r] + v[mt][nt][r] * rs[r] * g;
                    const bf16_t xq = f2bf(xf);
                    const float xn = bf2f(xq);
                    bp[off] = xq; if (xout) xp[off] = xf; ss[r] += xn * xn;
                }
                asm volatile("" ::: "memory");
            }
        }
        const float tot = rowsum32(ss, lane);
        if ((lane & 1) == 0) part_next[(size_t)(row0 + wm * 64 + mt * 32 + crow((lane >> 1) & 15, hi)) * 16 + slot] = tot;
    }
}

__device__ __forceinline__ void exch_epilogue_w(f32x16 (&v)[2][4], int row0, int col0, unsigned long long* gran, unsigned tag, const float* __restrict__ gain,
                                                float* xout, bf16_t* xb, float* part_next, float* ep) {
    const int tid = opq(threadIdx.x), lane = tid & 63, wave = __builtin_amdgcn_readfirstlane(tid >> 6), wm = wave >> 1, wn = wave & 1, fm = lane & 31, hi = lane >> 5;
    const int slot = (col0 >> 8) * 2 + wn;
    float xs[2][16];
    auto ldx = [&](int u, float (&x)[16]) __attribute__((always_inline)) {
        const int lo = opq((4 * hi) * D + fm);
        const bf16_t* xp = xb + (size_t)(row0 + wm * 64 + (u >> 2) * 32) * D + col0 + wn * 128 + (u & 3) * 32 + lo;
#pragma unroll
        for (int r = 0; r < 16; ++r) x[r] = bf2f(xp[((r & 3) + 8 * (r >> 2)) * D]);
    };
    ldx(0, xs[0]);
#pragma unroll
    for (int mt = 0; mt < 2; ++mt) {
        float ss[16];
#pragma unroll
        for (int r = 0; r < 16; ++r) ss[r] = (v[mt][0][r] * v[mt][0][r] + v[mt][1][r] * v[mt][1][r]) + (v[mt][2][r] * v[mt][2][r] + v[mt][3][r] * v[mt][3][r]);
        const float tot = rowsum32(ss, lane);
        if ((lane & 1) == 0) __hip_atomic_store(gran + (size_t)(row0 + wm * 64 + mt * 32 + crow((lane >> 1) & 15, hi)) * 16 + slot, ((unsigned long long)tag << 32) | (unsigned long long)__float_as_uint(tot), __ATOMIC_RELAXED, __HIP_MEMORY_SCOPE_AGENT);
    }
    if (tid < 128) {
        const unsigned long long* g = gran + (size_t)(row0 + tid) * 16;
        float s;
        for (;;) {
            s = 0.f; bool ok = true;
#pragma unroll
            for (int i = 0; i < 8; ++i) { const unsigned long long x = __hip_atomic_load(g + i, __ATOMIC_RELAXED, __HIP_MEMORY_SCOPE_AGENT); ok &= ((unsigned)(x >> 32) == tag); s += __uint_as_float((unsigned)x); }
            if (ok) break;
            __builtin_amdgcn_s_sleep(1);
        }
        ep[128 + tid] = rsqrtf(s * (1.0f / 1024.0f) + EPS);
    }
    __syncthreads();
    float ss[16];
#pragma unroll
    for (int u = 0; u < 8; ++u) {
        const int mt = u >> 2, nt = u & 3;
        if (nt == 0) {
#pragma unroll
            for (int r = 0; r < 16; ++r) ss[r] = 0.f;
        }
        if (u + 1 < 8) ldx(u + 1, xs[(u + 1) & 1]);
        const int fmo = opq(fm), hio = opq(hi);
        const int col = col0 + wn * 128 + nt * 32 + fmo;
        const float g = gain[col];
        bf16_t* bp = xb + (size_t)(row0 + wm * 64 + mt * 32 + 4 * hio) * D + col;
#pragma unroll
        for (int g4 = 0; g4 < 4; ++g4) {
            const f32x4 rs4 = *(const f32x4*)(ep + 128 + wm * 64 + mt * 32 + 8 * g4 + 4 * hio);
#pragma unroll
            for (int i = 0; i < 4; ++i) {
                const int r = 4 * g4 + i, off = (8 * g4 + i) * D;
                const bf16_t xq = f2bf(xs[u & 1][r] + v[mt][nt][r] * rs4[i] * g);
                const float xn = bf2f(xq);
                bp[off] = xq; ss[r] += xn * xn;
            }
        }
        asm volatile("" ::: "memory");
        if (nt == 3) {
            const float tot = rowsum32(ss, lane);
            if ((lane & 1) == 0) part_next[(size_t)(row0 + wm * 64 + mt * 32 + crow((lane >> 1) & 15, hi)) * 16 + slot] = tot;
        }
    }
}

__device__ __forceinline__ void gbar(unsigned* ctr, unsigned& epoch, unsigned G) {
    asm volatile("s_waitcnt vmcnt(0)" ::: "memory");
    __syncthreads();
    epoch += 1u;
    if (threadIdx.x == 0) {
        __builtin_amdgcn_fence(__ATOMIC_RELEASE, "agent");
        asm volatile("s_waitcnt vmcnt(0)" ::: "memory");
        __hip_atomic_fetch_add(ctr, 1u, __ATOMIC_RELAXED, __HIP_MEMORY_SCOPE_AGENT);
        const unsigned target = epoch * G;
        while (__hip_atomic_load(ctr, __ATOMIC_RELAXED, __HIP_MEMORY_SCOPE_AGENT) < target) __builtin_amdgcn_s_sleep(1);
        __builtin_amdgcn_fence(__ATOMIC_ACQUIRE, "agent");
        asm volatile("s_waitcnt vmcnt(0)" ::: "memory");
    }
    __syncthreads();
}

#define LAS __attribute__((address_space(3)))
#define XB_TMO      128
#define XB_XCNT(j)  (256  + 64 * (j))
#define XB_XSUB(j)  (1280 + 64 * (j))
#define XB_XGEN(j)  (2304 + 64 * (j))
#define XB_TOP      3328
#define XB_TOPGEN   3392
#define XCD_BAR_WORDS 3456
#define XB_SPIN_CAP (1u << 22)
__device__ __forceinline__ unsigned xb_ld(unsigned* p)              { return __hip_atomic_load(p, __ATOMIC_RELAXED, __HIP_MEMORY_SCOPE_AGENT); }
__device__ __forceinline__ unsigned xb_add(unsigned* p, unsigned v) { return __hip_atomic_fetch_add(p, v, __ATOMIC_RELAXED, __HIP_MEMORY_SCOPE_AGENT); }
__device__ __forceinline__ unsigned xb_xcc_id() { return (unsigned)__builtin_amdgcn_s_getreg((3 << 11) | 20) & 0xFu; }
#define XB_SPIN(cond, bar) do { unsigned _sp = 0; while (cond) { __builtin_amdgcn_s_sleep(1); \
    if ((++_sp & 255u) == 0u) { if (xb_ld(&(bar)[XB_TMO])) break; if (_sp > XB_SPIN_CAP) { atomicAdd(&(bar)[XB_TMO], 1u); break; } } } } while (0)
struct XcdBarrier { unsigned* bar; unsigned x; volatile LAS unsigned* st; };
__device__ __forceinline__ XcdBarrier xcd_barrier_post(unsigned* bar, volatile LAS unsigned* st) {
    XcdBarrier b; b.bar = bar; b.x = xb_xcc_id(); b.st = st;
    if (threadIdx.x == 0) (void)xb_add(&bar[XB_XCNT(b.x)], 1u);
    return b;
}
__device__ __forceinline__ void xcd_barrier_complete(unsigned* bar, unsigned x, unsigned& nloc, unsigned& nx) {
    const unsigned G = gridDim.x * gridDim.y * gridDim.z;
    unsigned sum, cnt, mine, sp = 0u;
    for (;;) {
        sum = 0u; cnt = 0u; mine = 0u;
#pragma unroll
        for (unsigned j = 0; j < 16; ++j) { const unsigned c = xb_ld(&bar[XB_XCNT(j)]); sum += c; cnt += (c > 0u) ? 1u : 0u; mine = (j == x) ? c : mine; }
        if (sum == G) break;
        __builtin_amdgcn_s_sleep(1);
        if ((++sp & 255u) == 0u) { if (xb_ld(&bar[XB_TMO])) break; if (sp > XB_SPIN_CAP) { atomicAdd(&bar[XB_TMO], 1u); break; } }
    }
    nloc = mine > 0u ? mine : 1u; nx = cnt > 0u ? cnt : 1u;
}
__device__ __forceinline__ void xcd_barrier(const XcdBarrier& b) {
    asm volatile("s_waitcnt vmcnt(0)" ::: "memory");
    __syncthreads();
    if (threadIdx.x == 0) {
        unsigned* bar = b.bar;
        __builtin_amdgcn_s_waitcnt(0);
        unsigned nloc = b.st[0], nx = b.st[1];
        if (nloc == 0u) { xcd_barrier_complete(bar, b.x, nloc, nx); b.st[0] = nloc; b.st[1] = nx; }
        const unsigned old = xb_add(&bar[XB_XSUB(b.x)], 1u);
        const unsigned gen = old / nloc;
        if (old + 1u == (gen + 1u) * nloc) {
            __builtin_amdgcn_fence(__ATOMIC_RELEASE, "agent");
            asm volatile("s_waitcnt vmcnt(0)" ::: "memory");
            const unsigned og = xb_add(&bar[XB_TOP], 1u);
            const unsigned tg = og / nx;
            if (og + 1u == (tg + 1u) * nx) xb_add(&bar[XB_TOPGEN], 1u);
            else XB_SPIN(xb_ld(&bar[XB_TOPGEN]) == tg, bar);
            __builtin_amdgcn_fence(__ATOMIC_ACQUIRE, "agent");
            xb_add(&bar[XB_XGEN(b.x)], 1u);
            asm volatile("s_waitcnt vmcnt(0)" ::: "memory");
        } else {
            XB_SPIN(xb_ld(&bar[XB_XGEN(b.x)]) == gen, bar);
            __builtin_amdgcn_fence(__ATOMIC_ACQUIRE, "agent");
            asm volatile("s_waitcnt vmcnt(0)" ::: "memory");
        }
    }
    __syncthreads();
}

__global__ void __launch_bounds__(256, 2) mega(Params P) {
    extern __shared__ __attribute__((aligned(16))) unsigned char lds[];
    cg::grid_group grid = cg::this_grid();
    const int tid = threadIdx.x, lane = tid & 63, wave = __builtin_amdgcn_readfirstlane(tid >> 6), wm = wave >> 1, wn = wave & 1, fm = lane & 31, hi = lane >> 5;
    const int G = gridDim.x, vb = vblock();
    unsigned char* ws = P.ws;
    float* stat = (float*)(ws + WS_STAT);
    unsigned* cnts = (unsigned*)(ws + WS_CNT);
    float* cosT = (float*)(ws + WS_ROPE);
    float* sinT = cosT + S * 16;
    bf16_t* xb = (bf16_t*)(ws + WS_XB);
    bf16_t* mix = (bf16_t*)(ws + WS_MIX);
    bf16_t* ebuf = mix;
    bf16_t* zb = (bf16_t*)(ws + WS_Z);
    bf16_t* Qb = (bf16_t*)(ws + WS_Q);
    bf16_t* Kb = (bf16_t*)(ws + WS_K);
    bf16_t* Vt = (bf16_t*)(ws + WS_VT);
    bf16_t* ub = (bf16_t*)(ws + WS_U);
    float* xout = P.out;
    float* ep = (float*)(lds + EP_OFF);
    unsigned long long* gran = (unsigned long long*)(ws + WS_GRAN);
    unsigned* gctr = cnts + 4096;
    unsigned gepoch = 0u; (void)gepoch; (void)gctr;
    volatile LAS unsigned* xst = (volatile LAS unsigned*)((LAS unsigned char*)lds + XB_OFF);
    if (tid == 0) { xst[0] = 0u; xst[1] = 0u; }

    auto dump_bf = [&](const bf16_t* buf, int pitch) {
        grid.sync();
        for (int i = vb * 256 + tid; i < T * D; i += G * 256) { const int row = i >> 10, col = i & 1023; xout[i] = bf2f(buf[(size_t)row * pitch + col]); }
    };
    if (PHASES & 1) for (int rep = 0; rep < REPP; ++rep) {
        float* tl = (float*)lds;
        for (int t = vb; t < NL * 3336; t += G) {
            const int l = t / 3336; int r = t % 3336;
            const float* src; const float* gA = nullptr; const float* gB = nullptr; int K, N, Np; size_t off;
            if (r < 576) { src = P.in[3] + (size_t)l * 1024 * 2208; gA = P.in[2] + l * 1024; gB = gA + 512; K = 1024; N = 2208; Np = 2304; off = OW_IN; }
            else if ((r -= 576) < 72) { src = P.in[5] + (size_t)l * 384 * 768; gA = P.in[4] + l * 384; gB = gA + 512; K = 384; N = 768; Np = 768; off = OW_QB; }
            else if ((r -= 72) < 64) { src = P.in[7] + (size_t)l * 256 * 1024; gA = P.in[6] + l * 256; gB = gA + 512; K = 256; N = 1024; Np = 1024; off = OW_KVB; }
            else if ((r -= 64) < 256) { src = P.in[11] + (size_t)l * 1024 * 1024; gA = P.in[9] + l * 512; gB = P.in[10] + l * 512; K = 1024; N = 1024; Np = 1024; off = OW_OUT; }
            else if ((r -= 256) < 1024) { src = P.in[14] + (size_t)l * 1024 * 4096; gA = P.in[13] + l * 1024; gB = gA + 512; K = 1024; N = 4096; Np = 4096; off = OW_UP; }
            else if ((r -= 1024) < 1024) { src = P.in[15] + (size_t)l * 4096 * 1024; K = 4096; N = 1024; Np = 1024; off = OW_DOWN; }
            else if ((r -= 1024) < 256) { src = P.in[18] + (size_t)l * 1024 * 1024; gA = P.in[17] + l * 1024; gB = gA + 512; K = 1024; N = 1024; Np = 1024; off = OW_G; }
            else { r -= 256; src = P.in[19] + (size_t)l * 256 * 1024; K = 256; N = 1024; Np = 1024; off = OW_P; }
            bf16_t* dst = (bf16_t*)(ws + WS_W + (size_t)l * WL_BYTES + off);
            const int nct = Np / 64, k0 = (r / nct) * 64, n0 = (r % nct) * 64;
#pragma unroll
            for (int j = 0; j < 4; ++j) {
                const int kr = (tid >> 4) + 16 * j, n4 = (tid & 15) * 4, k = k0 + kr;
                f32x4 v = (f32x4){0.f, 0.f, 0.f, 0.f};
                if (n0 + n4 < N) v = *(const f32x4*)(src + (size_t)k * N + n0 + n4);
                float g = 1.f;
                if (gA) g = (k < 512) ? gA[k] : gB[k - 512];
                tl[kr * 65 + n4 + 0] = v[0] * g; tl[kr * 65 + n4 + 1] = v[1] * g; tl[kr * 65 + n4 + 2] = v[2] * g; tl[kr * 65 + n4 + 3] = v[3] * g;
            }
            __syncthreads();
            {
                const int n = tid >> 2, kq = (tid & 3) * 16;
                unsigned w[8];
#pragma unroll
                for (int i = 0; i < 8; ++i) w[i] = pk2(tl[(kq + 2 * i) * 65 + n], tl[(kq + 2 * i + 1) * 65 + n]);
                bf16_t* dp = dst + (size_t)(n0 + n) * K + k0 + kq;
                *(u32x4*)dp = (u32x4){w[0], w[1], w[2], w[3]};
                *(u32x4*)(dp + 8) = (u32x4){w[4], w[5], w[6], w[7]};
            }
            __syncthreads();
        }
        const float* x = P.in[0];
        for (int row = vb * 4 + wave; row < T; row += G * 4) {
            float ss = 0.f;
#pragma unroll
            for (int j = 0; j < 4; ++j) {
                const size_t idx = (size_t)row * D + j * 256 + lane * 4;
                const f32x4 v = *(const f32x4*)(x + idx);
                *(u32x2*)(xb + idx) = (u32x2){pk2(v[0], v[1]), pk2(v[2], v[3])};
                ss += v[0] * v[0] + v[1] * v[1] + v[2] * v[2] + v[3] * v[3];
            }
            ss += __shfl_xor(ss, 32); ss += __shfl_xor(ss, 16); ss += __shfl_xor(ss, 8); ss += __shfl_xor(ss, 4); ss += __shfl_xor(ss, 2); ss += __shfl_xor(ss, 1);
            if (lane < 16) stat[((size_t)ST_X0 * T + row) * 16 + lane] = (lane == 0) ? ss : 0.f;
        }
        for (int idx = vb * 256 + tid; idx < NL * 3 * 128; idx += G * 256) cnts[idx] = 0u;
        if (blockIdx.x == 0 && tid == 0) *gctr = 0u;
        for (int idx = vb * 256 + tid; idx < 3 * T * 16 / 2; idx += G * 256) ((u32x4*)gran)[idx] = (u32x4){0u, 0u, 0u, 0u};
        for (int idx = vb * 256 + tid; idx < XCD_BAR_WORDS; idx += G * 256) cnts[8192 + idx] = 0u;
        for (int idx = vb * 256 + tid; idx < S * 16; idx += G * 256) {
            const int s = idx >> 4, j = idx & 15;
            const double base = sqrt(sqrt(sqrt(sqrt(10000.0))));
            double pw = 1.0;
            for (int q = 0; q < j; ++q) pw *= base;
            const float pwf = (float)pw;
            const float inv_freq = 1.0f / pwf;
            const float angf = (float)s * inv_freq;
            const double a = (double)angf;
            const double n = rint(a * 0.15915494309189535);
            const double rr = a - n * 6.283185307179586;
            const double r2 = rr * rr;
            double sn = 0.0, term = rr;
            for (int k = 0; k < 16; ++k) { sn += term; term *= -r2 / (double)((2 * k + 2) * (2 * k + 3)); }
            double cs = 0.0; term = 1.0;
            for (int k = 0; k < 16; ++k) { cs += term; term *= -r2 / (double)((2 * k + 1) * (2 * k + 2)); }
            cosT[idx] = (float)cs; sinT[idx] = (float)sn;
        }
    }
    grid.sync();
    const XcdBarrier xbar = xcd_barrier_post(cnts + 8192, xst);

    for (int l = 0; l < NL; ++l) {
        const unsigned char* wl = ws + WS_W + (size_t)l * WL_BYTES;
        const bf16_t* WIN = (const bf16_t*)(wl + OW_IN);
        const bf16_t* WQB = (const bf16_t*)(wl + OW_QB);
        const bf16_t* WKVB = (const bf16_t*)(wl + OW_KVB);
        const bf16_t* WOUT = (const bf16_t*)(wl + OW_OUT);
        const bf16_t* WUP = (const bf16_t*)(wl + OW_UP);
        const bf16_t* WDOWN = (const bf16_t*)(wl + OW_DOWN);
        const bf16_t* WG = (const bf16_t*)(wl + OW_G);
        const bf16_t* WP = (const bf16_t*)(wl + OW_P);
        float* st = stat;

        if (PHASES & 2) for (int t = vb; t < 128 * 12; t += G) {
            const int tid = opq(threadIdx.x), lane = tid & 63, wave = __builtin_amdgcn_readfirstlane(tid >> 6), wm = wave >> 1, wn = wave & 1, fm = lane & 31, hi = lane >> 5;
            int panel = t / 12, ct = t % 12;
            if (G == 512) { const int M = (t >> 9) * 8 + (vb >> 6), q = vb & 63; panel = (M / 3) * 16 + (q >> 2); ct = (M % 3) * 4 + (q & 3); }
            const int row0 = panel * 128, col0 = ct * 192;
            if (tid < 128) ep[tid] = rsqrtf(sum_slots(st + ((size_t)ST_X0 * T + row0 + tid) * 16, 16) * (1.0f / 1024.0f) + EPS);
            f32x16 acc[2][3];
            gemm_mainloop_w3(xb + (size_t)row0 * D, D, WIN + (size_t)col0 * D, D, D, lds, acc);
            const int grp = 2 * ct + wn;
#pragma unroll
            for (int mt = 0; mt < 2; ++mt) {
                float ss[16], rs[16];
#pragma unroll
                for (int r = 0; r < 16; ++r) { ss[r] = 0.f; rs[r] = ep[wm * 64 + mt * 32 + crow(r, hi)]; }
#pragma unroll
                for (int nt = 0; nt < 3; ++nt) {
                    const int col = col0 + wn * 96 + nt * 32 + fm;
                    const bool cnt = (grp < 6) || (nt < 2);
#pragma unroll
                    for (int r = 0; r < 16; ++r) {
                        const float v = acc[mt][nt][r] * rs[r];
                        zb[(size_t)(row0 + wm * 64 + mt * 32 + crow(r, hi)) * ZW + col] = f2bf(v);
                        if (cnt) ss[r] += v * v;
                    }
                }
                if (grp < 7) {
                    const float tot = rowsum32(ss, lane);
                    float* pp = st + ((size_t)(grp < 4 ? ST_QA : ST_KVA) * T + row0 + wm * 64 + mt * 32 + crow((lane >> 1) & 15, hi)) * 16 + (grp < 4 ? grp : grp - 4);
                    if ((lane & 1) == 0) *pp = tot;
                }
            }
            __syncthreads();
        }
        xcd_barrier(xbar);

        if (STOP == 1) { dump_bf(zb, ZW); return; }
        if (PHASES & 4) for (int t = vb; t < 128 * 14; t += G) {
            const int tid = opq(threadIdx.x), lane = tid & 63, wave = __builtin_amdgcn_readfirstlane(tid >> 6), wm = wave >> 1, wn = wave & 1, fm = lane & 31, hi = lane >> 5; (void)wm; (void)wn; (void)fm; (void)hi; (void)wave; (void)lane;
            f32x16 acc[2][2];
            if (t < 128 * 6) {
                const int panel = t / 6, ct = t % 6, row0 = panel * 128, col0 = ct * 128;
                if (tid < 128) ep[tid] = rsqrtf(sum_slots(st + ((size_t)ST_QA * T + row0 + tid) * 16, 4) * (1.0f / 384.0f) + EPS);
                gemm_mainloop<false>(zb + (size_t)row0 * ZW, ZW, WQB + (size_t)col0 * 384, 384, 384, lds, acc);
#pragma unroll
                for (int mt = 0; mt < 2; ++mt) {
                    float rs[16];
#pragma unroll
                    for (int r = 0; r < 16; ++r) rs[r] = ep[wm * 64 + mt * 32 + crow(r, hi)] * QSCALE;
#pragma unroll
                    for (int nt = 0; nt < 2; ++nt) {
                        const int c32 = col0 + wn * 64 + nt * 32;
                        const int h = c32 / 96, dh = c32 % 96;
                        const bool rope = (dh == 64);
#pragma unroll
                        for (int r = 0; r < 16; ++r) {
                            const int row = row0 + wm * 64 + mt * 32 + crow(r, hi);
                            const int b = row >> 12, s = row & 4095;
                            float v = acc[mt][nt][r] * rs[r];
                            if (rope) {
                                const float pr = __shfl_xor(v, 16);
                                const float c = cosT[s * 16 + (fm & 15)], sn = sinT[s * 16 + (fm & 15)];
                                v = (fm < 16) ? (v * c - pr * sn) : (v * c + pr * sn);
                            }
                            Qb[((size_t)(b * NH + h) * S + s) * 96 + dh + fm] = f2bf(v);
                        }
                    }
                }
            } else {
                const int t2 = t - 128 * 6;
                const int panel = t2 / 8, ct = t2 % 8, row0 = panel * 128, col0 = ct * 128;
                if (tid < 128) ep[tid] = rsqrtf(sum_slots(st + ((size_t)ST_KVA * T + row0 + tid) * 16, 3) * (1.0f / 256.0f) + EPS);
                gemm_mainloop<false>(zb + (size_t)row0 * ZW + 384, ZW, WKVB + (size_t)col0 * 256, 256, 256, lds, acc);
                const int h = ct;
#pragma unroll
                for (int mt = 0; mt < 2; ++mt) {
                    float rs[16];
#pragma unroll
                    for (int r = 0; r < 16; ++r) rs[r] = ep[wm * 64 + mt * 32 + crow(r, hi)];
                    const int rbase = row0 + wm * 64 + mt * 32;
                    const int b = rbase >> 12;
#pragma unroll
                    for (int nt = 0; nt < 2; ++nt) {
                        const int d = nt * 32 + fm;
                        if (wn == 0) {
#pragma unroll
                            for (int r = 0; r < 16; ++r) {
                                const int s = (rbase + crow(r, hi)) & 4095;
                                Kb[((size_t)(b * NH + h) * S + s) * 96 + d] = f2bf(acc[mt][nt][r] * rs[r]);
                            }
                        } else {
#pragma unroll
                            for (int g = 0; g < 4; ++g) {
                                const int s = (rbase + 8 * g + 4 * hi) & 4095;
                                const u32x2 w = (u32x2){pk2(acc[mt][nt][4 * g] * rs[4 * g], acc[mt][nt][4 * g + 1] * rs[4 * g + 1]),
                                                         pk2(acc[mt][nt][4 * g + 2] * rs[4 * g + 2], acc[mt][nt][4 * g + 3] * rs[4 * g + 3])};
                                *(u32x2*)(Vt + ((size_t)(b * NH + h) * 64 + d) * S + s) = w;
                            }
                        }
                    }
                }
            }
            __syncthreads();
        }
        if (PHASES & 8) {
            const float* wc = P.in[8] + (size_t)l * 3 * 512;
            for (int row = vb * 4 + wave; row < T; row += G * 4) {
                const int tid = opq(threadIdx.x), lane = tid & 63, wave_ = 0, wm = 0, wn = 0, fm = lane & 31, hi = lane >> 5; (void)wm; (void)wn; (void)fm; (void)hi; (void)wave_; (void)lane;
                const int s = row & 4095, b = row >> 12;
                const bf16_t* zr = zb + (size_t)row * ZW;
                const int c0 = 8 * lane;
                const u32x4 gbv = *(const u32x4*)(zr + 672 + c0);
                const u32x4 gc1 = *(const u32x4*)(zr + 1184 + c0), ci1 = *(const u32x4*)(zr + 1696 + c0);
                u32x4 gc0 = (u32x4){0, 0, 0, 0}, ci0 = gc0, gc2 = gc0, ci2 = gc0;
                if (s > 0) { gc0 = *(const u32x4*)(zr - ZW + 1184 + c0); ci0 = *(const u32x4*)(zr - ZW + 1696 + c0); }
                if (s < S - 1) { gc2 = *(const u32x4*)(zr + ZW + 1184 + c0); ci2 = *(const u32x4*)(zr + ZW + 1696 + c0); }
                const f32x4 w0a = *(const f32x4*)(wc + c0), w0b = *(const f32x4*)(wc + c0 + 4);
                const f32x4 w1a = *(const f32x4*)(wc + 512 + c0), w1b = *(const f32x4*)(wc + 512 + c0 + 4);
                const f32x4 w2a = *(const f32x4*)(wc + 1024 + c0), w2b = *(const f32x4*)(wc + 1024 + c0 + 4);
                float cv[8]; float ss = 0.f;
#pragma unroll
                for (int i = 0; i < 4; ++i) {
                    const unsigned a0 = gc0[i], a1 = gc1[i], a2 = gc2[i], d0 = ci0[i], d1 = ci1[i], d2 = ci2[i], gw = gbv[i];
                    const float wlo0 = (i < 2) ? w0a[2 * i] : w0b[2 * i - 4], whi0 = (i < 2) ? w0a[2 * i + 1] : w0b[2 * i - 3];
                    const float wlo1 = (i < 2) ? w1a[2 * i] : w1b[2 * i - 4], whi1 = (i < 2) ? w1a[2 * i + 1] : w1b[2 * i - 3];
                    const float wlo2 = (i < 2) ? w2a[2 * i] : w2b[2 * i - 4], whi2 = (i < 2) ? w2a[2 * i + 1] : w2b[2 * i - 3];
                    const float lo = bflo(gw) * (wlo0 * bflo(a0) * bflo(d0) + wlo1 * bflo(a1) * bflo(d1) + wlo2 * bflo(a2) * bflo(d2));
                    const float hv = bfhi(gw) * (whi0 * bfhi(a0) * bfhi(d0) + whi1 * bfhi(a1) * bfhi(d1) + whi2 * bfhi(a2) * bfhi(d2));
                    cv[2 * i] = lo; cv[2 * i + 1] = hv; ss += lo * lo + hv * hv;
                }
                ss += __shfl_xor(ss, 1); ss += __shfl_xor(ss, 2); ss += __shfl_xor(ss, 4);
                const float rn = rsqrtf(ss * (1.0f / 64.0f) + EPS);
                *(u32x4*)(mix + (size_t)row * D + 512 + c0) = (u32x4){pk2(cv[0] * rn, cv[1] * rn), pk2(cv[2] * rn, cv[3] * rn), pk2(cv[4] * rn, cv[5] * rn), pk2(cv[6] * rn, cv[7] * rn)};
                if (lane < 16) {
                    const float a = bf2f(zr[640 + lane]), bb = bf2f(zr[656 + lane]);
                    const float c = cosT[s * 16 + lane], sn = sinT[s * 16 + lane];
                    const bf16_t o1 = f2bf(a * c - bb * sn), o2 = f2bf(bb * c + a * sn);
#pragma unroll
                    for (int h = 0; h < NH; ++h) {
                        bf16_t* kp = Kb + ((size_t)(b * NH + h) * S + s) * 96;
                        kp[64 + lane] = o1; kp[80 + lane] = o2;
                    }
                }
            }
        }
        xcd_barrier(xbar);

        if (STOP == 2) { dump_bf(Qb, 768); return; }
        if (STOP == 12) { dump_bf(Kb, 768); return; }
        if (STOP == 22) { dump_bf(Vt, 512); return; }
        if (STOP == 32) { dump_bf(mix, 1024); return; }
        if (PHASES & 16) for (int rep = 0; rep < REPA; ++rep) for (int it = vb; it < 32 * 16; it += G) {
            const int tid = opq(threadIdx.x), lane = tid & 63, wave = __builtin_amdgcn_readfirstlane(tid >> 6), fm = lane & 31, hi = lane >> 5;
            const int bh = it >> 4, qb = it & 15, b = bh >> 3, h = bh & 7;
            const bf16_t* Qp = Qb + ((size_t)bh * S + qb * 256 + wave * 64 + fm) * 96 + hi * 8;
            const bf16_t* Kp = Kb + (size_t)bh * S * 96;
            const bf16_t* Vp = Vt + (size_t)bh * 64 * S;
            bf16x8 qf[2][6];
#pragma unroll
            for (int u = 0; u < 2; ++u)
#pragma unroll
                for (int d0 = 0; d0 < 6; ++d0) qf[u][d0] = *(const bf16x8*)(Qp + (size_t)u * 32 * 96 + d0 * 16);
            f32x16 o[2][2];
#pragma unroll
            for (int u = 0; u < 2; ++u)
#pragma unroll
                for (int r = 0; r < 16; ++r) { o[u][0][r] = 0.f; o[u][1][r] = 0.f; }
            float mhat[2] = {0.f, 0.f}, lrun[2] = {0.f, 0.f};
            u32x4 kr[3], vr[2];
            const int pim = (fm & ~12) | ((fm & 4) << 1) | ((fm & 8) >> 1);
            const int koff = pim * KROW + hi * 16, voff = fm * VROW + hi * 16;
            auto loadkv = [&](int kv0) __attribute__((always_inline)) {
#pragma unroll
                for (int i = 0; i < 3; ++i) kr[i] = *(const u32x4*)(Kp + (size_t)kv0 * 96 + (tid + 256 * i) * 8);
#pragma unroll
                for (int i = 0; i < 2; ++i) { const int c = tid + 256 * i; vr[i] = *(const u32x4*)(Vp + (size_t)(c >> 3) * S + kv0 + (c & 7) * 8); }
            };
            auto storekv = [&](int buf) __attribute__((always_inline)) {
                unsigned char* kb = lds + buf * (KT_BYTES + VT_BYTES);
                unsigned char* vbp = kb + KT_BYTES;
#pragma unroll
                for (int i = 0; i < 3; ++i) { const int c = tid + 256 * i; *(u32x4*)(kb + (c / 12) * KROW + (c % 12) * 16) = kr[i]; }
#pragma unroll
                for (int i = 0; i < 2; ++i) { const int c = tid + 256 * i; *(u32x4*)(vbp + (c >> 3) * VROW + (c & 7) * 16) = vr[i]; }
            };
            loadkv(0); storekv(0); __syncthreads();
            for (int kt = 0; kt < 64; ++kt) {
                if (kt + 1 < 64) loadkv((kt + 1) * 64);
                __builtin_amdgcn_sched_barrier(0);
                const unsigned char* kb = lds + (kt & 1) * (KT_BYTES + VT_BYTES);
                const unsigned char* vbp = kb + KT_BYTES;
                f32x16 p[2][2];
#pragma unroll
                for (int d0 = 0; d0 < 6; ++d0) {
                    const bf16x8 k0 = *(const bf16x8*)(kb + koff + d0 * 32), k1 = *(const bf16x8*)(kb + koff + 32 * KROW + d0 * 32);
#pragma unroll
                    for (int u = 0; u < 2; ++u) {
                        if (d0 == 0) {
                            p[u][0] = __builtin_amdgcn_mfma_f32_32x32x16_bf16(k0, qf[u][0], (f32x16){0.f,0.f,0.f,0.f,0.f,0.f,0.f,0.f,0.f,0.f,0.f,0.f,0.f,0.f,0.f,0.f}, 0, 0, 0);
                            p[u][1] = __builtin_amdgcn_mfma_f32_32x32x16_bf16(k1, qf[u][0], (f32x16){0.f,0.f,0.f,0.f,0.f,0.f,0.f,0.f,0.f,0.f,0.f,0.f,0.f,0.f,0.f,0.f}, 0, 0, 0);
                        } else {
                            p[u][0] = __builtin_amdgcn_mfma_f32_32x32x16_bf16(k0, qf[u][d0], p[u][0], 0, 0, 0);
                            p[u][1] = __builtin_amdgcn_mfma_f32_32x32x16_bf16(k1, qf[u][d0], p[u][1], 0, 0, 0);
                        }
                    }
                }
#pragma unroll
                for (int u = 0; u < 2; ++u) {
                    float mx = p[u][0][0];
#pragma unroll
                    for (int r = 0; r < 16; ++r) mx = fmaxf(fmaxf(mx, p[u][0][r]), p[u][1][r]);
                    mx = fmaxf(mx, __shfl_xor(mx, 32));
                    if (kt == 0 || __any(mx - mhat[u] > 8.0f)) {
                        const float nm = (kt == 0) ? mx : fmaxf(mx, mhat[u]);
                        const float f = (kt == 0) ? 1.0f : __builtin_amdgcn_exp2f(mhat[u] - nm);
                        mhat[u] = nm; lrun[u] *= f;
#pragma unroll
                        for (int r = 0; r < 16; ++r) { o[u][0][r] *= f; o[u][1][r] *= f; }
                    }
                }
                auto soft = [&](int u, bf16x8 (&pfu)[4]) __attribute__((always_inline)) {
                    const float mh = mhat[u];
#pragma unroll
                    for (int r = 0; r < 16; ++r) { p[u][0][r] = __builtin_amdgcn_exp2f(p[u][0][r] - mh); p[u][1][r] = __builtin_amdgcn_exp2f(p[u][1][r] - mh); }
                    {
                        const f32x16 t = p[u][0] + p[u][1];
                        float rsum = ((t[0] + t[1]) + (t[2] + t[3])) + ((t[4] + t[5]) + (t[6] + t[7]));
                        rsum += ((t[8] + t[9]) + (t[10] + t[11])) + ((t[12] + t[13]) + (t[14] + t[15]));
                        lrun[u] += rsum;
                    }
#pragma unroll
                    for (int c = 0; c < 4; ++c) {
                        const int mt = c >> 1, r0 = (c & 1) * 8;
                        const u32x4 w = (u32x4){pk2(p[u][mt][r0], p[u][mt][r0 + 1]), pk2(p[u][mt][r0 + 2], p[u][mt][r0 + 3]), pk2(p[u][mt][r0 + 4], p[u][mt][r0 + 5]), pk2(p[u][mt][r0 + 6], p[u][mt][r0 + 7])};
                        pfu[c] = __builtin_bit_cast(bf16x8, w);
                    }
                };
                auto pvm = [&](int u, const bf16x8 (&pfu)[4]) __attribute__((always_inline)) {
#pragma unroll
                    for (int c = 0; c < 4; ++c) {
                        const bf16x8 v0 = *(const bf16x8*)(vbp + voff + c * 32), v1 = *(const bf16x8*)(vbp + voff + 32 * VROW + c * 32);
                        o[u][0] = __builtin_amdgcn_mfma_f32_32x32x16_bf16(v0, pfu[c], o[u][0], 0, 0, 0);
                        o[u][1] = __builtin_amdgcn_mfma_f32_32x32x16_bf16(v1, pfu[c], o[u][1], 0, 0, 0);
                    }
                };
                bf16x8 pfa[4], pfb[4];
                soft(0, pfa);
                pvm(0, pfa);
                soft(1, pfb);
#pragma unroll
                for (int i = 0; i < 8; ++i) { __builtin_amdgcn_sched_group_barrier(0x008, 1, 0); __builtin_amdgcn_sched_group_barrier(0x002, 10, 0); }
                pvm(1, pfb);
                if (kt + 1 < 64) storekv((kt + 1) & 1);
                __syncthreads();
            }
#pragma unroll
            for (int u = 0; u < 2; ++u) {
                const float ltot = lrun[u] + __shfl_xor(lrun[u], 32);
                const float inv = 1.0f / ltot;
                float ss = 0.f;
#pragma unroll
                for (int r = 0; r < 16; ++r) { o[u][0][r] *= inv; o[u][1][r] *= inv; ss += o[u][0][r] * o[u][0][r] + o[u][1][r] * o[u][1][r]; }
                ss += __shfl_xor(ss, 32);
                const float rn = rsqrtf(ss * (1.0f / 64.0f) + EPS);
                bf16_t* mp = mix + (size_t)(b * S + qb * 256 + wave * 64 + u * 32 + fm) * D + h * 64 + 4 * hi;
#pragma unroll
                for (int d0 = 0; d0 < 2; ++d0)
#pragma unroll
                    for (int g = 0; g < 4; ++g)
                        *(u32x2*)(mp + d0 * 32 + 8 * g) = (u32x2){pk2(o[u][d0][4 * g] * rn, o[u][d0][4 * g + 1] * rn), pk2(o[u][d0][4 * g + 2] * rn, o[u][d0][4 * g + 3] * rn)};
            }
        }
        xcd_barrier(xbar);

        if (STOP == 3) { dump_bf(mix, 1024); return; }
        if (PHASES & 32) for (int t = vb; t < 128 * 4; t += G) {
            const int panel = t >> 2, ct = t & 3, row0 = panel * 128, col0 = ct * 256;
            f32x16 acc[2][4];
            gemm_mainloop_w(mix + (size_t)row0 * D, D, WOUT + (size_t)col0 * D, D, D, lds, acc);
            exch_epilogue_w(acc, row0, col0, gran + (size_t)0 * T * 16, (unsigned)(l * 4 + 1), P.in[12] + l * D, xout, xb, st + (size_t)ST_X1 * T * 16, ep);
            __syncthreads();
        }
        xcd_barrier(xbar);

        if (STOP == 4) { return; }
        if (PHASES & 64) for (int t = vb; t < 2048 + 1024; t += G) {
            const int tid = opq(threadIdx.x), lane = tid & 63, wave = __builtin_amdgcn_readfirstlane(tid >> 6), wm = wave >> 1, wn = wave & 1, fm = lane & 31, hi = lane >> 5; (void)lane;
            if (t < 2048) {
                int panel = t >> 4, ct = t & 15;
                if (G == 512) { const int M = (t >> 9) * 8 + (vb >> 6), q = vb & 63; panel = (M >> 1) * 8 + (q >> 3); ct = (M & 1) * 8 + (q & 7); }
                const int row0 = panel * 128, col0 = ct * 256;
                if (tid < 128) ep[tid] = rsqrtf(sum_slots(st + ((size_t)ST_X1 * T + row0 + tid) * 16, 8) * (1.0f / 1024.0f) + EPS);
                f32x16 acc[2][4];
                gemm_mainloop_w(xb + (size_t)row0 * D, D, WUP + (size_t)col0 * D, D, D, lds, acc);
#pragma unroll
                for (int mt = 0; mt < 2; ++mt) {
                    float rs[16];
#pragma unroll
                    for (int r = 0; r < 16; ++r) rs[r] = ep[wm * 64 + mt * 32 + crow(r, hi)];
#pragma unroll
                    for (int nt = 0; nt < 4; ++nt) {
                        const int col = col0 + wn * 128 + nt * 32 + fm;
#pragma unroll
                        for (int r = 0; r < 16; ++r) {
                            const float v = fmaxf(acc[mt][nt][r] * rs[r], 0.f);
                            ub[(size_t)(row0 + wm * 64 + mt * 32 + crow(r, hi)) * FF + col] = f2bf(v * v);
                        }
                    }
                }
            } else {
                const int t2 = t - 2048;
                const int panel = t2 >> 3, ct = t2 & 7, row0 = panel * 128, col0 = ct * 128;
                f32x16 acc[2][2];
                gemm_mainloop<true>(P.in[1] + ((size_t)l * T + row0) * 256, 256, WP + (size_t)col0 * 256, 256, 256, lds, acc);
#pragma unroll
                for (int mt = 0; mt < 2; ++mt)
#pragma unroll
                    for (int nt = 0; nt < 2; ++nt) {
                        const int col = col0 + wn * 64 + nt * 32 + fm;
#pragma unroll
                        for (int r = 0; r < 16; ++r) ebuf[(size_t)(row0 + wm * 64 + mt * 32 + crow(r, hi)) * D + col] = f2bf(acc[mt][nt][r]);
                    }
            }
            __syncthreads();
        }
        xcd_barrier(xbar);

        if (STOP == 5) { dump_bf(ub, 4096); return; }
        if (STOP == 15) { dump_bf(ebuf, 1024); return; }
        if (PHASES & 128) for (int t = vb; t < 128 * 4; t += G) {
            const int panel = t >> 2, ct = t & 3, row0 = panel * 128, col0 = ct * 256;
            f32x16 acc[2][4];
            gemm_mainloop_w(ub + (size_t)row0 * FF, FF, WDOWN + (size_t)col0 * FF, FF, FF, lds, acc);
            exch_epilogue_w(acc, row0, col0, gran + (size_t)1 * T * 16, (unsigned)(l * 4 + 2), P.in[16] + l * D, xout, xb, st + (size_t)ST_X2 * T * 16, ep);
            __syncthreads();
        }
        xcd_barrier(xbar);

        if (STOP == 6) { return; }
        if (PHASES & 256) for (int t = vb; t < 128 * 8; t += G) {
            const int tid = opq(threadIdx.x), lane = tid & 63, wave = __builtin_amdgcn_readfirstlane(tid >> 6), wm = wave >> 1, wn = wave & 1, fm = lane & 31, hi = lane >> 5; (void)wm; (void)wn; (void)fm; (void)hi; (void)wave; (void)lane;
            const int panel = t >> 3, ct = t & 7, row0 = panel * 128, col0 = ct * 128;
            if (tid < 128) ep[tid] = rsqrtf(sum_slots(st + ((size_t)ST_X2 * T + row0 + tid) * 16, 8) * (1.0f / 1024.0f) + EPS);
            f32x16 acc[2][2];
            gemm_mainloop<false>(xb + (size_t)row0 * D, D, WG + (size_t)col0 * D, D, D, lds, acc);
#pragma unroll
            for (int mt = 0; mt < 2; ++mt) {
                float rs[16];
#pragma unroll
                for (int r = 0; r < 16; ++r) rs[r] = ep[wm * 64 + mt * 32 + crow(r, hi)];
#pragma unroll
                for (int nt = 0; nt < 2; ++nt) {
                    const int col = col0 + wn * 64 + nt * 32 + fm;
#pragma unroll
                    for (int r = 0; r < 16; ++r) {
                        const float gte = 1.0f / (1.0f + __expf(-acc[mt][nt][r] * rs[r]));
                        acc[mt][nt][r] = gte * bf2f(ebuf[(size_t)(row0 + wm * 64 + mt * 32 + crow(r, hi)) * D + col]);
                    }
                }
            }
            exch_epilogue(acc, row0, col0, gran + (size_t)2 * T * 16, (unsigned)(l * 4 + 3), P.in[20] + l * D, (l == NL - 1) ? xout : nullptr, xb, st + (size_t)ST_X0 * T * 16, ep);
            __syncthreads();
        }
        if (STOP == 7) return;
        if (l + 1 < NL) xcd_barrier(xbar);
    }
}

extern "C" void kernel_launch(void* const* d_in, const int* in_sizes, int n_in, void* d_out, int out_size, void* d_ws, size_t ws_size, hipStream_t stream) {
    static int grid = 0;
    if (grid == 0) {
        if (n_in != 21 || out_size != T * D || ws_size < WS_END) { fprintf(stderr, "kernel_launch: unexpected problem (n_in %d out %d ws %zu)\n", n_in, out_size, ws_size); grid = -1; return; }
        int dev = 0, cus = 0, per_cu = 0;
        hipGetDevice(&dev);
        hipDeviceGetAttribute(&cus, hipDeviceAttributeMultiprocessorCount, dev);
        if (hipFuncSetAttribute((const void*)mega, hipFuncAttributeMaxDynamicSharedMemorySize, LDS_BYTES) != hipSuccess) { fprintf(stderr, "hipFuncSetAttribute failed\n"); grid = -1; return; }
        if (hipOccupancyMaxActiveBlocksPerMultiprocessor(&per_cu, (const void*)mega, 256, LDS_BYTES) != hipSuccess || per_cu < 1) { fprintf(stderr, "occupancy query failed (%d)\n", per_cu); per_cu = 1; }
        if (per_cu > 2) per_cu = 2;
        grid = (cus * per_cu) & ~7;
        fprintf(stderr, "kernel_launch: cus %d per_cu %d grid %d\n", cus, per_cu, grid);
    }
    if (grid < 0) return;
    Params p{};
    for (int i = 0; i < 21; ++i) p.in[i] = (const float*)d_in[i];
    p.out = (float*)d_out; p.ws = (unsigned char*)d_ws;
    void* args[] = {&p};
    hipError_t e = hipLaunchCooperativeKernel((const void*)mega, dim3(grid), dim3(256), args, LDS_BYTES, stream);
    if (e != hipSuccess) fprintf(stderr, "cooperative launch failed: %s (grid %d)\n", hipGetErrorString(e), grid);
}
```

```cpp
#include <hip/hip_runtime.h>
#include <hip/hip_cooperative_groups.h>
#include <cstdio>
#include <cstdint>
namespace cg = cooperative_groups;

typedef unsigned short bf16_t;
typedef short bf16x8 __attribute__((ext_vector_type(8)));
typedef float f32x16 __attribute__((ext_vector_type(16)));
typedef float f32x4 __attribute__((ext_vector_type(4)));
typedef unsigned u32x4 __attribute__((ext_vector_type(4)));
typedef unsigned u32x2 __attribute__((ext_vector_type(2)));

constexpr int T = 16384, S = 4096, D = 1024, NL = 4, NH = 8, ZW = 2304, FF = 4096;
constexpr float EPS = 1e-6f;
constexpr float QSCALE = 0.10206207261596575f * 1.4426950408889634f;

constexpr size_t MiB = (size_t)1 << 20;
constexpr size_t WS_STAT = 0;
constexpr size_t WS_CNT = 8 * MiB;
constexpr size_t WS_ROPE = 9 * MiB;
constexpr size_t WS_W = 10 * MiB;
constexpr size_t WL_BYTES = 27328512;
constexpr size_t OW_IN = 0, OW_QB = 4718592, OW_KVB = 5308416, OW_OUT = 5832704, OW_UP = 7929856, OW_DOWN = 16318464, OW_G = 24707072, OW_P = 26804224;
constexpr size_t WS_XB = 115 * MiB;
constexpr size_t WS_MIX = 147 * MiB;
constexpr size_t WS_Z = 179 * MiB;
constexpr size_t WS_Q = 251 * MiB;
constexpr size_t WS_K = 275 * MiB;
constexpr size_t WS_VT = 299 * MiB;
constexpr size_t WS_U = 179 * MiB;
constexpr size_t WS_GRAN = 315 * MiB;
constexpr size_t WS_END = 321 * MiB;

enum { ST_X0 = 0, ST_QA = 1, ST_KVA = 2, ST_Y1 = 3, ST_X1 = 4, ST_F = 5, ST_X2 = 6, ST_T = 7 };

constexpr int LROW = 144;
constexpr int TILE_BYTES = 128 * LROW;
constexpr int EP_OFF = 4 * TILE_BYTES;
constexpr int XB_OFF = EP_OFF + 1024;
constexpr int LDS_BYTES = XB_OFF + 64;
constexpr int KROW = 208, VROW = 144;
constexpr int KT_BYTES = 64 * KROW, VT_BYTES = 64 * VROW;

#ifndef PHASES
#define PHASES 511
#endif
#ifndef REPG
#define REPG 1
#endif
#ifndef REPA
#define REPA 1
#endif
#ifndef REPP
#define REPP 1
#endif
#ifndef STOP
#define STOP 0
#endif
struct Params { const float* in[21]; float* out; unsigned char* ws; };

typedef float f32x2_t __attribute__((ext_vector_type(2)));
typedef __bf16 bf16x2_t __attribute__((ext_vector_type(2)));
__device__ __forceinline__ unsigned pk2(float lo, float hi) { const f32x2_t v = {lo, hi}; const bf16x2_t b = __builtin_convertvector(v, bf16x2_t); return __builtin_bit_cast(unsigned, b); }
__device__ __forceinline__ bf16_t f2bf(float f) { return (bf16_t)(pk2(f, 0.f) & 0xffffu); }
__device__ __forceinline__ float bf2f(bf16_t b) { return __uint_as_float(((unsigned)b) << 16); }
__device__ __forceinline__ float bflo(unsigned w) { return __uint_as_float(w << 16); }
__device__ __forceinline__ float bfhi(unsigned w) { return __uint_as_float(w & 0xffff0000u); }
__device__ __forceinline__ int opq(int v) { asm volatile("" : "+v"(v)); return v; }
__device__ __forceinline__ int crow(int r, int hi) { return (r & 3) + 8 * (r >> 2) + 4 * hi; }
__device__ __forceinline__ int vblock() { const int G = gridDim.x, b = blockIdx.x; return (G % 8 == 0) ? (b % 8) * (G / 8) + b / 8 : b; }
__device__ __forceinline__ void st_wt(float* p, float v) { __hip_atomic_store(p, v, __ATOMIC_RELAXED, __HIP_MEMORY_SCOPE_AGENT); }
__device__ __forceinline__ float atomic_ldf(const float* p) { return __hip_atomic_load(p, __ATOMIC_RELAXED, __HIP_MEMORY_SCOPE_AGENT); }
__device__ __forceinline__ float sum_slots(const float* p, int nslot) {
    const f32x4* q = (const f32x4*)p; float s = 0.f;
    for (int i = 0; i < (nslot >> 2); ++i) { const f32x4 a = q[i]; s += (a[0] + a[1]) + (a[2] + a[3]); }
    for (int i = nslot & ~3; i < nslot; ++i) s += p[i];
    return s;
}

__device__ __forceinline__ float rowsum32(const float (&s)[16], int lane) {
    const bool b4 = lane & 16, b3 = lane & 8, b2 = lane & 4, b1 = lane & 2;
    float a[8], b[4], c[2], d;
#pragma unroll
    for (int i = 0; i < 8; ++i) { const float keep = b4 ? s[8 + i] : s[i], send = b4 ? s[i] : s[8 + i]; a[i] = keep + __shfl_xor(send, 16); }
#pragma unroll
    for (int i = 0; i < 4; ++i) { const float keep = b3 ? a[4 + i] : a[i], send = b3 ? a[i] : a[4 + i]; b[i] = keep + __shfl_xor(send, 8); }
#pragma unroll
    for (int i = 0; i < 2; ++i) { const float keep = b2 ? b[2 + i] : b[i], send = b2 ? b[i] : b[2 + i]; c[i] = keep + __shfl_xor(send, 4); }
    { const float keep = b1 ? c[1] : c[0], send = b1 ? c[0] : c[1]; d = keep + __shfl_xor(send, 2); }
    d += __shfl_xor(d, 1);
    return d;
}

template <bool AF32>
__device__ __forceinline__ void gemm_mainloop(const void* __restrict__ Ap, int lda, const bf16_t* __restrict__ Bt, int ldb, int K,
                                              unsigned char* smem, f32x16 (&acc)[2][2]) {
    const int tid = opq(threadIdx.x), lane = tid & 63, wave = __builtin_amdgcn_readfirstlane(tid >> 6), wm = wave >> 1, wn = wave & 1, fm = lane & 31, hi = lane >> 5;
    const int srow = tid >> 3, skc = tid & 7;
    u32x4 ra0[4], rb0[4], ra1[4], rb1[4];
    u32x4 rx0[AF32 ? 4 : 1], rx1[AF32 ? 4 : 1];
#pragma unroll
    for (int i = 0; i < 2; ++i)
#pragma unroll
        for (int j = 0; j < 2; ++j)
#pragma unroll
            for (int r = 0; r < 16; ++r) acc[i][j][r] = 0.f;
    const int aoff = (wm * 64 + fm) * LROW + hi * 16, boff = (wn * 64 + fm) * LROW + hi * 16;
    const int soff = srow * LROW + skc * 16;
    const unsigned la = (unsigned)(srow * lda + skc * 8), lb = (unsigned)(srow * ldb + skc * 8);
    auto loadt = [&](int k0, u32x4 (&ra)[4], u32x4 (&rx)[AF32 ? 4 : 1], u32x4 (&rb)[4]) __attribute__((always_inline)) {
#pragma unroll
        for (int i = 0; i < 4; ++i) {
            if (AF32) {
                const float* ap = (const float*)Ap + (size_t)(32 * i) * lda + k0;
                ra[i] = *(const u32x4*)(ap + la); rx[i] = *(const u32x4*)(ap + la + 4);
            } else {
                const bf16_t* ap = (const bf16_t*)Ap + (size_t)(32 * i) * lda + k0;
                ra[i] = *(const u32x4*)(ap + la);
            }
            const bf16_t* bp = Bt + (size_t)(32 * i) * ldb + k0;
            rb[i] = *(const u32x4*)(bp + lb);
        }
    };
    auto storet = [&](int buf, const u32x4 (&ra)[4], const u32x4 (&rx)[AF32 ? 4 : 1], const u32x4 (&rb)[4]) __attribute__((always_inline)) {
        unsigned char* a = smem + buf * 2 * TILE_BYTES;
        unsigned char* b = a + TILE_BYTES;
#pragma unroll
        for (int i = 0; i < 4; ++i) {
            u32x4 av = ra[i];
            if (AF32) av = (u32x4){pk2(__uint_as_float(ra[i][0]), __uint_as_float(ra[i][1])), pk2(__uint_as_float(ra[i][2]), __uint_as_float(ra[i][3])),
                                   pk2(__uint_as_float(rx[i][0]), __uint_as_float(rx[i][1])), pk2(__uint_as_float(rx[i][2]), __uint_as_float(rx[i][3]))};
            *(u32x4*)(a + soff + i * 32 * LROW) = av; *(u32x4*)(b + soff + i * 32 * LROW) = rb[i];
        }
    };
    auto compute = [&](int buf) __attribute__((always_inline)) {
        const unsigned char* a = smem + buf * 2 * TILE_BYTES;
        const unsigned char* b = a + TILE_BYTES;
        __builtin_amdgcn_s_setprio(1);
#pragma unroll
        for (int kk = 0; kk < 4; ++kk) {
            const bf16x8 a0 = *(const bf16x8*)(a + aoff + kk * 32), a1 = *(const bf16x8*)(a + aoff + 32 * LROW + kk * 32);
            const bf16x8 b0 = *(const bf16x8*)(b + boff + kk * 32), b1 = *(const bf16x8*)(b + boff + 32 * LROW + kk * 32);
            acc[0][0] = __builtin_amdgcn_mfma_f32_32x32x16_bf16(a0, b0, acc[0][0], 0, 0, 0);
            acc[0][1] = __builtin_amdgcn_mfma_f32_32x32x16_bf16(a0, b1, acc[0][1], 0, 0, 0);
            acc[1][0] = __builtin_amdgcn_mfma_f32_32x32x16_bf16(a1, b0, acc[1][0], 0, 0, 0);
            acc[1][1] = __builtin_amdgcn_mfma_f32_32x32x16_bf16(a1, b1, acc[1][1], 0, 0, 0);
        }
        __builtin_amdgcn_s_setprio(0);
    };
    const int nk = K >> 6;
    for (int rep = 0; rep < REPG; ++rep) {
    if (rep) {
#pragma unroll
        for (int i = 0; i < 2; ++i)
#pragma unroll
            for (int j = 0; j < 2; ++j)
#pragma unroll
                for (int r = 0; r < 16; ++r) acc[i][j][r] = 0.f;
    }
    loadt(0, ra0, rx0, rb0);
    if (nk > 1) loadt(64, ra1, rx1, rb1);
    storet(0, ra0, rx0, rb0); __syncthreads();
    for (int kt = 0; kt < nk; kt += 2) {
        if (kt + 2 < nk) loadt((kt + 2) << 6, ra0, rx0, rb0);
        __builtin_amdgcn_sched_barrier(0);
        compute(0);
        if (kt + 1 < nk) storet(1, ra1, rx1, rb1);
        __syncthreads();
        if (kt + 1 < nk) {
            if (kt + 3 < nk) loadt((kt + 3) << 6, ra1, rx1, rb1);
            __builtin_amdgcn_sched_barrier(0);
            compute(1);
            if (kt + 2 < nk) storet(0, ra0, rx0, rb0);
            __syncthreads();
        }
    }
    }
}

constexpr int LROW2 = 80;
constexpr int A2_BYTES = 128 * LROW2, B2_BYTES = 256 * LROW2, STAGE2 = A2_BYTES + B2_BYTES;
__device__ __forceinline__ void gemm_mainloop_w(const bf16_t* __restrict__ Ap, int lda, const bf16_t* __restrict__ Bt, int ldb, int K,
                                                unsigned char* smem, f32x16 (&acc)[2][4]) {
    const int tid = opq(threadIdx.x), lane = tid & 63, wave = __builtin_amdgcn_readfirstlane(tid >> 6), wm = wave >> 1, wn = wave & 1, fm = lane & 31, hi = lane >> 5;
    const int srow = tid >> 2, skc = tid & 3;
    u32x4 ra0[2], rb0[4], ra1[2], rb1[4];
#pragma unroll
    for (int i = 0; i < 2; ++i)
#pragma unroll
        for (int j = 0; j < 4; ++j)
#pragma unroll
            for (int r = 0; r < 16; ++r) acc[i][j][r] = 0.f;
    const int aoff = (wm * 64 + fm) * LROW2 + hi * 16, boff = A2_BYTES + (wn * 128 + fm) * LROW2 + hi * 16;
    const int soff = srow * LROW2 + skc * 16;
    const unsigned la = (unsigned)(srow * lda + skc * 8), lb = (unsigned)(srow * ldb + skc * 8);
    auto loadt = [&](int k0, u32x4 (&ra)[2], u32x4 (&rb)[4]) __attribute__((always_inline)) {
#pragma unroll
        for (int i = 0; i < 2; ++i) { const bf16_t* ap = Ap + (size_t)(64 * i) * lda + k0; ra[i] = *(const u32x4*)(ap + la); }
#pragma unroll
        for (int i = 0; i < 4; ++i) { const bf16_t* bp = Bt + (size_t)(64 * i) * ldb + k0; rb[i] = *(const u32x4*)(bp + lb); }
    };
    auto storet = [&](int buf, const u32x4 (&ra)[2], const u32x4 (&rb)[4]) __attribute__((always_inline)) {
        unsigned char* a = smem + buf * STAGE2;
#pragma unroll
        for (int i = 0; i < 2; ++i) *(u32x4*)(a + soff + i * 64 * LROW2) = ra[i];
#pragma unroll
        for (int i = 0; i < 4; ++i) *(u32x4*)(a + A2_BYTES + soff + i * 64 * LROW2) = rb[i];
    };
    auto compute = [&](int buf) __attribute__((always_inline)) {
        const unsigned char* s = smem + buf * STAGE2;
        bf16x8 a[2][2], b[2][4];
#pragma unroll
        for (int kk = 0; kk < 2; ++kk) {
            a[kk][0] = *(const bf16x8*)(s + aoff + kk * 32); a[kk][1] = *(const bf16x8*)(s + aoff + 32 * LROW2 + kk * 32);
#pragma unroll
            for (int nt = 0; nt < 4; ++nt) b[kk][nt] = *(const bf16x8*)(s + boff + nt * 32 * LROW2 + kk * 32);
        }
        __builtin_amdgcn_sched_barrier(0);
        __builtin_amdgcn_s_setprio(1);
#pragma unroll
        for (int kk = 0; kk < 2; ++kk)
#pragma unroll
            for (int nt = 0; nt < 4; ++nt) {
                acc[0][nt] = __builtin_amdgcn_mfma_f32_32x32x16_bf16(a[kk][0], b[kk][nt], acc[0][nt], 0, 0, 0);
                acc[1][nt] = __builtin_amdgcn_mfma_f32_32x32x16_bf16(a[kk][1], b[kk][nt], acc[1][nt], 0, 0, 0);
            }
        __builtin_amdgcn_s_setprio(0);
    };
    const int nk = K >> 5;
    loadt(0, ra0, rb0);
    if (nk > 1) loadt(32, ra1, rb1);
    storet(0, ra0, rb0); __syncthreads();
    for (int kt = 0; kt < nk; kt += 2) {
        if (kt + 2 < nk) loadt((kt + 2) << 5, ra0, rb0);
        __builtin_amdgcn_sched_barrier(0);
        compute(0);
        if (kt + 1 < nk) storet(1, ra1, rb1);
        __syncthreads();
        if (kt + 1 < nk) {
            if (kt + 3 < nk) loadt((kt + 3) << 5, ra1, rb1);
            __builtin_amdgcn_sched_barrier(0);
            compute(1);
            if (kt + 2 < nk) storet(0, ra0, rb0);
            __syncthreads();
        }
    }
}

__device__ __forceinline__ void gemm_mainloop_w3(const bf16_t* __restrict__ Ap, int lda, const bf16_t* __restrict__ Bt, int ldb, int K,
                                                unsigned char* smem, f32x16 (&acc)[2][3]) {
    const int tid = opq(threadIdx.x), lane = tid & 63, wave = __builtin_amdgcn_readfirstlane(tid >> 6), wm = wave >> 1, wn = wave & 1, fm = lane & 31, hi = lane >> 5;
    const int srow = tid >> 2, skc = tid & 3;
    u32x4 ra0[2], rb0[3], ra1[2], rb1[3];
#pragma unroll
    for (int i = 0; i < 2; ++i)
#pragma unroll
        for (int j = 0; j < 3; ++j)
#pragma unroll
            for (int r = 0; r < 16; ++r) acc[i][j][r] = 0.f;
    const int aoff = (wm * 64 + fm) * LROW2 + hi * 16, boff = A2_BYTES + (wn * 96 + fm) * LROW2 + hi * 16;
    const int soff = srow * LROW2 + skc * 16;
    const unsigned la = (unsigned)(srow * lda + skc * 8), lb = (unsigned)(srow * ldb + skc * 8);
    auto loadt = [&](int k0, u32x4 (&ra)[2], u32x4 (&rb)[3]) __attribute__((always_inline)) {
#pragma unroll
        for (int i = 0; i < 2; ++i) { const bf16_t* ap = Ap + (size_t)(64 * i) * lda + k0; ra[i] = *(const u32x4*)(ap + la); }
#pragma unroll
        for (int i = 0; i < 3; ++i) { const bf16_t* bp = Bt + (size_t)(64 * i) * ldb + k0; rb[i] = *(const u32x4*)(bp + lb); }
    };
    auto storet = [&](int buf, const u32x4 (&ra)[2], const u32x4 (&rb)[3]) __attribute__((always_inline)) {
        unsigned char* a = smem + buf * STAGE2;
#pragma unroll
        for (int i = 0; i < 2; ++i) *(u32x4*)(a + soff + i * 64 * LROW2) = ra[i];
#pragma unroll
        for (int i = 0; i < 3; ++i) *(u32x4*)(a + A2_BYTES + soff + i * 64 * LROW2) = rb[i];
    };
    auto compute = [&](int buf) __attribute__((always_inline)) {
        const unsigned char* s = smem + buf * STAGE2;
        bf16x8 a[2][2], b[2][3];
#pragma unroll
        for (int kk = 0; kk < 2; ++kk) {
            a[kk][0] = *(const bf16x8*)(s + aoff + kk * 32); a[kk][1] = *(const bf16x8*)(s + aoff + 32 * LROW2 + kk * 32);
#pragma unroll
            for (int nt = 0; nt < 3; ++nt) b[kk][nt] = *(const bf16x8*)(s + boff + nt * 32 * LROW2 + kk * 32);
        }
        __builtin_amdgcn_sched_barrier(0);
        __builtin_amdgcn_s_setprio(1);
#pragma unroll
        for (int kk = 0; kk < 2; ++kk)
#pragma unroll
            for (int nt = 0; nt < 3; ++nt) {
                acc[0][nt] = __builtin_amdgcn_mfma_f32_32x32x16_bf16(a[kk][0], b[kk][nt], acc[0][nt], 0, 0, 0);
                acc[1][nt] = __builtin_amdgcn_mfma_f32_32x32x16_bf16(a[kk][1], b[kk][nt], acc[1][nt], 0, 0, 0);
            }
        __builtin_amdgcn_s_setprio(0);
    };
    const int nk = K >> 5;
    loadt(0, ra0, rb0);
    if (nk > 1) loadt(32, ra1, rb1);
    storet(0, ra0, rb0); __syncthreads();
    for (int kt = 0; kt < nk; kt += 2) {
        if (kt + 2 < nk) loadt((kt + 2) << 5, ra0, rb0);
        __builtin_amdgcn_sched_barrier(0);
        compute(0);
        if (kt + 1 < nk) storet(1, ra1, rb1);
        __syncthreads();
        if (kt + 1 < nk) {
            if (kt + 3 < nk) loadt((kt + 3) << 5, ra1, rb1);
            __builtin_amdgcn_sched_barrier(0);
            compute(1);
            if (kt + 2 < nk) storet(0, ra0, rb0);
            __syncthreads();
        }
    }
}

__device__ __forceinline__ void exch_epilogue(f32x16 (&v)[2][2], int row0, int col0, unsigned long long* gran, unsigned tag, const float* __restrict__ gain,
                                              float* xout, bf16_t* xb, float* part_next, float* ep) {
    const int tid = opq(threadIdx.x), lane = tid & 63, wave = __builtin_amdgcn_readfirstlane(tid >> 6), wm = wave >> 1, wn = wave & 1, fm = lane & 31, hi = lane >> 5;
    const int slot = (col0 >> 7) * 2 + wn;
    float xo[2][2][16];
#pragma unroll
    for (int mt = 0; mt < 2; ++mt)
#pragma unroll
        for (int nt = 0; nt < 2; ++nt) {
            const bf16_t* xp = xb + (size_t)(row0 + wm * 64 + mt * 32 + 4 * hi) * D + col0 + wn * 64 + nt * 32 + fm;
#pragma unroll
            for (int r = 0; r < 16; ++r) xo[mt][nt][r] = bf2f(xp[((r & 3) + 8 * (r >> 2)) * D]);
        }
#pragma unroll
    for (int mt = 0; mt < 2; ++mt) {
        float ss[16];
#pragma unroll
        for (int r = 0; r < 16; ++r) ss[r] = v[mt][0][r] * v[mt][0][r] + v[mt][1][r] * v[mt][1][r];
        const float tot = rowsum32(ss, lane);
        if ((lane & 1) == 0) __hip_atomic_store(gran + (size_t)(row0 + wm * 64 + mt * 32 + crow((lane >> 1) & 15, hi)) * 16 + slot, ((unsigned long long)tag << 32) | (unsigned long long)__float_as_uint(tot), __ATOMIC_RELAXED, __HIP_MEMORY_SCOPE_AGENT);
    }
    if (tid < 128) {
        const unsigned long long* g = gran + (size_t)(row0 + tid) * 16;
        float s;
        for (;;) {
            s = 0.f; bool ok = true;
#pragma unroll
            for (int i = 0; i < 16; ++i) { const unsigned long long x = __hip_atomic_load(g + i, __ATOMIC_RELAXED, __HIP_MEMORY_SCOPE_AGENT); ok &= ((unsigned)(x >> 32) == tag); s += __uint_as_float((unsigned)x); }
            if (ok) break;
            __builtin_amdgcn_s_sleep(1);
        }
        ep[128 + tid] = rsqrtf(s * (1.0f / 1024.0f) + EPS);
    }
    __syncthreads();
#pragma unroll
    for (int mt = 0; mt < 2; ++mt) {
        float ss[16], rs[16];
#pragma unroll
        for (int r = 0; r < 16; ++r) { ss[r] = 0.f; rs[r] = ep[128 + wm * 64 + mt * 32 + crow(r, hi)]; }
#pragma unroll
        for (int nt = 0; nt < 2; ++nt) {
            const int col = col0 + wn * 64 + nt * 32 + fm;
            const float g = gain[col];
            float* xp = xout + (size_t)(row0 + wm * 64 + mt * 32 + 4 * hi) * D + col;
            bf16_t* bp = xb + (size_t)(row0 + wm * 64 + mt * 32 + 4 * hi) * D + col;
#pragma unroll
            for (int g4 = 0; g4 < 4; ++g4) {
#pragma unroll
                for (int i = 0; i < 4; ++i) {
                    const int r = 4 * g4 + i, off = (8 * g4 + i) * D;
                    const float xf = xo[mt][nt][r] + v[mt][nt][r] * rs[r] * g;
                    const bf16_t xq = f2bf(xf);
                    const float xn = bf2f(xq);
                    bp[off] = xq; if (xout) xp[off] = xf; ss[r] += xn * xn;
                }
                asm volatile("" ::: "memory");
            }
        }
        const float tot = rowsum32(ss, lane);
        if ((lane & 1) == 0) part_next[(size_t)(row0 + wm * 64 + mt * 32 + crow((lane >> 1) & 15, hi)) * 16 + slot] = tot;
    }
}

__device__ __forceinline__ void exch_epilogue_w(f32x16 (&v)[2][4], int row0, int col0, unsigned long long* gran, unsigned tag, const float* __restrict__ gain,
                                                float* xout, bf16_t* xb, float* part_next, float* ep) {
    const int tid = opq(threadIdx.x), lane = tid & 63, wave = __builtin_amdgcn_readfirstlane(tid >> 6), wm = wave >> 1, wn = wave & 1, fm = lane & 31, hi = lane >> 5;
    const int slot = (col0 >> 8) * 2 + wn;
    float xs[2][16];
    auto ldx = [&](int u, float (&x)[16]) __attribute__((always_inline)) {
        const int lo = opq((4 * hi) * D + fm);
        const bf16_t* xp = xb + (size_t)(row0 + wm * 64 + (u >> 2) * 32) * D + col0 + wn * 128 + (u & 3) * 32 + lo;
#pragma unroll
        for (int r = 0; r < 16; ++r) x[r] = bf2f(xp[((r & 3) + 8 * (r >> 2)) * D]);
    };
    ldx(0, xs[0]);
#pragma unroll
    for (int mt = 0; mt < 2; ++mt) {
        float ss[16];
#pragma unroll
        for (int r = 0; r < 16; ++r) ss[r] = (v[mt][0][r] * v[mt][0][r] + v[mt][1][r] * v[mt][1][r]) + (v[mt][2][r] * v[mt][2][r] + v[mt][3][r] * v[mt][3][r]);
        const float tot = rowsum32(ss, lane);
        if ((lane & 1) == 0) __hip_atomic_store(gran + (size_t)(row0 + wm * 64 + mt * 32 + crow((lane >> 1) & 15, hi)) * 16 + slot, ((unsigned long long)tag << 32) | (unsigned long long)__float_as_uint(tot), __ATOMIC_RELAXED, __HIP_MEMORY_SCOPE_AGENT);
    }
    if (tid < 128) {
        const unsigned long long* g = gran + (size_t)(row0 + tid) * 16;
        float s;
        for (;;) {
            s = 0.f; bool ok = true;
#pragma unroll
            for (int i = 0; i < 8; ++i) { const unsigned long long x = __hip_atomic_load(g + i, __ATOMIC_RELAXED, __HIP_MEMORY_SCOPE_AGENT); ok &= ((unsigned)(x >> 32) == tag); s += __uint_as_float((unsigned)x); }
            if (ok) break;
            __builtin_amdgcn_s_sleep(1);
        }
        ep[128 + tid] = rsqrtf(s * (1.0f / 1024.0f) + EPS);
    }
    __syncthreads();
    float ss[16];
#pragma unroll
    for (int u = 0; u < 8; ++u) {
        const int mt = u >> 2, nt = u & 3;
        if (nt == 0) {
#pragma unroll
            for (int r = 0; r < 16; ++r) ss[r] = 0.f;
        }
        if (u + 1 < 8) ldx(u + 1, xs[(u + 1) & 1]);
        const int fmo = opq(fm), hio = opq(hi);
        const int col = col0 + wn * 128 + nt * 32 + fmo;
        const float g = gain[col];
        bf16_t* bp = xb + (size_t)(row0 + wm * 64 + mt * 32 + 4 * hio) * D + col;
#pragma unroll
        for (int g4 = 0; g4 < 4; ++g4) {
            const f32x4 rs4 = *(const f32x4*)(ep + 128 + wm * 64 + mt * 32 + 8 * g4 + 4 * hio);
#pragma unroll
            for (int i = 0; i < 4; ++i) {
                const int r = 4 * g4 + i, off = (8 * g4 + i) * D;
                const bf16_t xq = f2bf(xs[u & 1][r] + v[mt][nt][r] * rs4[i] * g);
                const float xn = bf2f(xq);
                bp[off] = xq; ss[r] += xn * xn;
            }
        }
        asm volatile("" ::: "memory");
        if (nt == 3) {
            const float tot = rowsum32(ss, lane);
            if ((lane & 1) == 0) part_next[(size_t)(row0 + wm * 64 + mt * 32 + crow((lane >> 1) & 15, hi)) * 16 + slot] = tot;
        }
    }
}

__device__ __forceinline__ void gbar(unsigned* ctr, unsigned& epoch, unsigned G) {
    asm volatile("s_waitcnt vmcnt(0)" ::: "memory");
    __syncthreads();
    epoch += 1u;
    if (threadIdx.x == 0) {
        __builtin_amdgcn_fence(__ATOMIC_RELEASE, "agent");
        asm volatile("s_waitcnt vmcnt(0)" ::: "memory");
        __hip_atomic_fetch_add(ctr, 1u, __ATOMIC_RELAXED, __HIP_MEMORY_SCOPE_AGENT);
        const unsigned target = epoch * G;
        while (__hip_atomic_load(ctr, __ATOMIC_RELAXED, __HIP_MEMORY_SCOPE_AGENT) < target) __builtin_amdgcn_s_sleep(1);
        __builtin_amdgcn_fence(__ATOMIC_ACQUIRE, "agent");
        asm volatile("s_waitcnt vmcnt(0)" ::: "memory");
    }
    __syncthreads();
}

#define LAS __attribute__((address_space(3)))
#define XB_TMO      128
#define XB_XCNT(j)  (256  + 64 * (j))
#define XB_XSUB(j)  (1280 + 64 * (j))
#define XB_XGEN(j)  (2304 + 64 * (j))
#define XB_TOP      3328
#define XB_TOPGEN   3392
#define XCD_BAR_WORDS 3456
#define XB_SPIN_CAP (1u << 22)
__device__ __forceinline__ unsigned xb_ld(unsigned* p)              { return __hip_atomic_load(p, __ATOMIC_RELAXED, __HIP_MEMORY_SCOPE_AGENT); }
__device__ __forceinline__ unsigned xb_add(unsigned* p, unsigned v) { return __hip_atomic_fetch_add(p, v, __ATOMIC_RELAXED, __HIP_MEMORY_SCOPE_AGENT); }
__device__ __forceinline__ unsigned xb_xcc_id() { return (unsigned)__builtin_amdgcn_s_getreg((3 << 11) | 20) & 0xFu; }
#define XB_SPIN(cond, bar) do { unsigned _sp = 0; while (cond) { __builtin_amdgcn_s_sleep(1); \
    if ((++_sp & 255u) == 0u) { if (xb_ld(&(bar)[XB_TMO])) break; if (_sp > XB_SPIN_CAP) { atomicAdd(&(bar)[XB_TMO], 1u); break; } } } } while (0)
struct XcdBarrier { unsigned* bar; unsigned x; volatile LAS unsigned* st; };
__device__ __forceinline__ XcdBarrier xcd_barrier_post(unsigned* bar, volatile LAS unsigned* st) {
    XcdBarrier b; b.bar = bar; b.x = xb_xcc_id(); b.st = st;
    if (threadIdx.x == 0) (void)xb_add(&bar[XB_XCNT(b.x)], 1u);
    return b;
}
__device__ __forceinline__ void xcd_barrier_complete(unsigned* bar, unsigned x, unsigned& nloc, unsigned& nx) {
    const unsigned G = gridDim.x * gridDim.y * gridDim.z;
    unsigned sum, cnt, mine, sp = 0u;
    for (;;) {
        sum = 0u; cnt = 0u; mine = 0u;
#pragma unroll
        for (unsigned j = 0; j < 16; ++j) { const unsigned c = xb_ld(&bar[XB_XCNT(j)]); sum += c; cnt += (c > 0u) ? 1u : 0u; mine = (j == x) ? c : mine; }
        if (sum == G) break;
        __builtin_amdgcn_s_sleep(1);
        if ((++sp & 255u) == 0u) { if (xb_ld(&bar[XB_TMO])) break; if (sp > XB_SPIN_CAP) { atomicAdd(&bar[XB_TMO], 1u); break; } }
    }
    nloc = mine > 0u ? mine : 1u; nx = cnt > 0u ? cnt : 1u;
}
__device__ __forceinline__ void xcd_barrier(const XcdBarrier& b) {
    asm volatile("s_waitcnt vmcnt(0)" ::: "memory");
    __syncthreads();
    if (threadIdx.x == 0) {
        unsigned* bar = b.bar;
        __builtin_amdgcn_s_waitcnt(0);
        unsigned nloc = b.st[0], nx = b.st[1];
        if (nloc == 0u) { xcd_barrier_complete(bar, b.x, nloc, nx); b.st[0] = nloc; b.st[1] = nx; }
        const unsigned old = xb_add(&bar[XB_XSUB(b.x)], 1u);
        const unsigned gen = old / nloc;
        if (old + 1u == (gen + 1u) * nloc) {
            __builtin_amdgcn_fence(__ATOMIC_RELEASE, "agent");
            asm volatile("s_waitcnt vmcnt(0)" ::: "memory");
            const unsigned og = xb_add(&bar[XB_TOP], 1u);
            const unsigned tg = og / nx;
            if (og + 1u == (tg + 1u) * nx) xb_add(&bar[XB_TOPGEN], 1u);
            else XB_SPIN(xb_ld(&bar[XB_TOPGEN]) == tg, bar);
            __builtin_amdgcn_fence(__ATOMIC_ACQUIRE, "agent");
            xb_add(&bar[XB_XGEN(b.x)], 1u);
            asm volatile("s_waitcnt vmcnt(0)" ::: "memory");
        } else {
            XB_SPIN(xb_ld(&bar[XB_XGEN(b.x)]) == gen, bar);
            __builtin_amdgcn_fence(__ATOMIC_ACQUIRE, "agent");
            asm volatile("s_waitcnt vmcnt(0)" ::: "memory");
        }
    }
    __syncthreads();
}

__global__ void __launch_bounds__(256, 2) mega(Params P) {
    extern __shared__ __attribute__((aligned(16))) unsigned char lds[];
    cg::grid_group grid = cg::this_grid();
    const int tid = threadIdx.x, lane = tid & 63, wave = __builtin_amdgcn_readfirstlane(tid >> 6), wm = wave >> 1, wn = wave & 1, fm = lane & 31, hi = lane >> 5;
    const int G = gridDim.x, vb = vblock();
    unsigned char* ws = P.ws;
    float* stat = (float*)(ws + WS_STAT);
    unsigned* cnts = (unsigned*)(ws + WS_CNT);
    float* cosT = (float*)(ws + WS_ROPE);
    float* sinT = cosT + S * 16;
    bf16_t* xb = (bf16_t*)(ws + WS_XB);
    bf16_t* mix = (bf16_t*)(ws + WS_MIX);
    bf16_t* ebuf = mix;
    bf16_t* zb = (bf16_t*)(ws + WS_Z);
    bf16_t* Qb = (bf16_t*)(ws + WS_Q);
    bf16_t* Kb = (bf16_t*)(ws + WS_K);
    bf16_t* Vt = (bf16_t*)(ws + WS_VT);
    bf16_t* ub = (bf16_t*)(ws + WS_U);
    float* xout = P.out;
    float* ep = (float*)(lds + EP_OFF);
    unsigned long long* gran = (unsigned long long*)(ws + WS_GRAN);
    unsigned* gctr = cnts + 4096;
    unsigned gepoch = 0u; (void)gepoch; (void)gctr;
    volatile LAS unsigned* xst = (volatile LAS unsigned*)((LAS unsigned char*)lds + XB_OFF);
    if (tid == 0) { xst[0] = 0u; xst[1] = 0u; }

    auto dump_bf = [&](const bf16_t* buf, int pitch) {
        grid.sync();
        for (int i = vb * 256 + tid; i < T * D; i += G * 256) { const int row = i >> 10, col = i & 1023; xout[i] = bf2f(buf[(size_t)row * pitch + col]); }
    };
    if (PHASES & 1) for (int rep = 0; rep < REPP; ++rep) {
        float* tl = (float*)lds;
        for (int t = vb; t < NL * 3336; t += G) {
            const int l = t / 3336; int r = t % 3336;
            const float* src; const float* gA = nullptr; const float* gB = nullptr; int K, N, Np; size_t off;
            if (r < 576) { src = P.in[3] + (size_t)l * 1024 * 2208; gA = P.in[2] + l * 1024; gB = gA + 512; K = 1024; N = 2208; Np = 2304; off = OW_IN; }
            else if ((r -= 576) < 72) { src = P.in[5] + (size_t)l * 384 * 768; gA = P.in[4] + l * 384; gB = gA + 512; K = 384; N = 768; Np = 768; off = OW_QB; }
            else if ((r -= 72) < 64) { src = P.in[7] + (size_t)l * 256 * 1024; gA = P.in[6] + l * 256; gB = gA + 512; K = 256; N = 1024; Np = 1024; off = OW_KVB; }
            else if ((r -= 64) < 256) { src = P.in[11] + (size_t)l * 1024 * 1024; gA = P.in[9] + l * 512; gB = P.in[10] + l * 512; K = 1024; N = 1024; Np = 1024; off = OW_OUT; }
            else if ((r -= 256) < 1024) { src = P.in[14] + (size_t)l * 1024 * 4096; gA = P.in[13] + l * 1024; gB = gA + 512; K = 1024; N = 4096; Np = 4096; off = OW_UP; }
            else if ((r -= 1024) < 1024) { src = P.in[15] + (size_t)l * 4096 * 1024; K = 4096; N = 1024; Np = 1024; off = OW_DOWN; }
            else if ((r -= 1024) < 256) { src = P.in[18] + (size_t)l * 1024 * 1024; gA = P.in[17] + l * 1024; gB = gA + 512; K = 1024; N = 1024; Np = 1024; off = OW_G; }
            else { r -= 256; src = P.in[19] + (size_t)l * 256 * 1024; K = 256; N = 1024; Np = 1024; off = OW_P; }
            bf16_t* dst = (bf16_t*)(ws + WS_W + (size_t)l * WL_BYTES + off);
            const int nct = Np / 64, k0 = (r / nct) * 64, n0 = (r % nct) * 64;
#pragma unroll
            for (int j = 0; j < 4; ++j) {
                const int kr = (tid >> 4) + 16 * j, n4 = (tid & 15) * 4, k = k0 + kr;
                f32x4 v = (f32x4){0.f, 0.f, 0.f, 0.f};
                if (n0 + n4 < N) v = *(const f32x4*)(src + (size_t)k * N + n0 + n4);
                float g = 1.f;
                if (gA) g = (k < 512) ? gA[k] : gB[k - 512];
                tl[kr * 65 + n4 + 0] = v[0] * g; tl[kr * 65 + n4 + 1] = v[1] * g; tl[kr * 65 + n4 + 2] = v[2] * g; tl[kr * 65 + n4 + 3] = v[3] * g;
            }
            __syncthreads();
            {
                const int n = tid >> 2, kq = (tid & 3) * 16;
                unsigned w[8];
#pragma unroll
                for (int i = 0; i < 8; ++i) w[i] = pk2(tl[(kq + 2 * i) * 65 + n], tl[(kq + 2 * i + 1) * 65 + n]);
                bf16_t* dp = dst + (size_t)(n0 + n) * K + k0 + kq;
                *(u32x4*)dp = (u32x4){w[0], w[1], w[2], w[3]};
                *(u32x4*)(dp + 8) = (u32x4){w[4], w[5], w[6], w[7]};
            }
            __syncthreads();
        }
        const float* x = P.in[0];
        for (int row = vb * 4 + wave; row < T; row += G * 4) {
            float ss = 0.f;
#pragma unroll
            for (int j = 0; j < 4; ++j) {
                const size_t idx = (size_t)row * D + j * 256 + lane * 4;
                const f32x4 v = *(const f32x4*)(x + idx);
                *(u32x2*)(xb + idx) = (u32x2){pk2(v[0], v[1]), pk2(v[2], v[3])};
                ss += v[0] * v[0] + v[1] * v[1] + v[2] * v[2] + v[3] * v[3];
            }
            ss += __shfl_xor(ss, 32); ss += __shfl_xor(ss, 16); ss += __shfl_xor(ss, 8); ss += __shfl_xor(ss, 4); ss += __shfl_xor(ss, 2); ss += __shfl_xor(ss, 1);
            if (lane < 16) stat[((size_t)ST_X0 * T + row) * 16 + lane] = (lane == 0) ? ss : 0.f;
        }
        for (int idx = vb * 256 + tid; idx < NL * 3 * 128; idx += G * 256) cnts[idx] = 0u;
        if (blockIdx.x == 0 && tid == 0) *gctr = 0u;
        for (int idx = vb * 256 + tid; idx < 3 * T * 16 / 2; idx += G * 256) ((u32x4*)gran)[idx] = (u32x4){0u, 0u, 0u, 0u};
        for (int idx = vb * 256 + tid; idx < XCD_BAR_WORDS; idx += G * 256) cnts[8192 + idx] = 0u;
        for (int idx = vb * 256 + tid; idx < S * 16; idx += G * 256) {
            const int s = idx >> 4, j = idx & 15;
            const double base = sqrt(sqrt(sqrt(sqrt(10000.0))));
            double pw = 1.0;
            for (int q = 0; q < j; ++q) pw *= base;
            const float pwf = (float)pw;
            const float inv_freq = 1.0f / pwf;
            const float angf = (float)s * inv_freq;
            const double a = (double)angf;
            const double n = rint(a * 0.15915494309189535);
            const double rr = a - n * 6.283185307179586;
            const double r2 = rr * rr;
            double sn = 0.0, term = rr;
            for (int k = 0; k < 16; ++k) { sn += term; term *= -r2 / (double)((2 * k + 2) * (2 * k + 3)); }
            double cs = 0.0; term = 1.0;
            for (int k = 0; k < 16; ++k) { cs += term; term *= -r2 / (double)((2 * k + 1) * (2 * k + 2)); }
            cosT[idx] = (float)cs; sinT[idx] = (float)sn;
        }
    }
    grid.sync();
    const XcdBarrier xbar = xcd_barrier_post(cnts + 8192, xst);

    for (int l = 0; l < NL; ++l) {
        const unsigned char* wl = ws + WS_W + (size_t)l * WL_BYTES;
        const bf16_t* WIN = (const bf16_t*)(wl + OW_IN);
        const bf16_t* WQB = (const bf16_t*)(wl + OW_QB);
        const bf16_t* WKVB = (const bf16_t*)(wl + OW_KVB);
        const bf16_t* WOUT = (const bf16_t*)(wl + OW_OUT);
        const bf16_t* WUP = (const bf16_t*)(wl + OW_UP);
        const bf16_t* WDOWN = (const bf16_t*)(wl + OW_DOWN);
        const bf16_t* WG = (const bf16_t*)(wl + OW_G);
        const bf16_t* WP = (const bf16_t*)(wl + OW_P);
        float* st = stat;

        if (PHASES & 2) for (int t = vb; t < 128 * 12; t += G) {
            const int tid = opq(threadIdx.x), lane = tid & 63, wave = __builtin_amdgcn_readfirstlane(tid >> 6), wm = wave >> 1, wn = wave & 1, fm = lane & 31, hi = lane >> 5;
            int panel = t / 12, ct = t % 12;
            if (G == 512) { const int M = (t >> 9) * 8 + (vb >> 6), q = vb & 63; panel = (M / 3) * 16 + (q >> 2); ct = (M % 3) * 4 + (q & 3); }
            const int row0 = panel * 128, col0 = ct * 192;
            if (tid < 128) ep[tid] = rsqrtf(sum_slots(st + ((size_t)ST_X0 * T + row0 + tid) * 16, 16) * (1.0f / 1024.0f) + EPS);
            f32x16 acc[2][3];
            gemm_mainloop_w3(xb + (size_t)row0 * D, D, WIN + (size_t)col0 * D, D, D, lds, acc);
            const int grp = 2 * ct + wn;
#pragma unroll
            for (int mt = 0; mt < 2; ++mt) {
                float ss[16], rs[16];
#pragma unroll
                for (int r = 0; r < 16; ++r) { ss[r] = 0.f; rs[r] = ep[wm * 64 + mt * 32 + crow(r, hi)]; }
#pragma unroll
                for (int nt = 0; nt < 3; ++nt) {
                    const int col = col0 + wn * 96 + nt * 32 + fm;
                    const bool cnt = (grp < 6) || (nt < 2);
#pragma unroll
                    for (int r = 0; r < 16; ++r) {
                        const float v = acc[mt][nt][r] * rs[r];
                        zb[(size_t)(row0 + wm * 64 + mt * 32 + crow(r, hi)) * ZW + col] = f2bf(v);
                        if (cnt) ss[r] += v * v;
                    }
                }
                if (grp < 7) {
                    const float tot = rowsum32(ss, lane);
                    float* pp = st + ((size_t)(grp < 4 ? ST_QA : ST_KVA) * T + row0 + wm * 64 + mt * 32 + crow((lane >> 1) & 15, hi)) * 16 + (grp < 4 ? grp : grp - 4);
                    if ((lane & 1) == 0) *pp = tot;
                }
            }
            __syncthreads();
        }
        xcd_barrier(xbar);

        if (STOP == 1) { dump_bf(zb, ZW); return; }
        if (PHASES & 4) for (int t = vb; t < 1024; t += G) {
            const int tid = opq(threadIdx.x), lane = tid & 63, wave = __builtin_amdgcn_readfirstlane(tid >> 6), wm = wave >> 1, wn = wave & 1, fm = lane & 31, hi = lane >> 5; (void)lane;
            if (t < 512) {
                const int panel = t >> 2, ct = t & 3, row0 = panel * 128, col0 = ct * 192;
                if (tid < 128) ep[tid] = rsqrtf(sum_slots(st + ((size_t)ST_QA * T + row0 + tid) * 16, 4) * (1.0f / 384.0f) + EPS);
                f32x16 acc[2][3];
                gemm_mainloop_w3(zb + (size_t)row0 * ZW, ZW, WQB + (size_t)col0 * 384, 384, 384, lds, acc);
                const int h = 2 * ct + wn;
#pragma unroll
                for (int mt = 0; mt < 2; ++mt) {
                    float rs[16];
#pragma unroll
                    for (int r = 0; r < 16; ++r) rs[r] = ep[wm * 64 + mt * 32 + crow(r, hi)] * QSCALE;
#pragma unroll
                    for (int nt = 0; nt < 3; ++nt) {
#pragma unroll
                        for (int r = 0; r < 16; ++r) {
                            const int row = row0 + wm * 64 + mt * 32 + crow(r, hi);
                            const int b = row >> 12, s = row & 4095;
                            float v = acc[mt][nt][r] * rs[r];
                            if (nt == 2) {
                                const float pr = __shfl_xor(v, 16);
                                const float c = cosT[s * 16 + (fm & 15)], sn = sinT[s * 16 + (fm & 15)];
                                v = (fm < 16) ? (v * c - pr * sn) : (v * c + pr * sn);
                            }
                            Qb[((size_t)(b * NH + h) * S + s) * 96 + nt * 32 + fm] = f2bf(v);
                        }
                    }
                }
            } else {
                const int t2 = t - 512;
                const int panel = t2 >> 2, ct = t2 & 3, row0 = panel * 128, col0 = ct * 256;
                if (tid < 128) ep[tid] = rsqrtf(sum_slots(st + ((size_t)ST_KVA * T + row0 + tid) * 16, 3) * (1.0f / 256.0f) + EPS);
                f32x16 acc[2][4];
                gemm_mainloop_w(zb + (size_t)row0 * ZW + 384, ZW, WKVB + (size_t)col0 * 256, 256, 256, lds, acc);
                const int h = 2 * ct + wn;
#pragma unroll
                for (int mt = 0; mt < 2; ++mt) {
                    float rs[16];
#pragma unroll
                    for (int r = 0; r < 16; ++r) rs[r] = ep[wm * 64 + mt * 32 + crow(r, hi)];
                    const int rbase = row0 + wm * 64 + mt * 32;
                    const int b = rbase >> 12;
#pragma unroll
                    for (int nt = 0; nt < 4; ++nt) {
                        if (nt < 2) {
                            const int d = nt * 32 + fm;
#pragma unroll
                            for (int r = 0; r < 16; ++r) {
                                const int s = (rbase + crow(r, hi)) & 4095;
                                Kb[((size_t)(b * NH + h) * S + s) * 96 + d] = f2bf(acc[mt][nt][r] * rs[r]);
                            }
                        } else {
                            const int d = (nt - 2) * 32 + fm;
#pragma unroll
                            for (int g = 0; g < 4; ++g) {
                                const int s = (rbase + 8 * g + 4 * hi) & 4095;
                                const u32x2 w = (u32x2){pk2(acc[mt][nt][4 * g] * rs[4 * g], acc[mt][nt][4 * g + 1] * rs[4 * g + 1]),
                                                         pk2(acc[mt][nt][4 * g + 2] * rs[4 * g + 2], acc[mt][nt][4 * g + 3] * rs[4 * g + 3])};
                                *(u32x2*)(Vt + ((size_t)(b * NH + h) * 64 + d) * S + s) = w;
                            }
                        }
                    }
                }
            }
            __syncthreads();
        }
        if (PHASES & 8) {
            const float* wc = P.in[8] + (size_t)l * 3 * 512;
            for (int row = vb * 4 + wave; row < T; row += G * 4) {
                const int tid = opq(threadIdx.x), lane = tid & 63, wave_ = 0, wm = 0, wn = 0, fm = lane & 31, hi = lane >> 5; (void)wm; (void)wn; (void)fm; (void)hi; (void)wave_; (void)lane;
                const int s = row & 4095, b = row >> 12;
                const bf16_t* zr = zb + (size_t)row * ZW;
                const int c0 = 8 * lane;
                const u32x4 gbv = *(const u32x4*)(zr + 672 + c0);
                const u32x4 gc1 = *(const u32x4*)(zr + 1184 + c0), ci1 = *(const u32x4*)(zr + 1696 + c0);
                u32x4 gc0 = (u32x4){0, 0, 0, 0}, ci0 = gc0, gc2 = gc0, ci2 = gc0;
                if (s > 0) { gc0 = *(const u32x4*)(zr - ZW + 1184 + c0); ci0 = *(const u32x4*)(zr - ZW + 1696 + c0); }
                if (s < S - 1) { gc2 = *(const u32x4*)(zr + ZW + 1184 + c0); ci2 = *(const u32x4*)(zr + ZW + 1696 + c0); }
                const f32x4 w0a = *(const f32x4*)(wc + c0), w0b = *(const f32x4*)(wc + c0 + 4);
                const f32x4 w1a = *(const f32x4*)(wc + 512 + c0), w1b = *(const f32x4*)(wc + 512 + c0 + 4);
                const f32x4 w2a = *(const f32x4*)(wc + 1024 + c0), w2b = *(const f32x4*)(wc + 1024 + c0 + 4);
                float cv[8]; float ss = 0.f;
#pragma unroll
                for (int i = 0; i < 4; ++i) {
                    const unsigned a0 = gc0[i], a1 = gc1[i], a2 = gc2[i], d0 = ci0[i], d1 = ci1[i], d2 = ci2[i], gw = gbv[i];
                    const float wlo0 = (i < 2) ? w0a[2 * i] : w0b[2 * i - 4], whi0 = (i < 2) ? w0a[2 * i + 1] : w0b[2 * i - 3];
                    const float wlo1 = (i < 2) ? w1a[2 * i] : w1b[2 * i - 4], whi1 = (i < 2) ? w1a[2 * i + 1] : w1b[2 * i - 3];
                    const float wlo2 = (i < 2) ? w2a[2 * i] : w2b[2 * i - 4], whi2 = (i < 2) ? w2a[2 * i + 1] : w2b[2 * i - 3];
                    const float lo = bflo(gw) * (wlo0 * bflo(a0) * bflo(d0) + wlo1 * bflo(a1) * bflo(d1) + wlo2 * bflo(a2) * bflo(d2));
                    const float hv = bfhi(gw) * (whi0 * bfhi(a0) * bfhi(d0) + whi1 * bfhi(a1) * bfhi(d1) + whi2 * bfhi(a2) * bfhi(d2));
                    cv[2 * i] = lo; cv[2 * i + 1] = hv; ss += lo * lo + hv * hv;
                }
                ss += __shfl_xor(ss, 1); ss += __shfl_xor(ss, 2); ss += __shfl_xor(ss, 4);
                const float rn = rsqrtf(ss * (1.0f / 64.0f) + EPS);
                *(u32x4*)(mix + (size_t)row * D + 512 + c0) = (u32x4){pk2(cv[0] * rn, cv[1] * rn), pk2(cv[2] * rn, cv[3] * rn), pk2(cv[4] * rn, cv[5] * rn), pk2(cv[6] * rn, cv[7] * rn)};
                if (lane < 16) {
                    const float a = bf2f(zr[640 + lane]), bb = bf2f(zr[656 + lane]);
                    const float c = cosT[s * 16 + lane], sn = sinT[s * 16 + lane];
                    const bf16_t o1 = f2bf(a * c - bb * sn), o2 = f2bf(bb * c + a * sn);
#pragma unroll
                    for (int h = 0; h < NH; ++h) {
                        bf16_t* kp = Kb + ((size_t)(b * NH + h) * S + s) * 96;
                        kp[64 + lane] = o1; kp[80 + lane] = o2;
                    }
                }
            }
        }
        xcd_barrier(xbar);

        if (STOP == 2) { dump_bf(Qb, 768); return; }
        if (STOP == 12) { dump_bf(Kb, 768); return; }
        if (STOP == 22) { dump_bf(Vt, 512); return; }
        if (STOP == 32) { dump_bf(mix, 1024); return; }
        if (PHASES & 16) for (int rep = 0; rep < REPA; ++rep) for (int it = vb; it < 32 * 16; it += G) {
            const int tid = opq(threadIdx.x), lane = tid & 63, wave = __builtin_amdgcn_readfirstlane(tid >> 6), fm = lane & 31, hi = lane >> 5;
            const int bh = it >> 4, qb = it & 15, b = bh >> 3, h = bh & 7;
            const bf16_t* Qp = Qb + ((size_t)bh * S + qb * 256 + wave * 64 + fm) * 96 + hi * 8;
            const bf16_t* Kp = Kb + (size_t)bh * S * 96;
            const bf16_t* Vp = Vt + (size_t)bh * 64 * S;
            bf16x8 qf[2][6];
#pragma unroll
            for (int u = 0; u < 2; ++u)
#pragma unroll
                for (int d0 = 0; d0 < 6; ++d0) qf[u][d0] = *(const bf16x8*)(Qp + (size_t)u * 32 * 96 + d0 * 16);
            f32x16 o[2][2];
#pragma unroll
            for (int u = 0; u < 2; ++u)
#pragma unroll
                for (int r = 0; r < 16; ++r) { o[u][0][r] = 0.f; o[u][1][r] = 0.f; }
            float mhat[2] = {0.f, 0.f}, lrun[2] = {0.f, 0.f};
            u32x4 kr[3], vr[2];
            const int pim = (fm & ~12) | ((fm & 4) << 1) | ((fm & 8) >> 1);
            const int koff = pim * KROW + hi * 16, voff = fm * VROW + hi * 16;
            auto loadkv = [&](int kv0) __attribute__((always_inline)) {
#pragma unroll
                for (int i = 0; i < 3; ++i) kr[i] = *(const u32x4*)(Kp + (size_t)kv0 * 96 + (tid + 256 * i) * 8);
#pragma unroll
                for (int i = 0; i < 2; ++i) { const int c = tid + 256 * i; vr[i] = *(const u32x4*)(Vp + (size_t)(c >> 3) * S + kv0 + (c & 7) * 8); }
            };
            auto storekv = [&](int buf) __attribute__((always_inline)) {
                unsigned char* kb = lds + buf * (KT_BYTES + VT_BYTES);
                unsigned char* vbp = kb + KT_BYTES;
#pragma unroll
                for (int i = 0; i < 3; ++i) { const int c = tid + 256 * i; *(u32x4*)(kb + (c / 12) * KROW + (c % 12) * 16) = kr[i]; }
#pragma unroll
                for (int i = 0; i < 2; ++i) { const int c = tid + 256 * i; *(u32x4*)(vbp + (c >> 3) * VROW + (c & 7) * 16) = vr[i]; }
            };
            loadkv(0); storekv(0); __syncthreads();
            for (int kt = 0; kt < 64; ++kt) {
                if (kt + 1 < 64) loadkv((kt + 1) * 64);
                __builtin_amdgcn_sched_barrier(0);
                const unsigned char* kb = lds + (kt & 1) * (KT_BYTES + VT_BYTES);
                const unsigned char* vbp = kb + KT_BYTES;
                f32x16 p[2][2];
#pragma unroll
                for (int d0 = 0; d0 < 6; ++d0) {
                    const bf16x8 k0 = *(const bf16x8*)(kb + koff + d0 * 32), k1 = *(const bf16x8*)(kb + koff + 32 * KROW + d0 * 32);
#pragma unroll
                    for (int u = 0; u < 2; ++u) {
                        if (d0 == 0) {
                            p[u][0] = __builtin_amdgcn_mfma_f32_32x32x16_bf16(k0, qf[u][0], (f32x16){0.f,0.f,0.f,0.f,0.f,0.f,0.f,0.f,0.f,0.f,0.f,0.f,0.f,0.f,0.f,0.f}, 0, 0, 0);
                            p[u][1] = __builtin_amdgcn_mfma_f32_32x32x16_bf16(k1, qf[u][0], (f32x16){0.f,0.f,0.f,0.f,0.f,0.f,0.f,0.f,0.f,0.f,0.f,0.f,0.f,0.f,0.f,0.f}, 0, 0, 0);
                        } else {
                            p[u][0] = __builtin_amdgcn_mfma_f32_32x32x16_bf16(k0, qf[u][d0], p[u][0], 0, 0, 0);
                            p[u][1] = __builtin_amdgcn_mfma_f32_32x32x16_bf16(k1, qf[u][d0], p[u][1], 0, 0, 0);
                        }
                    }
                }
#pragma unroll
                for (int u = 0; u < 2; ++u) {
                    float mx = p[u][0][0];
#pragma unroll
                    for (int r = 0; r < 16; ++r) mx = fmaxf(fmaxf(mx, p[u][0][r]), p[u][1][r]);
                    mx = fmaxf(mx, __shfl_xor(mx, 32));
                    if (kt == 0 || __any(mx - mhat[u] > 8.0f)) {
                        const float nm = (kt == 0) ? mx : fmaxf(mx, mhat[u]);
                        const float f = (kt == 0) ? 1.0f : __builtin_amdgcn_exp2f(mhat[u] - nm);
                        mhat[u] = nm; lrun[u] *= f;
#pragma unroll
                        for (int r = 0; r < 16; ++r) { o[u][0][r] *= f; o[u][1][r] *= f; }
                    }
                }
                auto soft = [&](int u, bf16x8 (&pfu)[4]) __attribute__((always_inline)) {
                    const float mh = mhat[u];
#pragma unroll
                    for (int r = 0; r < 16; ++r) { p[u][0][r] = __builtin_amdgcn_exp2f(p[u][0][r] - mh); p[u][1][r] = __builtin_amdgcn_exp2f(p[u][1][r] - mh); }
                    {
                        const f32x16 t = p[u][0] + p[u][1];
                        float rsum = ((t[0] + t[1]) + (t[2] + t[3])) + ((t[4] + t[5]) + (t[6] + t[7]));
                        rsum += ((t[8] + t[9]) + (t[10] + t[11])) + ((t[12] + t[13]) + (t[14] + t[15]));
                        lrun[u] += rsum;
                    }
#pragma unroll
                    for (int c = 0; c < 4; ++c) {
                        const int mt = c >> 1, r0 = (c & 1) * 8;
                        const u32x4 w = (u32x4){pk2(p[u][mt][r0], p[u][mt][r0 + 1]), pk2(p[u][mt][r0 + 2], p[u][mt][r0 + 3]), pk2(p[u][mt][r0 + 4], p[u][mt][r0 + 5]), pk2(p[u][mt][r0 + 6], p[u][mt][r0 + 7])};
                        pfu[c] = __builtin_bit_cast(bf16x8, w);
                    }
                };
                auto pvm = [&](int u, const bf16x8 (&pfu)[4]) __attribute__((always_inline)) {
#pragma unroll
                    for (int c = 0; c < 4; ++c) {
                        const bf16x8 v0 = *(const bf16x8*)(vbp + voff + c * 32), v1 = *(const bf16x8*)(vbp + voff + 32 * VROW + c * 32);
                        o[u][0] = __builtin_amdgcn_mfma_f32_32x32x16_bf16(v0, pfu[c], o[u][0], 0, 0, 0);
                        o[u][1] = __builtin_amdgcn_mfma_f32_32x32x16_bf16(v1, pfu[c], o[u][1], 0, 0, 0);
                    }
                };
                bf16x8 pfa[4], pfb[4];
                soft(0, pfa);
                pvm(0, pfa);
                soft(1, pfb);
#pragma unroll
                for (int i = 0; i < 8; ++i) { __builtin_amdgcn_sched_group_barrier(0x008, 1, 0); __builtin_amdgcn_sched_group_barrier(0x002, 10, 0); }
                pvm(1, pfb);
                if (kt + 1 < 64) storekv((kt + 1) & 1);
                __syncthreads();
            }
#pragma unroll
            for (int u = 0; u < 2; ++u) {
                const float ltot = lrun[u] + __shfl_xor(lrun[u], 32);
                const float inv = 1.0f / ltot;
                float ss = 0.f;
#pragma unroll
                for (int r = 0; r < 16; ++r) { o[u][0][r] *= inv; o[u][1][r] *= inv; ss += o[u][0][r] * o[u][0][r] + o[u][1][r] * o[u][1][r]; }
                ss += __shfl_xor(ss, 32);
                const float rn = rsqrtf(ss * (1.0f / 64.0f) + EPS);
                bf16_t* mp = mix + (size_t)(b * S + qb * 256 + wave * 64 + u * 32 + fm) * D + h * 64 + 4 * hi;
#pragma unroll
                for (int d0 = 0; d0 < 2; ++d0)
#pragma unroll
                    for (int g = 0; g < 4; ++g)
                        *(u32x2*)(mp + d0 * 32 + 8 * g) = (u32x2){pk2(o[u][d0][4 * g] * rn, o[u][d0][4 * g + 1] * rn), pk2(o[u][d0][4 * g + 2] * rn, o[u][d0][4 * g + 3] * rn)};
            }
        }
        xcd_barrier(xbar);

        if (STOP == 3) { dump_bf(mix, 1024); return; }
        if (PHASES & 32) for (int t = vb; t < 128 * 4; t += G) {
            const int panel = t >> 2, ct = t & 3, row0 = panel * 128, col0 = ct * 256;
            f32x16 acc[2][4];
            gemm_mainloop_w(mix + (size_t)row0 * D, D, WOUT + (size_t)col0 * D, D, D, lds, acc);
            exch_epilogue_w(acc, row0, col0, gran + (size_t)0 * T * 16, (unsigned)(l * 4 + 1), P.in[12] + l * D, xout, xb, st + (size_t)ST_X1 * T * 16, ep);
            __syncthreads();
        }
        xcd_barrier(xbar);

        if (STOP == 4) { return; }
        if (PHASES & 64) for (int t = vb; t < 2048 + 1024; t += G) {
            const int tid = opq(threadIdx.x), lane = tid & 63, wave = __builtin_amdgcn_readfirstlane(tid >> 6), wm = wave >> 1, wn = wave & 1, fm = lane & 31, hi = lane >> 5; (void)lane;
            if (t < 2048) {
                int panel = t >> 4, ct = t & 15;
                if (G == 512) { const int M = (t >> 9) * 8 + (vb >> 6), q = vb & 63; panel = (M >> 1) * 8 + (q >> 3); ct = (M & 1) * 8 + (q & 7); }
                const int row0 = panel * 128, col0 = ct * 256;
                if (tid < 128) ep[tid] = rsqrtf(sum_slots(st + ((size_t)ST_X1 * T + row0 + tid) * 16, 8) * (1.0f / 1024.0f) + EPS);
                f32x16 acc[2][4];
                gemm_mainloop_w(xb + (size_t)row0 * D, D, WUP + (size_t)col0 * D, D, D, lds, acc);
#pragma unroll
                for (int mt = 0; mt < 2; ++mt) {
                    float rs[16];
#pragma unroll
                    for (int r = 0; r < 16; ++r) rs[r] = ep[wm * 64 + mt * 32 + crow(r, hi)];
#pragma unroll
                    for (int nt = 0; nt < 4; ++nt) {
                        const int col = col0 + wn * 128 + nt * 32 + fm;
#pragma unroll
                        for (int r = 0; r < 16; ++r) {
                            const float v = fmaxf(acc[mt][nt][r] * rs[r], 0.f);
                            ub[(size_t)(row0 + wm * 64 + mt * 32 + crow(r, hi)) * FF + col] = f2bf(v * v);
                        }
                    }
                }
            } else {
                const int t2 = t - 2048;
                const int panel = t2 >> 3, ct = t2 & 7, row0 = panel * 128, col0 = ct * 128;
                f32x16 acc[2][2];
                gemm_mainloop<true>(P.in[1] + ((size_t)l * T + row0) * 256, 256, WP + (size_t)col0 * 256, 256, 256, lds, acc);
#pragma unroll
                for (int mt = 0; mt < 2; ++mt)
#pragma unroll
                    for (int nt = 0; nt < 2; ++nt) {
                        const int col = col0 + wn * 64 + nt * 32 + fm;
#pragma unroll
                        for (int r = 0; r < 16; ++r) ebuf[(size_t)(row0 + wm * 64 + mt * 32 + crow(r, hi)) * D + col] = f2bf(acc[mt][nt][r]);
                    }
            }
            __syncthreads();
        }
        xcd_barrier(xbar);

        if (STOP == 5) { dump_bf(ub, 4096); return; }
        if (STOP == 15) { dump_bf(ebuf, 1024); return; }
        if (PHASES & 128) for (int t = vb; t < 128 * 4; t += G) {
            const int panel = t >> 2, ct = t & 3, row0 = panel * 128, col0 = ct * 256;
            f32x16 acc[2][4];
            gemm_mainloop_w(ub + (size_t)row0 * FF, FF, WDOWN + (size_t)col0 * FF, FF, FF, lds, acc);
            exch_epilogue_w(acc, row0, col0, gran + (size_t)1 * T * 16, (unsigned)(l * 4 + 2), P.in[16] + l * D, xout, xb, st + (size_t)ST_X2 * T * 16, ep);
            __syncthreads();
        }
        xcd_barrier(xbar);

        if (STOP == 6) { return; }
        if (PHASES & 256) for (int t = vb; t < 128 * 8; t += G) {
            const int tid = opq(threadIdx.x), lane = tid & 63, wave = __builtin_amdgcn_readfirstlane(tid >> 6), wm = wave >> 1, wn = wave & 1, fm = lane & 31, hi = lane >> 5; (void)wm; (void)wn; (void)fm; (void)hi; (void)wave; (void)lane;
            const int panel = t >> 3, ct = t & 7, row0 = panel * 128, col0 = ct * 128;
            if (tid < 128) ep[tid] = rsqrtf(sum_slots(st + ((size_t)ST_X2 * T + row0 + tid) * 16, 8) * (1.0f / 1024.0f) + EPS);
            f32x16 acc[2][2];
            gemm_mainloop<false>(xb + (size_t)row0 * D, D, WG + (size_t)col0 * D, D, D, lds, acc);
#pragma unroll
            for (int mt = 0; mt < 2; ++mt) {
                float rs[16];
#pragma unroll
                for (int r = 0; r < 16; ++r) rs[r] = ep[wm * 64 + mt * 32 + crow(r, hi)];
#pragma unroll
                for (int nt = 0; nt < 2; ++nt) {
                    const int col = col0 + wn * 64 + nt * 32 + fm;
#pragma unroll
                    for (int r = 0; r < 16; ++r) {
                        const float gte = 1.0f / (1.0f + __expf(-acc[mt][nt][r] * rs[r]));
                        acc[mt][nt][r] = gte * bf2f(ebuf[(size_t)(row0 + wm * 64 + mt * 32 + crow(r, hi)) * D + col]);
                    }
                }
            }
            exch_epilogue(acc, row0, col0, gran + (size_t)2 * T * 16, (unsigned)(l * 4 + 3), P.in[20] + l * D, (l == NL - 1) ? xout : nullptr, xb, st + (size_t)ST_X0 * T * 16, ep);
            __syncthreads();
        }
        if (STOP == 7) return;
        if (l + 1 < NL) xcd_barrier(xbar);
    }
}

extern "C" void kernel_launch(void* const* d_in, const int* in_sizes, int n_in, void* d_out, int out_size, void* d_ws, size_t ws_size, hipStream_t stream) {
    static int grid = 0;
    if (grid == 0) {
        if (n_in != 21 || out_size != T * D || ws_size < WS_END) { fprintf(stderr, "kernel_launch: unexpected problem (n_in %d out %d ws %zu)\n", n_in, out_size, ws_size); grid = -1; return; }
        int dev = 0, cus = 0, per_cu = 0;
        hipGetDevice(&dev);
        hipDeviceGetAttribute(&cus, hipDeviceAttributeMultiprocessorCount, dev);
        if (hipFuncSetAttribute((const void*)mega, hipFuncAttributeMaxDynamicSharedMemorySize, LDS_BYTES) != hipSuccess) { fprintf(stderr, "hipFuncSetAttribute failed\n"); grid = -1; return; }
        if (hipOccupancyMaxActiveBlocksPerMultiprocessor(&per_cu, (const void*)mega, 256, LDS_BYTES) != hipSuccess || per_cu < 1) { fprintf(stderr, "occupancy query failed (%d)\n", per_cu); per_cu = 1; }
        if (per_cu > 2) per_cu = 2;
        grid = (cus * per_cu) & ~7;
        fprintf(stderr, "kernel_launch: cus %d per_cu %d grid %d\n", cus, per_cu, grid);
    }
    if (grid < 0) return;
    Params p{};
    for (int i = 0; i < 21; ++i) p.in[i] = (const float*)d_in[i];
    p.out = (float*)d_out; p.ws = (unsigned char*)d_ws;
    void* args[] = {&p};
    hipError_t e = hipLaunchCooperativeKernel((const void*)mega, dim3(grid), dim3(256), args, LDS_BYTES, stream);
    if (e != hipSuccess) fprintf(stderr, "cooperative launch failed: %s (grid %d)\n", hipGetErrorString(e), grid);
}
```

```cpp
#include <hip/hip_runtime.h>
#include <hip/hip_cooperative_groups.h>
#include <cstdio>
#include <cstdint>
namespace cg = cooperative_groups;

typedef unsigned short bf16_t;
typedef short bf16x8 __attribute__((ext_vector_type(8)));
typedef float f32x16 __attribute__((ext_vector_type(16)));
typedef float f32x4 __attribute__((ext_vector_type(4)));
typedef unsigned u32x4 __attribute__((ext_vector_type(4)));
typedef unsigned u32x2 __attribute__((ext_vector_type(2)));

constexpr int T = 16384, S = 4096, D = 1024, NL = 4, NH = 8, ZW = 2304, FF = 4096;
constexpr float EPS = 1e-6f;
constexpr float QSCALE = 0.10206207261596575f * 1.4426950408889634f;

constexpr size_t MiB = (size_t)1 << 20;
constexpr size_t WS_STAT = 0;
constexpr size_t WS_CNT = 8 * MiB;
constexpr size_t WS_ROPE = 9 * MiB;
constexpr size_t WS_W = 10 * MiB;
constexpr size_t WL_BYTES = 27328512;
constexpr size_t OW_IN = 0, OW_QB = 4718592, OW_KVB = 5308416, OW_OUT = 5832704, OW_UP = 7929856, OW_DOWN = 16318464, OW_G = 24707072, OW_P = 26804224;
constexpr size_t WS_XB = 115 * MiB;
constexpr size_t WS_MIX = 147 * MiB;
constexpr size_t WS_Z = 179 * MiB;
constexpr size_t WS_Q = 251 * MiB;
constexpr size_t WS_K = 275 * MiB;
constexpr size_t WS_VT = 299 * MiB;
constexpr size_t WS_U = 179 * MiB;
constexpr size_t WS_GRAN = 315 * MiB;
constexpr size_t WS_END = 321 * MiB;

enum { ST_X0 = 0, ST_QA = 1, ST_KVA = 2, ST_Y1 = 3, ST_X1 = 4, ST_F = 5, ST_X2 = 6, ST_T = 7 };

constexpr int LROW = 144;
constexpr int TILE_BYTES = 128 * LROW;
constexpr int EP_OFF = 4 * TILE_BYTES;
constexpr int XB_OFF = EP_OFF + 1024;
constexpr int LDS_BYTES = XB_OFF + 64;
constexpr int KROW = 208, VROW = 144;
constexpr int KT_BYTES = 64 * KROW, VT_BYTES = 64 * VROW;

#ifndef PHASES
#define PHASES 511
#endif
#ifndef REPG
#define REPG 1
#endif
#ifndef REPA
#define REPA 1
#endif
#ifndef REPP
#define REPP 1
#endif
#ifndef STOP
#define STOP 0
#endif
struct Params { const float* in[21]; float* out; unsigned char* ws; };

typedef float f32x2_t __attribute__((ext_vector_type(2)));
typedef __bf16 bf16x2_t __attribute__((ext_vector_type(2)));
__device__ __forceinline__ unsigned pk2(float lo, float hi) { const f32x2_t v = {lo, hi}; const bf16x2_t b = __builtin_convertvector(v, bf16x2_t); return __builtin_bit_cast(unsigned, b); }
__device__ __forceinline__ bf16_t f2bf(float f) { return (bf16_t)(pk2(f, 0.f) & 0xffffu); }
__device__ __forceinline__ float bf2f(bf16_t b) { return __uint_as_float(((unsigned)b) << 16); }
__device__ __forceinline__ float bflo(unsigned w) { return __uint_as_float(w << 16); }
__device__ __forceinline__ float bfhi(unsigned w) { return __uint_as_float(w & 0xffff0000u); }
__device__ __forceinline__ int opq(int v) { asm volatile("" : "+v"(v)); return v; }
__device__ __forceinline__ int crow(int r, int hi) { return (r & 3) + 8 * (r >> 2) + 4 * hi; }
__device__ __forceinline__ int vblock() { const int G = gridDim.x, b = blockIdx.x; return (G % 8 == 0) ? (b % 8) * (G / 8) + b / 8 : b; }
__device__ __forceinline__ void st_wt(float* p, float v) { __hip_atomic_store(p, v, __ATOMIC_RELAXED, __HIP_MEMORY_SCOPE_AGENT); }
__device__ __forceinline__ float atomic_ldf(const float* p) { return __hip_atomic_load(p, __ATOMIC_RELAXED, __HIP_MEMORY_SCOPE_AGENT); }
__device__ __forceinline__ float sum_slots(const float* p, int nslot) {
    const f32x4* q = (const f32x4*)p; float s = 0.f;
    for (int i = 0; i < (nslot >> 2); ++i) { const f32x4 a = q[i]; s += (a[0] + a[1]) + (a[2] + a[3]); }
    for (int i = nslot & ~3; i < nslot; ++i) s += p[i];
    return s;
}

__device__ __forceinline__ float rowsum32(const float (&s)[16], int lane) {
    const bool b4 = lane & 16, b3 = lane & 8, b2 = lane & 4, b1 = lane & 2;
    float a[8], b[4], c[2], d;
#pragma unroll
    for (int i = 0; i < 8; ++i) { const float keep = b4 ? s[8 + i] : s[i], send = b4 ? s[i] : s[8 + i]; a[i] = keep + __shfl_xor(send, 16); }
#pragma unroll
    for (int i = 0; i < 4; ++i) { const float keep = b3 ? a[4 + i] : a[i], send = b3 ? a[i] : a[4 + i]; b[i] = keep + __shfl_xor(send, 8); }
#pragma unroll
    for (int i = 0; i < 2; ++i) { const float keep = b2 ? b[2 + i] : b[i], send = b2 ? b[i] : b[2 + i]; c[i] = keep + __shfl_xor(send, 4); }
    { const float keep = b1 ? c[1] : c[0], send = b1 ? c[0] : c[1]; d = keep + __shfl_xor(send, 2); }
    d += __shfl_xor(d, 1);
    return d;
}

template <bool AF32>
__device__ __forceinline__ void gemm_mainloop(const void* __restrict__ Ap, int lda, const bf16_t* __restrict__ Bt, int ldb, int K,
                                              unsigned char* smem, f32x16 (&acc)[2][2]) {
    const int tid = opq(threadIdx.x), lane = tid & 63, wave = __builtin_amdgcn_readfirstlane(tid >> 6), wm = wave >> 1, wn = wave & 1, fm = lane & 31, hi = lane >> 5;
    const int srow = tid >> 3, skc = tid & 7;
    u32x4 ra0[4], rb0[4], ra1[4], rb1[4];
    u32x4 rx0[AF32 ? 4 : 1], rx1[AF32 ? 4 : 1];
#pragma unroll
    for (int i = 0; i < 2; ++i)
#pragma unroll
        for (int j = 0; j < 2; ++j)
#pragma unroll
            for (int r = 0; r < 16; ++r) acc[i][j][r] = 0.f;
    const int aoff = (wm * 64 + fm) * LROW + hi * 16, boff = (wn * 64 + fm) * LROW + hi * 16;
    const int soff = srow * LROW + skc * 16;
    const unsigned la = (unsigned)(srow * lda + skc * 8), lb = (unsigned)(srow * ldb + skc * 8);
    auto loadt = [&](int k0, u32x4 (&ra)[4], u32x4 (&rx)[AF32 ? 4 : 1], u32x4 (&rb)[4]) __attribute__((always_inline)) {
#pragma unroll
        for (int i = 0; i < 4; ++i) {
            if (AF32) {
                const float* ap = (const float*)Ap + (size_t)(32 * i) * lda + k0;
                ra[i] = *(const u32x4*)(ap + la); rx[i] = *(const u32x4*)(ap + la + 4);
            } else {
                const bf16_t* ap = (const bf16_t*)Ap + (size_t)(32 * i) * lda + k0;
                ra[i] = *(const u32x4*)(ap + la);
            }
            const bf16_t* bp = Bt + (size_t)(32 * i) * ldb + k0;
            rb[i] = *(const u32x4*)(bp + lb);
        }
    };
    auto storet = [&](int buf, const u32x4 (&ra)[4], const u32x4 (&rx)[AF32 ? 4 : 1], const u32x4 (&rb)[4]) __attribute__((always_inline)) {
        unsigned char* a = smem + buf * 2 * TILE_BYTES;
        unsigned char* b = a + TILE_BYTES;
#pragma unroll
        for (int i = 0; i < 4; ++i) {
            u32x4 av = ra[i];
            if (AF32) av = (u32x4){pk2(__uint_as_float(ra[i][0]), __uint_as_float(ra[i][1])), pk2(__uint_as_float(ra[i][2]), __uint_as_float(ra[i][3])),
                                   pk2(__uint_as_float(rx[i][0]), __uint_as_float(rx[i][1])), pk2(__uint_as_float(rx[i][2]), __uint_as_float(rx[i][3]))};
            *(u32x4*)(a + soff + i * 32 * LROW) = av; *(u32x4*)(b + soff + i * 32 * LROW) = rb[i];
        }
    };
    auto compute = [&](int buf) __attribute__((always_inline)) {
        const unsigned char* a = smem + buf * 2 * TILE_BYTES;
        const unsigned char* b = a + TILE_BYTES;
        __builtin_amdgcn_s_setprio(1);
#pragma unroll
        for (int kk = 0; kk < 4; ++kk) {
            const bf16x8 a0 = *(const bf16x8*)(a + aoff + kk * 32), a1 = *(const bf16x8*)(a + aoff + 32 * LROW + kk * 32);
            const bf16x8 b0 = *(const bf16x8*)(b + boff + kk * 32), b1 = *(const bf16x8*)(b + boff + 32 * LROW + kk * 32);
            acc[0][0] = __builtin_amdgcn_mfma_f32_32x32x16_bf16(a0, b0, acc[0][0], 0, 0, 0);
            acc[0][1] = __builtin_amdgcn_mfma_f32_32x32x16_bf16(a0, b1, acc[0][1], 0, 0, 0);
            acc[1][0] = __builtin_amdgcn_mfma_f32_32x32x16_bf16(a1, b0, acc[1][0], 0, 0, 0);
            acc[1][1] = __builtin_amdgcn_mfma_f32_32x32x16_bf16(a1, b1, acc[1][1], 0, 0, 0);
        }
        __builtin_amdgcn_s_setprio(0);
    };
    const int nk = K >> 6;
    for (int rep = 0; rep < REPG; ++rep) {
    if (rep) {
#pragma unroll
        for (int i = 0; i < 2; ++i)
#pragma unroll
            for (int j = 0; j < 2; ++j)
#pragma unroll
                for (int r = 0; r < 16; ++r) acc[i][j][r] = 0.f;
    }
    loadt(0, ra0, rx0, rb0);
    if (nk > 1) loadt(64, ra1, rx1, rb1);
    storet(0, ra0, rx0, rb0); __syncthreads();
    for (int kt = 0; kt < nk; kt += 2) {
        if (kt + 2 < nk) loadt((kt + 2) << 6, ra0, rx0, rb0);
        __builtin_amdgcn_sched_barrier(0);
        compute(0);
        if (kt + 1 < nk) storet(1, ra1, rx1, rb1);
        __syncthreads();
        if (kt + 1 < nk) {
            if (kt + 3 < nk) loadt((kt + 3) << 6, ra1, rx1, rb1);
            __builtin_amdgcn_sched_barrier(0);
            compute(1);
            if (kt + 2 < nk) storet(0, ra0, rx0, rb0);
            __syncthreads();
        }
    }
    }
}

constexpr int LROW2 = 80;
constexpr int A2_BYTES = 128 * LROW2, B2_BYTES = 256 * LROW2, STAGE2 = A2_BYTES + B2_BYTES;
__device__ __forceinline__ void gemm_mainloop_w(const bf16_t* __restrict__ Ap, int lda, const bf16_t* __restrict__ Bt, int ldb, int K,
                                                unsigned char* smem, f32x16 (&acc)[2][4]) {
    const int tid = opq(threadIdx.x), lane = tid & 63, wave = __builtin_amdgcn_readfirstlane(tid >> 6), wm = wave >> 1, wn = wave & 1, fm = lane & 31, hi = lane >> 5;
    const int srow = tid >> 2, skc = tid & 3;
    u32x4 ra0[2], rb0[4], ra1[2], rb1[4];
#pragma unroll
    for (int i = 0; i < 2; ++i)
#pragma unroll
        for (int j = 0; j < 4; ++j)
#pragma unroll
            for (int r = 0; r < 16; ++r) acc[i][j][r] = 0.f;
    const int aoff = (wm * 64 + fm) * LROW2 + hi * 16, boff = A2_BYTES + (wn * 128 + fm) * LROW2 + hi * 16;
    const int soff = srow * LROW2 + skc * 16;
    const unsigned la = (unsigned)(srow * lda + skc * 8), lb = (unsigned)(srow * ldb + skc * 8);
    auto loadt = [&](int k0, u32x4 (&ra)[2], u32x4 (&rb)[4]) __attribute__((always_inline)) {
#pragma unroll
        for (int i = 0; i < 2; ++i) { const bf16_t* ap = Ap + (size_t)(64 * i) * lda + k0; ra[i] = *(const u32x4*)(ap + la); }
#pragma unroll
        for (int i = 0; i < 4; ++i) { const bf16_t* bp = Bt + (size_t)(64 * i) * ldb + k0; rb[i] = *(const u32x4*)(bp + lb); }
    };
    auto storet = [&](int buf, const u32x4 (&ra)[2], const u32x4 (&rb)[4]) __attribute__((always_inline)) {
        unsigned char* a = smem + buf * STAGE2;
#pragma unroll
        for (int i = 0; i < 2; ++i) *(u32x4*)(a + soff + i * 64 * LROW2) = ra[i];
#pragma unroll
        for (int i = 0; i < 4; ++i) *(u32x4*)(a + A2_BYTES + soff + i * 64 * LROW2) = rb[i];
    };
    auto compute = [&](int buf) __attribute__((always_inline)) {
        const unsigned char* s = smem + buf * STAGE2;
        bf16x8 a[2][2], b[2][4];
#pragma unroll
        for (int kk = 0; kk < 2; ++kk) {
            a[kk][0] = *(const bf16x8*)(s + aoff + kk * 32); a[kk][1] = *(const bf16x8*)(s + aoff + 32 * LROW2 + kk * 32);
#pragma unroll
            for (int nt = 0; nt < 4; ++nt) b[kk][nt] = *(const bf16x8*)(s + boff + nt * 32 * LROW2 + kk * 32);
        }
        __builtin_amdgcn_sched_barrier(0);
        __builtin_amdgcn_s_setprio(1);
#pragma unroll
        for (int kk = 0; kk < 2; ++kk)
#pragma unroll
            for (int nt = 0; nt < 4; ++nt) {
                acc[0][nt] = __builtin_amdgcn_mfma_f32_32x32x16_bf16(a[kk][0], b[kk][nt], acc[0][nt], 0, 0, 0);
                acc[1][nt] = __builtin_amdgcn_mfma_f32_32x32x16_bf16(a[kk][1], b[kk][nt], acc[1][nt], 0, 0, 0);
            }
        __builtin_amdgcn_s_setprio(0);
    };
    const int nk = K >> 5;
    loadt(0, ra0, rb0);
    if (nk > 1) loadt(32, ra1, rb1);
    storet(0, ra0, rb0); __syncthreads();
    for (int kt = 0; kt < nk; kt += 2) {
        if (kt + 2 < nk) loadt((kt + 2) << 5, ra0, rb0);
        __builtin_amdgcn_sched_barrier(0);
        compute(0);
        if (kt + 1 < nk) storet(1, ra1, rb1);
        __syncthreads();
        if (kt + 1 < nk) {
            if (kt + 3 < nk) loadt((kt + 3) << 5, ra1, rb1);
            __builtin_amdgcn_sched_barrier(0);
            compute(1);
            if (kt + 2 < nk) storet(0, ra0, rb0);
            __syncthreads();
        }
    }
}

__device__ __forceinline__ void gemm_mainloop_w3(const bf16_t* __restrict__ Ap, int lda, const bf16_t* __restrict__ Bt, int ldb, int K,
                                                unsigned char* smem, f32x16 (&acc)[2][3]) {
    const int tid = opq(threadIdx.x), lane = tid & 63, wave = __builtin_amdgcn_readfirstlane(tid >> 6), wm = wave >> 1, wn = wave & 1, fm = lane & 31, hi = lane >> 5;
    const int srow = tid >> 2, skc = tid & 3;
    u32x4 ra0[2], rb0[3], ra1[2], rb1[3];
#pragma unroll
    for (int i = 0; i < 2; ++i)
#pragma unroll
        for (int j = 0; j < 3; ++j)
#pragma unroll
            for (int r = 0; r < 16; ++r) acc[i][j][r] = 0.f;
    const int aoff = (wm * 64 + fm) * LROW2 + hi * 16, boff = A2_BYTES + (wn * 96 + fm) * LROW2 + hi * 16;
    const int soff = srow * LROW2 + skc * 16;
    const unsigned la = (unsigned)(srow * lda + skc * 8), lb = (unsigned)(srow * ldb + skc * 8);
    auto loadt = [&](int k0, u32x4 (&ra)[2], u32x4 (&rb)[3]) __attribute__((always_inline)) {
#pragma unroll
        for (int i = 0; i < 2; ++i) { const bf16_t* ap = Ap + (size_t)(64 * i) * lda + k0; ra[i] = *(const u32x4*)(ap + la); }
#pragma unroll
        for (int i = 0; i < 3; ++i) { const bf16_t* bp = Bt + (size_t)(64 * i) * ldb + k0; rb[i] = *(const u32x4*)(bp + lb); }
    };
    auto storet = [&](int buf, const u32x4 (&ra)[2], const u32x4 (&rb)[3]) __attribute__((always_inline)) {
        unsigned char* a = smem + buf * STAGE2;
#pragma unroll
        for (int i = 0; i < 2; ++i) *(u32x4*)(a + soff + i * 64 * LROW2) = ra[i];
#pragma unroll
        for (int i = 0; i < 3; ++i) *(u32x4*)(a + A2_BYTES + soff + i * 64 * LROW2) = rb[i];
    };
    auto compute = [&](int buf) __attribute__((always_inline)) {
        const unsigned char* s = smem + buf * STAGE2;
        bf16x8 a[2][2], b[2][3];
#pragma unroll
        for (int kk = 0; kk < 2; ++kk) {
            a[kk][0] = *(const bf16x8*)(s + aoff + kk * 32); a[kk][1] = *(const bf16x8*)(s + aoff + 32 * LROW2 + kk * 32);
#pragma unroll
            for (int nt = 0; nt < 3; ++nt) b[kk][nt] = *(const bf16x8*)(s + boff + nt * 32 * LROW2 + kk * 32);
        }
        __builtin_amdgcn_sched_barrier(0);
        __builtin_amdgcn_s_setprio(1);
#pragma unroll
        for (int kk = 0; kk < 2; ++kk)
#pragma unroll
            for (int nt = 0; nt < 3; ++nt) {
                acc[0][nt] = __builtin_amdgcn_mfma_f32_32x32x16_bf16(a[kk][0], b[kk][nt], acc[0][nt], 0, 0, 0);
                acc[1][nt] = __builtin_amdgcn_mfma_f32_32x32x16_bf16(a[kk][1], b[kk][nt], acc[1][nt], 0, 0, 0);
            }
        __builtin_amdgcn_s_setprio(0);
    };
    const int nk = K >> 5;
    loadt(0, ra0, rb0);
    if (nk > 1) loadt(32, ra1, rb1);
    storet(0, ra0, rb0); __syncthreads();
    for (int kt = 0; kt < nk; kt += 2) {
        if (kt + 2 < nk) loadt((kt + 2) << 5, ra0, rb0);
        __builtin_amdgcn_sched_barrier(0);
        compute(0);
        if (kt + 1 < nk) storet(1, ra1, rb1);
        __syncthreads();
        if (kt + 1 < nk) {
            if (kt + 3 < nk) loadt((kt + 3) << 5, ra1, rb1);
            __builtin_amdgcn_sched_barrier(0);
            compute(1);
            if (kt + 2 < nk) storet(0, ra0, rb0);
            __syncthreads();
        }
    }
}

__device__ __forceinline__ void exch_epilogue(f32x16 (&v)[2][2], int row0, int col0, unsigned long long* gran, unsigned tag, const float* __restrict__ gain,
                                              float* xout, bf16_t* xb, float* part_next, float* ep) {
    const int tid = opq(threadIdx.x), lane = tid & 63, wave = __builtin_amdgcn_readfirstlane(tid >> 6), wm = wave >> 1, wn = wave & 1, fm = lane & 31, hi = lane >> 5;
    const int slot = (col0 >> 7) * 2 + wn;
    float xo[2][2][16];
#pragma unroll
    for (int mt = 0; mt < 2; ++mt)
#pragma unroll
        for (int nt = 0; nt < 2; ++nt) {
            const bf16_t* xp = xb + (size_t)(row0 + wm * 64 + mt * 32 + 4 * hi) * D + col0 + wn * 64 + nt * 32 + fm;
#pragma unroll
            for (int r = 0; r < 16; ++r) xo[mt][nt][r] = bf2f(xp[((r & 3) + 8 * (r >> 2)) * D]);
        }
#pragma unroll
    for (int mt = 0; mt < 2; ++mt) {
        float ss[16];
#pragma unroll
        for (int r = 0; r < 16; ++r) ss[r] = v[mt][0][r] * v[mt][0][r] + v[mt][1][r] * v[mt][1][r];
        const float tot = rowsum32(ss, lane);
        if ((lane & 1) == 0) __hip_atomic_store(gran + (size_t)(row0 + wm * 64 + mt * 32 + crow((lane >> 1) & 15, hi)) * 16 + slot, ((unsigned long long)tag << 32) | (unsigned long long)__float_as_uint(tot), __ATOMIC_RELAXED, __HIP_MEMORY_SCOPE_AGENT);
    }
    if (tid < 128) {
        const unsigned long long* g = gran + (size_t)(row0 + tid) * 16;
        float s;
        for (;;) {
            s = 0.f; bool ok = true;
#pragma unroll
            for (int i = 0; i < 16; ++i) { const unsigned long long x = __hip_atomic_load(g + i, __ATOMIC_RELAXED, __HIP_MEMORY_SCOPE_AGENT); ok &= ((unsigned)(x >> 32) == tag); s += __uint_as_float((unsigned)x); }
            if (ok) break;
            __builtin_amdgcn_s_sleep(1);
        }
        ep[128 + tid] = rsqrtf(s * (1.0f / 1024.0f) + EPS);
    }
    __syncthreads();
#pragma unroll
    for (int mt = 0; mt < 2; ++mt) {
        float ss[16], rs[16];
#pragma unroll
        for (int r = 0; r < 16; ++r) { ss[r] = 0.f; rs[r] = ep[128 + wm * 64 + mt * 32 + crow(r, hi)]; }
#pragma unroll
        for (int nt = 0; nt < 2; ++nt) {
            const int col = col0 + wn * 64 + nt * 32 + fm;
            const float g = gain[col];
            float* xp = xout + (size_t)(row0 + wm * 64 + mt * 32 + 4 * hi) * D + col;
            bf16_t* bp = xb + (size_t)(row0 + wm * 64 + mt * 32 + 4 * hi) * D + col;
#pragma unroll
            for (int g4 = 0; g4 < 4; ++g4) {
#pragma unroll
                for (int i = 0; i < 4; ++i) {
                    const int r = 4 * g4 + i, off = (8 * g4 + i) * D;
                    const float xf = xo[mt][nt][r] + v[mt][nt][r] * rs[r] * g;
                    const bf16_t xq = f2bf(xf);
                    const float xn = bf2f(xq);
                    bp[off] = xq; if (xout) xp[off] = xf; ss[r] += xn * xn;
                }
                asm volatile("" ::: "memory");
            }
        }
        const float tot = rowsum32(ss, lane);
        if ((lane & 1) == 0) part_next[(size_t)(row0 + wm * 64 + mt * 32 + crow((lane >> 1) & 15, hi)) * 16 + slot] = tot;
    }
}

__device__ __forceinline__ void exch_epilogue_w(f32x16 (&v)[2][4], int row0, int col0, unsigned long long* gran, unsigned tag, const float* __restrict__ gain,
                                                float* xout, bf16_t* xb, float* part_next, float* ep) {
    const int tid = opq(threadIdx.x), lane = tid & 63, wave = __builtin_amdgcn_readfirstlane(tid >> 6), wm = wave >> 1, wn = wave & 1, fm = lane & 31, hi = lane >> 5;
    const int slot = (col0 >> 8) * 2 + wn;
    float xs[2][16];
    auto ldx = [&](int u, float (&x)[16]) __attribute__((always_inline)) {
        const int lo = opq((4 * hi) * D + fm);
        const bf16_t* xp = xb + (size_t)(row0 + wm * 64 + (u >> 2) * 32) * D + col0 + wn * 128 + (u & 3) * 32 + lo;
#pragma unroll
        for (int r = 0; r < 16; ++r) x[r] = bf2f(xp[((r & 3) + 8 * (r >> 2)) * D]);
    };
    ldx(0, xs[0]);
#pragma unroll
    for (int mt = 0; mt < 2; ++mt) {
        float ss[16];
#pragma unroll
        for (int r = 0; r < 16; ++r) ss[r] = (v[mt][0][r] * v[mt][0][r] + v[mt][1][r] * v[mt][1][r]) + (v[mt][2][r] * v[mt][2][r] + v[mt][3][r] * v[mt][3][r]);
        const float tot = rowsum32(ss, lane);
        if ((lane & 1) == 0) __hip_atomic_store(gran + (size_t)(row0 + wm * 64 + mt * 32 + crow((lane >> 1) & 15, hi)) * 16 + slot, ((unsigned long long)tag << 32) | (unsigned long long)__float_as_uint(tot), __ATOMIC_RELAXED, __HIP_MEMORY_SCOPE_AGENT);
    }
    if (tid < 128) {
        const unsigned long long* g = gran + (size_t)(row0 + tid) * 16;
        float s;
        for (;;) {
            s = 0.f; bool ok = true;
#pragma unroll
            for (int i = 0; i < 8; ++i) { const unsigned long long x = __hip_atomic_load(g + i, __ATOMIC_RELAXED, __HIP_MEMORY_SCOPE_AGENT); ok &= ((unsigned)(x >> 32) == tag); s += __uint_as_float((unsigned)x); }
            if (ok) break;
            __builtin_amdgcn_s_sleep(1);
        }
        ep[128 + tid] = rsqrtf(s * (1.0f / 1024.0f) + EPS);
    }
    __syncthreads();
    float ss[16];
#pragma unroll
    for (int u = 0; u < 8; ++u) {
        const int mt = u >> 2, nt = u & 3;
        if (nt == 0) {
#pragma unroll
            for (int r = 0; r < 16; ++r) ss[r] = 0.f;
        }
        if (u + 1 < 8) ldx(u + 1, xs[(u + 1) & 1]);
        const int fmo = opq(fm), hio = opq(hi);
        const int col = col0 + wn * 128 + nt * 32 + fmo;
        const float g = gain[col];
        bf16_t* bp = xb + (size_t)(row0 + wm * 64 + mt * 32 + 4 * hio) * D + col;
#pragma unroll
        for (int g4 = 0; g4 < 4; ++g4) {
            const f32x4 rs4 = *(const f32x4*)(ep + 128 + wm * 64 + mt * 32 + 8 * g4 + 4 * hio);
#pragma unroll
            for (int i = 0; i < 4; ++i) {
                const int r = 4 * g4 + i, off = (8 * g4 + i) * D;
                const bf16_t xq = f2bf(xs[u & 1][r] + v[mt][nt][r] * rs4[i] * g);
                const float xn = bf2f(xq);
                bp[off] = xq; ss[r] += xn * xn;
            }
        }
        asm volatile("" ::: "memory");
        if (nt == 3) {
            const float tot = rowsum32(ss, lane);
            if ((lane & 1) == 0) part_next[(size_t)(row0 + wm * 64 + mt * 32 + crow((lane >> 1) & 15, hi)) * 16 + slot] = tot;
        }
    }
}

__device__ __forceinline__ void gbar(unsigned* ctr, unsigned& epoch, unsigned G) {
    asm volatile("s_waitcnt vmcnt(0)" ::: "memory");
    __syncthreads();
    epoch += 1u;
    if (threadIdx.x == 0) {
        __builtin_amdgcn_fence(__ATOMIC_RELEASE, "agent");
        asm volatile("s_waitcnt vmcnt(0)" ::: "memory");
        __hip_atomic_fetch_add(ctr, 1u, __ATOMIC_RELAXED, __HIP_MEMORY_SCOPE_AGENT);
        const unsigned target = epoch * G;
        while (__hip_atomic_load(ctr, __ATOMIC_RELAXED, __HIP_MEMORY_SCOPE_AGENT) < target) __builtin_amdgcn_s_sleep(1);
        __builtin_amdgcn_fence(__ATOMIC_ACQUIRE, "agent");
        asm volatile("s_waitcnt vmcnt(0)" ::: "memory");
    }
    __syncthreads();
}

#define LAS __attribute__((address_space(3)))
#define XB_TMO      128
#define XB_XCNT(j)  (256  + 64 * (j))
#define XB_XSUB(j)  (1280 + 64 * (j))
#define XB_XGEN(j)  (2304 + 64 * (j))
#define XB_TOP      3328
#define XB_TOPGEN   3392
#define XCD_BAR_WORDS 3456
#define XB_SPIN_CAP (1u << 22)
__device__ __forceinline__ unsigned xb_ld(unsigned* p)              { return __hip_atomic_load(p, __ATOMIC_RELAXED, __HIP_MEMORY_SCOPE_AGENT); }
__device__ __forceinline__ unsigned xb_add(unsigned* p, unsigned v) { return __hip_atomic_fetch_add(p, v, __ATOMIC_RELAXED, __HIP_MEMORY_SCOPE_AGENT); }
__device__ __forceinline__ unsigned xb_xcc_id() { return (unsigned)__builtin_amdgcn_s_getreg((3 << 11) | 20) & 0xFu; }
#define XB_SPIN(cond, bar) do { unsigned _sp = 0; while (cond) { __builtin_amdgcn_s_sleep(1); \
    if ((++_sp & 255u) == 0u) { if (xb_ld(&(bar)[XB_TMO])) break; if (_sp > XB_SPIN_CAP) { atomicAdd(&(bar)[XB_TMO], 1u); break; } } } } while (0)
struct XcdBarrier { unsigned* bar; unsigned x; volatile LAS unsigned* st; };
__device__ __forceinline__ XcdBarrier xcd_barrier_post(unsigned* bar, volatile LAS unsigned* st) {
    XcdBarrier b; b.bar = bar; b.x = xb_xcc_id(); b.st = st;
    if (threadIdx.x == 0) (void)xb_add(&bar[XB_XCNT(b.x)], 1u);
    return b;
}
__device__ __forceinline__ void xcd_barrier_complete(unsigned* bar, unsigned x, unsigned& nloc, unsigned& nx) {
    const unsigned G = gridDim.x * gridDim.y * gridDim.z;
    unsigned sum, cnt, mine, sp = 0u;
    for (;;) {
        sum = 0u; cnt = 0u; mine = 0u;
#pragma unroll
        for (unsigned j = 0; j < 16; ++j) { const unsigned c = xb_ld(&bar[XB_XCNT(j)]); sum += c; cnt += (c > 0u) ? 1u : 0u; mine = (j == x) ? c : mine; }
        if (sum == G) break;
        __builtin_amdgcn_s_sleep(1);
        if ((++sp & 255u) == 0u) { if (xb_ld(&bar[XB_TMO])) break; if (sp > XB_SPIN_CAP) { atomicAdd(&bar[XB_TMO], 1u); break; } }
    }
    nloc = mine > 0u ? mine : 1u; nx = cnt > 0u ? cnt : 1u;
}
__device__ __forceinline__ void xcd_barrier(const XcdBarrier& b) {
    asm volatile("s_waitcnt vmcnt(0)" ::: "memory");
    __syncthreads();
    if (threadIdx.x == 0) {
        unsigned* bar = b.bar;
        __builtin_amdgcn_s_waitcnt(0);
        unsigned nloc = b.st[0], nx = b.st[1];
        if (nloc == 0u) { xcd_barrier_complete(bar, b.x, nloc, nx); b.st[0] = nloc; b.st[1] = nx; }
        const unsigned old = xb_add(&bar[XB_XSUB(b.x)], 1u);
        const unsigned gen = old / nloc;
        if (old + 1u == (gen + 1u) * nloc) {
            __builtin_amdgcn_fence(__ATOMIC_RELEASE, "agent");
            asm volatile("s_waitcnt vmcnt(0)" ::: "memory");
            const unsigned og = xb_add(&bar[XB_TOP], 1u);
            const unsigned tg = og / nx;
            if (og + 1u == (tg + 1u) * nx) xb_add(&bar[XB_TOPGEN], 1u);
            else XB_SPIN(xb_ld(&bar[XB_TOPGEN]) == tg, bar);
            __builtin_amdgcn_fence(__ATOMIC_ACQUIRE, "agent");
            xb_add(&bar[XB_XGEN(b.x)], 1u);
            asm volatile("s_waitcnt vmcnt(0)" ::: "memory");
        } else {
            XB_SPIN(xb_ld(&bar[XB_XGEN(b.x)]) == gen, bar);
            __builtin_amdgcn_fence(__ATOMIC_ACQUIRE, "agent");
            asm volatile("s_waitcnt vmcnt(0)" ::: "memory");
        }
    }
    __syncthreads();
}

__global__ void __launch_bounds__(256, 2) mega(Params P) {
    extern __shared__ __attribute__((aligned(16))) unsigned char lds[];
    cg::grid_group grid = cg::this_grid();
    const int tid = threadIdx.x, lane = tid & 63, wave = __builtin_amdgcn_readfirstlane(tid >> 6), wm = wave >> 1, wn = wave & 1, fm = lane & 31, hi = lane >> 5;
    const int G = gridDim.x, vb = vblock();
    unsigned char* ws = P.ws;
    float* stat = (float*)(ws + WS_STAT);
    unsigned* cnts = (unsigned*)(ws + WS_CNT);
    float* cosT = (float*)(ws + WS_ROPE);
    float* sinT = cosT + S * 16;
    bf16_t* xb = (bf16_t*)(ws + WS_XB);
    bf16_t* mix = (bf16_t*)(ws + WS_MIX);
    bf16_t* ebuf = mix;
    bf16_t* zb = (bf16_t*)(ws + WS_Z);
    bf16_t* Qb = (bf16_t*)(ws + WS_Q);
    bf16_t* Kb = (bf16_t*)(ws + WS_K);
    bf16_t* Vt = (bf16_t*)(ws + WS_VT);
    bf16_t* ub = (bf16_t*)(ws + WS_U);
    float* xout = P.out;
    float* ep = (float*)(lds + EP_OFF);
    unsigned long long* gran = (unsigned long long*)(ws + WS_GRAN);
    unsigned* gctr = cnts + 4096;
    unsigned gepoch = 0u; (void)gepoch; (void)gctr;
    volatile LAS unsigned* xst = (volatile LAS unsigned*)((LAS unsigned char*)lds + XB_OFF);
    if (tid == 0) { xst[0] = 0u; xst[1] = 0u; }
    const XcdBarrier xbar = xcd_barrier_post(cnts + 8192, xst);

    auto dump_bf = [&](const bf16_t* buf, int pitch) {
        grid.sync();
        for (int i = vb * 256 + tid; i < T * D; i += G * 256) { const int row = i >> 10, col = i & 1023; xout[i] = bf2f(buf[(size_t)row * pitch + col]); }
    };
    if (PHASES & 1) for (int rep = 0; rep < REPP; ++rep) {
        float* tl = (float*)lds;
        for (int t = vb; t < NL * 3336; t += G) {
            const int l = t / 3336; int r = t % 3336;
            const float* src; const float* gA = nullptr; const float* gB = nullptr; int K, N, Np; size_t off;
            if (r < 576) { src = P.in[3] + (size_t)l * 1024 * 2208; gA = P.in[2] + l * 1024; gB = gA + 512; K = 1024; N = 2208; Np = 2304; off = OW_IN; }
            else if ((r -= 576) < 72) { src = P.in[5] + (size_t)l * 384 * 768; gA = P.in[4] + l * 384; gB = gA + 512; K = 384; N = 768; Np = 768; off = OW_QB; }
            else if ((r -= 72) < 64) { src = P.in[7] + (size_t)l * 256 * 1024; gA = P.in[6] + l * 256; gB = gA + 512; K = 256; N = 1024; Np = 1024; off = OW_KVB; }
            else if ((r -= 64) < 256) { src = P.in[11] + (size_t)l * 1024 * 1024; gA = P.in[9] + l * 512; gB = P.in[10] + l * 512; K = 1024; N = 1024; Np = 1024; off = OW_OUT; }
            else if ((r -= 256) < 1024) { src = P.in[14] + (size_t)l * 1024 * 4096; gA = P.in[13] + l * 1024; gB = gA + 512; K = 1024; N = 4096; Np = 4096; off = OW_UP; }
            else if ((r -= 1024) < 1024) { src = P.in[15] + (size_t)l * 4096 * 1024; K = 4096; N = 1024; Np = 1024; off = OW_DOWN; }
            else if ((r -= 1024) < 256) { src = P.in[18] + (size_t)l * 1024 * 1024; gA = P.in[17] + l * 1024; gB = gA + 512; K = 1024; N = 1024; Np = 1024; off = OW_G; }
            else { r -= 256; src = P.in[19] + (size_t)l * 256 * 1024; K = 256; N = 1024; Np = 1024; off = OW_P; }
            bf16_t* dst = (bf16_t*)(ws + WS_W + (size_t)l * WL_BYTES + off);
            const int nct = Np / 64, k0 = (r / nct) * 64, n0 = (r % nct) * 64;
#pragma unroll
            for (int j = 0; j < 4; ++j) {
                const int kr = (tid >> 4) + 16 * j, n4 = (tid & 15) * 4, k = k0 + kr;
                f32x4 v = (f32x4){0.f, 0.f, 0.f, 0.f};
                if (n0 + n4 < N) v = *(const f32x4*)(src + (size_t)k * N + n0 + n4);
                float g = 1.f;
                if (gA) g = (k < 512) ? gA[k] : gB[k - 512];
                tl[kr * 65 + n4 + 0] = v[0] * g; tl[kr * 65 + n4 + 1] = v[1] * g; tl[kr * 65 + n4 + 2] = v[2] * g; tl[kr * 65 + n4 + 3] = v[3] * g;
            }
            __syncthreads();
            {
                const int n = tid >> 2, kq = (tid & 3) * 16;
                unsigned w[8];
#pragma unroll
                for (int i = 0; i < 8; ++i) w[i] = pk2(tl[(kq + 2 * i) * 65 + n], tl[(kq + 2 * i + 1) * 65 + n]);
                bf16_t* dp = dst + (size_t)(n0 + n) * K + k0 + kq;
                *(u32x4*)dp = (u32x4){w[0], w[1], w[2], w[3]};
                *(u32x4*)(dp + 8) = (u32x4){w[4], w[5], w[6], w[7]};
            }
            __syncthreads();
        }
        const float* x = P.in[0];
        for (int row = vb * 4 + wave; row < T; row += G * 4) {
            float ss = 0.f;
#pragma unroll
            for (int j = 0; j < 4; ++j) {
                const size_t idx = (size_t)row * D + j * 256 + lane * 4;
                const f32x4 v = *(const f32x4*)(x + idx);
                *(u32x2*)(xb + idx) = (u32x2){pk2(v[0], v[1]), pk2(v[2], v[3])};
                ss += v[0] * v[0] + v[1] * v[1] + v[2] * v[2] + v[3] * v[3];
            }
            ss += __shfl_xor(ss, 32); ss += __shfl_xor(ss, 16); ss += __shfl_xor(ss, 8); ss += __shfl_xor(ss, 4); ss += __shfl_xor(ss, 2); ss += __shfl_xor(ss, 1);
            if (lane < 16) stat[((size_t)ST_X0 * T + row) * 16 + lane] = (lane == 0) ? ss : 0.f;
        }
        for (int idx = vb * 256 + tid; idx < NL * 3 * 128; idx += G * 256) cnts[idx] = 0u;
        if (blockIdx.x == 0 && tid == 0) *gctr = 0u;
        for (int idx = vb * 256 + tid; idx < 3 * T * 16 / 2; idx += G * 256) ((u32x4*)gran)[idx] = (u32x4){0u, 0u, 0u, 0u};
        for (int idx = vb * 256 + tid; idx < S * 16; idx += G * 256) {
            const int s = idx >> 4, j = idx & 15;
            const double base = sqrt(sqrt(sqrt(sqrt(10000.0))));
            double pw = 1.0;
            for (int q = 0; q < j; ++q) pw *= base;
            const float pwf = (float)pw;
            const float inv_freq = 1.0f / pwf;
            const float angf = (float)s * inv_freq;
            const double a = (double)angf;
            const double n = rint(a * 0.15915494309189535);
            const double rr = a - n * 6.283185307179586;
            const double r2 = rr * rr;
            double sn = 0.0, term = rr;
            for (int k = 0; k < 16; ++k) { sn += term; term *= -r2 / (double)((2 * k + 2) * (2 * k + 3)); }
            double cs = 0.0; term = 1.0;
            for (int k = 0; k < 16; ++k) { cs += term; term *= -r2 / (double)((2 * k + 1) * (2 * k + 2)); }
            cosT[idx] = (float)cs; sinT[idx] = (float)sn;
        }
    }
    xcd_barrier(xbar);
    if (P.ws == nullptr) grid.sync();

    for (int l = 0; l < NL; ++l) {
        const unsigned char* wl = ws + WS_W + (size_t)l * WL_BYTES;
        const bf16_t* WIN = (const bf16_t*)(wl + OW_IN);
        const bf16_t* WQB = (const bf16_t*)(wl + OW_QB);
        const bf16_t* WKVB = (const bf16_t*)(wl + OW_KVB);
        const bf16_t* WOUT = (const bf16_t*)(wl + OW_OUT);
        const bf16_t* WUP = (const bf16_t*)(wl + OW_UP);
        const bf16_t* WDOWN = (const bf16_t*)(wl + OW_DOWN);
        const bf16_t* WG = (const bf16_t*)(wl + OW_G);
        const bf16_t* WP = (const bf16_t*)(wl + OW_P);
        float* st = stat;

        if (PHASES & 2) for (int t = vb; t < 128 * 12; t += G) {
            const int tid = opq(threadIdx.x), lane = tid & 63, wave = __builtin_amdgcn_readfirstlane(tid >> 6), wm = wave >> 1, wn = wave & 1, fm = lane & 31, hi = lane >> 5;
            int panel = t / 12, ct = t % 12;
            if (G == 512) { const int M = (t >> 9) * 8 + (vb >> 6), q = vb & 63; panel = (M / 3) * 16 + (q >> 2); ct = (M % 3) * 4 + (q & 3); }
            const int row0 = panel * 128, col0 = ct * 192;
            if (tid < 128) ep[tid] = rsqrtf(sum_slots(st + ((size_t)ST_X0 * T + row0 + tid) * 16, 16) * (1.0f / 1024.0f) + EPS);
            f32x16 acc[2][3];
            gemm_mainloop_w3(xb + (size_t)row0 * D, D, WIN + (size_t)col0 * D, D, D, lds, acc);
            const int grp = 2 * ct + wn;
#pragma unroll
            for (int mt = 0; mt < 2; ++mt) {
                float ss[16], rs[16];
#pragma unroll
                for (int r = 0; r < 16; ++r) { ss[r] = 0.f; rs[r] = ep[wm * 64 + mt * 32 + crow(r, hi)]; }
#pragma unroll
                for (int nt = 0; nt < 3; ++nt) {
                    const int col = col0 + wn * 96 + nt * 32 + fm;
                    const bool cnt = (grp < 6) || (nt < 2);
#pragma unroll
                    for (int r = 0; r < 16; ++r) {
                        const float v = acc[mt][nt][r] * rs[r];
                        zb[(size_t)(row0 + wm * 64 + mt * 32 + crow(r, hi)) * ZW + col] = f2bf(v);
                        if (cnt) ss[r] += v * v;
                    }
                }
                if (grp < 7) {
                    const float tot = rowsum32(ss, lane);
                    float* pp = st + ((size_t)(grp < 4 ? ST_QA : ST_KVA) * T + row0 + wm * 64 + mt * 32 + crow((lane >> 1) & 15, hi)) * 16 + (grp < 4 ? grp : grp - 4);
                    if ((lane & 1) == 0) *pp = tot;
                }
            }
            __syncthreads();
        }
        xcd_barrier(xbar);

        if (STOP == 1) { dump_bf(zb, ZW); return; }
        if (PHASES & 4) for (int t = vb; t < 1024; t += G) {
            const int tid = opq(threadIdx.x), lane = tid & 63, wave = __builtin_amdgcn_readfirstlane(tid >> 6), wm = wave >> 1, wn = wave & 1, fm = lane & 31, hi = lane >> 5; (void)lane;
            if (t < 512) {
                const int panel = t >> 2, ct = t & 3, row0 = panel * 128, col0 = ct * 192;
                if (tid < 128) ep[tid] = rsqrtf(sum_slots(st + ((size_t)ST_QA * T + row0 + tid) * 16, 4) * (1.0f / 384.0f) + EPS);
                f32x16 acc[2][3];
                gemm_mainloop_w3(zb + (size_t)row0 * ZW, ZW, WQB + (size_t)col0 * 384, 384, 384, lds, acc);
                const int h = 2 * ct + wn;
#pragma unroll
                for (int mt = 0; mt < 2; ++mt) {
                    float rs[16];
#pragma unroll
                    for (int r = 0; r < 16; ++r) rs[r] = ep[wm * 64 + mt * 32 + crow(r, hi)] * QSCALE;
#pragma unroll
                    for (int nt = 0; nt < 3; ++nt) {
#pragma unroll
                        for (int r = 0; r < 16; ++r) {
                            const int row = row0 + wm * 64 + mt * 32 + crow(r, hi);
                            const int b = row >> 12, s = row & 4095;
                            float v = acc[mt][nt][r] * rs[r];
                            if (nt == 2) {
                                const float pr = __shfl_xor(v, 16);
                                const float c = cosT[s * 16 + (fm & 15)], sn = sinT[s * 16 + (fm & 15)];
                                v = (fm < 16) ? (v * c - pr * sn) : (v * c + pr * sn);
                            }
                            Qb[((size_t)(b * NH + h) * S + s) * 96 + nt * 32 + fm] = f2bf(v);
                        }
                    }
                }
            } else {
                const int t2 = t - 512;
                const int panel = t2 >> 2, ct = t2 & 3, row0 = panel * 128, col0 = ct * 256;
                if (tid < 128) ep[tid] = rsqrtf(sum_slots(st + ((size_t)ST_KVA * T + row0 + tid) * 16, 3) * (1.0f / 256.0f) + EPS);
                f32x16 acc[2][4];
                gemm_mainloop_w(zb + (size_t)row0 * ZW + 384, ZW, WKVB + (size_t)col0 * 256, 256, 256, lds, acc);
                const int h = 2 * ct + wn;
#pragma unroll
                for (int mt = 0; mt < 2; ++mt) {
                    float rs[16];
#pragma unroll
                    for (int r = 0; r < 16; ++r) rs[r] = ep[wm * 64 + mt * 32 + crow(r, hi)];
                    const int rbase = row0 + wm * 64 + mt * 32;
                    const int b = rbase >> 12;
#pragma unroll
                    for (int nt = 0; nt < 4; ++nt) {
                        if (nt < 2) {
                            const int d = nt * 32 + fm;
#pragma unroll
                            for (int r = 0; r < 16; ++r) {
                                const int s = (rbase + crow(r, hi)) & 4095;
                                Kb[((size_t)(b * NH + h) * S + s) * 96 + d] = f2bf(acc[mt][nt][r] * rs[r]);
                            }
                        } else {
                            const int d = (nt - 2) * 32 + fm;
#pragma unroll
                            for (int g = 0; g < 4; ++g) {
                                const int s = (rbase + 8 * g + 4 * hi) & 4095;
                                const u32x2 w = (u32x2){pk2(acc[mt][nt][4 * g] * rs[4 * g], acc[mt][nt][4 * g + 1] * rs[4 * g + 1]),
                                                         pk2(acc[mt][nt][4 * g + 2] * rs[4 * g + 2], acc[mt][nt][4 * g + 3] * rs[4 * g + 3])};
                                *(u32x2*)(Vt + ((size_t)(b * NH + h) * 64 + d) * S + s) = w;
                            }
                        }
                    }
                }
            }
            __syncthreads();
        }
        if (PHASES & 8) {
            const float* wc = P.in[8] + (size_t)l * 3 * 512;
            for (int row = vb * 4 + wave; row < T; row += G * 4) {
                const int tid = opq(threadIdx.x), lane = tid & 63, wave_ = 0, wm = 0, wn = 0, fm = lane & 31, hi = lane >> 5; (void)wm; (void)wn; (void)fm; (void)hi; (void)wave_; (void)lane;
                const int s = row & 4095, b = row >> 12;
                const bf16_t* zr = zb + (size_t)row * ZW;
                const int c0 = 8 * lane;
                const u32x4 gbv = *(const u32x4*)(zr + 672 + c0);
                const u32x4 gc1 = *(const u32x4*)(zr + 1184 + c0), ci1 = *(const u32x4*)(zr + 1696 + c0);
                u32x4 gc0 = (u32x4){0, 0, 0, 0}, ci0 = gc0, gc2 = gc0, ci2 = gc0;
                if (s > 0) { gc0 = *(const u32x4*)(zr - ZW + 1184 + c0); ci0 = *(const u32x4*)(zr - ZW + 1696 + c0); }
                if (s < S - 1) { gc2 = *(const u32x4*)(zr + ZW + 1184 + c0); ci2 = *(const u32x4*)(zr + ZW + 1696 + c0); }
                const f32x4 w0a = *(const f32x4*)(wc + c0), w0b = *(const f32x4*)(wc + c0 + 4);
                const f32x4 w1a = *(const f32x4*)(wc + 512 + c0), w1b = *(const f32x4*)(wc + 512 + c0 + 4);
                const f32x4 w2a = *(const f32x4*)(wc + 1024 + c0), w2b = *(const f32x4*)(wc + 1024 + c0 + 4);
                float cv[8]; float ss = 0.f;
#pragma unroll
                for (int i = 0; i < 4; ++i) {
                    const unsigned a0 = gc0[i], a1 = gc1[i], a2 = gc2[i], d0 = ci0[i], d1 = ci1[i], d2 = ci2[i], gw = gbv[i];
                    const float wlo0 = (i < 2) ? w0a[2 * i] : w0b[2 * i - 4], whi0 = (i < 2) ? w0a[2 * i + 1] : w0b[2 * i - 3];
                    const float wlo1 = (i < 2) ? w1a[2 * i] : w1b[2 * i - 4], whi1 = (i < 2) ? w1a[2 * i + 1] : w1b[2 * i - 3];
                    const float wlo2 = (i < 2) ? w2a[2 * i] : w2b[2 * i - 4], whi2 = (i < 2) ? w2a[2 * i + 1] : w2b[2 * i - 3];
                    const float lo = bflo(gw) * (wlo0 * bflo(a0) * bflo(d0) + wlo1 * bflo(a1) * bflo(d1) + wlo2 * bflo(a2) * bflo(d2));
                    const float hv = bfhi(gw) * (whi0 * bfhi(a0) * bfhi(d0) + whi1 * bfhi(a1) * bfhi(d1) + whi2 * bfhi(a2) * bfhi(d2));
                    cv[2 * i] = lo; cv[2 * i + 1] = hv; ss += lo * lo + hv * hv;
                }
                ss += __shfl_xor(ss, 1); ss += __shfl_xor(ss, 2); ss += __shfl_xor(ss, 4);
                const float rn = rsqrtf(ss * (1.0f / 64.0f) + EPS);
                *(u32x4*)(mix + (size_t)row * D + 512 + c0) = (u32x4){pk2(cv[0] * rn, cv[1] * rn), pk2(cv[2] * rn, cv[3] * rn), pk2(cv[4] * rn, cv[5] * rn), pk2(cv[6] * rn, cv[7] * rn)};
                if (lane < 16) {
                    const float a = bf2f(zr[640 + lane]), bb = bf2f(zr[656 + lane]);
                    const float c = cosT[s * 16 + lane], sn = sinT[s * 16 + lane];
                    const bf16_t o1 = f2bf(a * c - bb * sn), o2 = f2bf(bb * c + a * sn);
#pragma unroll
                    for (int h = 0; h < NH; ++h) {
                        bf16_t* kp = Kb + ((size_t)(b * NH + h) * S + s) * 96;
                        kp[64 + lane] = o1; kp[80 + lane] = o2;
                    }
                }
            }
        }
        xcd_barrier(xbar);

        if (STOP == 2) { dump_bf(Qb, 768); return; }
        if (STOP == 12) { dump_bf(Kb, 768); return; }
        if (STOP == 22) { dump_bf(Vt, 512); return; }
        if (STOP == 32) { dump_bf(mix, 1024); return; }
        if (PHASES & 16) for (int rep = 0; rep < REPA; ++rep) for (int it = vb; it < 32 * 16; it += G) {
            const int tid = opq(threadIdx.x), lane = tid & 63, wave = __builtin_amdgcn_readfirstlane(tid >> 6), fm = lane & 31, hi = lane >> 5;
            const int bh = it >> 4, qb = it & 15, b = bh >> 3, h = bh & 7;
            const bf16_t* Qp = Qb + ((size_t)bh * S + qb * 256 + wave * 64 + fm) * 96 + hi * 8;
            const bf16_t* Kp = Kb + (size_t)bh * S * 96;
            const bf16_t* Vp = Vt + (size_t)bh * 64 * S;
            bf16x8 qf[2][6];
#pragma unroll
            for (int u = 0; u < 2; ++u)
#pragma unroll
                for (int d0 = 0; d0 < 6; ++d0) qf[u][d0] = *(const bf16x8*)(Qp + (size_t)u * 32 * 96 + d0 * 16);
            f32x16 o[2][2];
#pragma unroll
            for (int u = 0; u < 2; ++u)
#pragma unroll
                for (int r = 0; r < 16; ++r) { o[u][0][r] = 0.f; o[u][1][r] = 0.f; }
            float mhat[2] = {0.f, 0.f}, lrun[2] = {0.f, 0.f};
            u32x4 kr[3], vr[2];
            const int pim = (fm & ~12) | ((fm & 4) << 1) | ((fm & 8) >> 1);
            const int koff = pim * KROW + hi * 16, voff = fm * VROW + hi * 16;
            auto loadkv = [&](int kv0) __attribute__((always_inline)) {
#pragma unroll
                for (int i = 0; i < 3; ++i) kr[i] = *(const u32x4*)(Kp + (size_t)kv0 * 96 + (tid + 256 * i) * 8);
#pragma unroll
                for (int i = 0; i < 2; ++i) { const int c = tid + 256 * i; vr[i] = *(const u32x4*)(Vp + (size_t)(c >> 3) * S + kv0 + (c & 7) * 8); }
            };
            auto storekv = [&](int buf) __attribute__((always_inline)) {
                unsigned char* kb = lds + buf * (KT_BYTES + VT_BYTES);
                unsigned char* vbp = kb + KT_BYTES;
#pragma unroll
                for (int i = 0; i < 3; ++i) { const int c = tid + 256 * i; *(u32x4*)(kb + (c / 12) * KROW + (c % 12) * 16) = kr[i]; }
#pragma unroll
                for (int i = 0; i < 2; ++i) { const int c = tid + 256 * i; *(u32x4*)(vbp + (c >> 3) * VROW + (c & 7) * 16) = vr[i]; }
            };
            loadkv(0); storekv(0); __syncthreads();
            for (int kt = 0; kt < 64; ++kt) {
                if (kt + 1 < 64) loadkv((kt + 1) * 64);
                __builtin_amdgcn_sched_barrier(0);
                const unsigned char* kb = lds + (kt & 1) * (KT_BYTES + VT_BYTES);
                const unsigned char* vbp = kb + KT_BYTES;
                f32x16 p[2][2];
#pragma unroll
                for (int d0 = 0; d0 < 6; ++d0) {
                    const bf16x8 k0 = *(const bf16x8*)(kb + koff + d0 * 32), k1 = *(const bf16x8*)(kb + koff + 32 * KROW + d0 * 32);
#pragma unroll
                    for (int u = 0; u < 2; ++u) {
                        if (d0 == 0) {
                            p[u][0] = __builtin_amdgcn_mfma_f32_32x32x16_bf16(k0, qf[u][0], (f32x16){0.f,0.f,0.f,0.f,0.f,0.f,0.f,0.f,0.f,0.f,0.f,0.f,0.f,0.f,0.f,0.f}, 0, 0, 0);
                            p[u][1] = __builtin_amdgcn_mfma_f32_32x32x16_bf16(k1, qf[u][0], (f32x16){0.f,0.f,0.f,0.f,0.f,0.f,0.f,0.f,0.f,0.f,0.f,0.f,0.f,0.f,0.f,0.f}, 0, 0, 0);
                        } else {
                            p[u][0] = __builtin_amdgcn_mfma_f32_32x32x16_bf16(k0, qf[u][d0], p[u][0], 0, 0, 0);
                            p[u][1] = __builtin_amdgcn_mfma_f32_32x32x16_bf16(k1, qf[u][d0], p[u][1], 0, 0, 0);
                        }
                    }
                }
#pragma unroll
                for (int u = 0; u < 2; ++u) {
                    float mx = p[u][0][0];
#pragma unroll
                    for (int r = 0; r < 16; ++r) mx = fmaxf(fmaxf(mx, p[u][0][r]), p[u][1][r]);
                    mx = fmaxf(mx, __shfl_xor(mx, 32));
                    if (kt == 0 || __any(mx - mhat[u] > 8.0f)) {
                        const float nm = (kt == 0) ? mx : fmaxf(mx, mhat[u]);
                        const float f = (kt == 0) ? 1.0f : __builtin_amdgcn_exp2f(mhat[u] - nm);
                        mhat[u] = nm; lrun[u] *= f;
#pragma unroll
                        for (int r = 0; r < 16; ++r) { o[u][0][r] *= f; o[u][1][r] *= f; }
                    }
                }
                auto soft = [&](int u, bf16x8 (&pfu)[4]) __attribute__((always_inline)) {
                    const float mh = mhat[u];
#pragma unroll
                    for (int r = 0; r < 16; ++r) { p[u][0][r] = __builtin_amdgcn_exp2f(p[u][0][r] - mh); p[u][1][r] = __builtin_amdgcn_exp2f(p[u][1][r] - mh); }
                    {
                        const f32x16 t = p[u][0] + p[u][1];
                        float rsum = ((t[0] + t[1]) + (t[2] + t[3])) + ((t[4] + t[5]) + (t[6] + t[7]));
                        rsum += ((t[8] + t[9]) + (t[10] + t[11])) + ((t[12] + t[13]) + (t[14] + t[15]));
                        lrun[u] += rsum;
                    }
#pragma unroll
                    for (int c = 0; c < 4; ++c) {
                        const int mt = c >> 1, r0 = (c & 1) * 8;
                        const u32x4 w = (u32x4){pk2(p[u][mt][r0], p[u][mt][r0 + 1]), pk2(p[u][mt][r0 + 2], p[u][mt][r0 + 3]), pk2(p[u][mt][r0 + 4], p[u][mt][r0 + 5]), pk2(p[u][mt][r0 + 6], p[u][mt][r0 + 7])};
                        pfu[c] = __builtin_bit_cast(bf16x8, w);
                    }
                };
                auto pvm = [&](int u, const bf16x8 (&pfu)[4]) __attribute__((always_inline)) {
#pragma unroll
                    for (int c = 0; c < 4; ++c) {
                        const bf16x8 v0 = *(const bf16x8*)(vbp + voff + c * 32), v1 = *(const bf16x8*)(vbp + voff + 32 * VROW + c * 32);
                        o[u][0] = __builtin_amdgcn_mfma_f32_32x32x16_bf16(v0, pfu[c], o[u][0], 0, 0, 0);
                        o[u][1] = __builtin_amdgcn_mfma_f32_32x32x16_bf16(v1, pfu[c], o[u][1], 0, 0, 0);
                    }
                };
                bf16x8 pfa[4], pfb[4];
                soft(0, pfa);
                pvm(0, pfa);
                soft(1, pfb);
#pragma unroll
                for (int i = 0; i < 8; ++i) { __builtin_amdgcn_sched_group_barrier(0x008, 1, 0); __builtin_amdgcn_sched_group_barrier(0x002, 10, 0); }
                pvm(1, pfb);
                if (kt + 1 < 64) storekv((kt + 1) & 1);
                __syncthreads();
            }
#pragma unroll
            for (int u = 0; u < 2; ++u) {
                const float ltot = lrun[u] + __shfl_xor(lrun[u], 32);
                const float inv = 1.0f / ltot;
                float ss = 0.f;
#pragma unroll
                for (int r = 0; r < 16; ++r) { o[u][0][r] *= inv; o[u][1][r] *= inv; ss += o[u][0][r] * o[u][0][r] + o[u][1][r] * o[u][1][r]; }
                ss += __shfl_xor(ss, 32);
                const float rn = rsqrtf(ss * (1.0f / 64.0f) + EPS);
                bf16_t* mp = mix + (size_t)(b * S + qb * 256 + wave * 64 + u * 32 + fm) * D + h * 64 + 4 * hi;
#pragma unroll
                for (int d0 = 0; d0 < 2; ++d0)
#pragma unroll
                    for (int g = 0; g < 4; ++g)
                        *(u32x2*)(mp + d0 * 32 + 8 * g) = (u32x2){pk2(o[u][d0][4 * g] * rn, o[u][d0][4 * g + 1] * rn), pk2(o[u][d0][4 * g + 2] * rn, o[u][d0][4 * g + 3] * rn)};
            }
        }
        xcd_barrier(xbar);

        if (STOP == 3) { dump_bf(mix, 1024); return; }
        if (PHASES & 32) for (int t = vb; t < 128 * 4; t += G) {
            const int panel = t >> 2, ct = t & 3, row0 = panel * 128, col0 = ct * 256;
            f32x16 acc[2][4];
            gemm_mainloop_w(mix + (size_t)row0 * D, D, WOUT + (size_t)col0 * D, D, D, lds, acc);
            exch_epilogue_w(acc, row0, col0, gran + (size_t)0 * T * 16, (unsigned)(l * 4 + 1), P.in[12] + l * D, xout, xb, st + (size_t)ST_X1 * T * 16, ep);
            __syncthreads();
        }
        xcd_barrier(xbar);

        if (STOP == 4) { return; }
        if (PHASES & 64) for (int t = vb; t < 2048 + 1024; t += G) {
            const int tid = opq(threadIdx.x), lane = tid & 63, wave = __builtin_amdgcn_readfirstlane(tid >> 6), wm = wave >> 1, wn = wave & 1, fm = lane & 31, hi = lane >> 5; (void)lane;
            if (t < 2048) {
                int panel = t >> 4, ct = t & 15;
                if (G == 512) { const int M = (t >> 9) * 8 + (vb >> 6), q = vb & 63; panel = (M >> 1) * 8 + (q >> 3); ct = (M & 1) * 8 + (q & 7); }
                const int row0 = panel * 128, col0 = ct * 256;
                if (tid < 128) ep[tid] = rsqrtf(sum_slots(st + ((size_t)ST_X1 * T + row0 + tid) * 16, 8) * (1.0f / 1024.0f) + EPS);
                f32x16 acc[2][4];
                gemm_mainloop_w(xb + (size_t)row0 * D, D, WUP + (size_t)col0 * D, D, D, lds, acc);
#pragma unroll
                for (int mt = 0; mt < 2; ++mt) {
                    float rs[16];
#pragma unroll
                    for (int r = 0; r < 16; ++r) rs[r] = ep[wm * 64 + mt * 32 + crow(r, hi)];
#pragma unroll
                    for (int nt = 0; nt < 4; ++nt) {
                        const int col = col0 + wn * 128 + nt * 32 + fm;
#pragma unroll
                        for (int r = 0; r < 16; ++r) {
                            const float v = fmaxf(acc[mt][nt][r] * rs[r], 0.f);
                            ub[(size_t)(row0 + wm * 64 + mt * 32 + crow(r, hi)) * FF + col] = f2bf(v * v);
                        }
                    }
                }
            } else {
                const int t2 = t - 2048;
                const int panel = t2 >> 3, ct = t2 & 7, row0 = panel * 128, col0 = ct * 128;
                f32x16 acc[2][2];
                gemm_mainloop<true>(P.in[1] + ((size_t)l * T + row0) * 256, 256, WP + (size_t)col0 * 256, 256, 256, lds, acc);
#pragma unroll
                for (int mt = 0; mt < 2; ++mt)
#pragma unroll
                    for (int nt = 0; nt < 2; ++nt) {
                        const int col = col0 + wn * 64 + nt * 32 + fm;
#pragma unroll
                        for (int r = 0; r < 16; ++r) ebuf[(size_t)(row0 + wm * 64 + mt * 32 + crow(r, hi)) * D + col] = f2bf(acc[mt][nt][r]);
                    }
            }
            __syncthreads();
        }
        xcd_barrier(xbar);

        if (STOP == 5) { dump_bf(ub, 4096); return; }
        if (STOP == 15) { dump_bf(ebuf, 1024); return; }
        if (PHASES & 128) for (int t = vb; t < 128 * 4; t += G) {
            const int panel = t >> 2, ct = t & 3, row0 = panel * 128, col0 = ct * 256;
            f32x16 acc[2][4];
            gemm_mainloop_w(ub + (size_t)row0 * FF, FF, WDOWN + (size_t)col0 * FF, FF, FF, lds, acc);
            exch_epilogue_w(acc, row0, col0, gran + (size_t)1 * T * 16, (unsigned)(l * 4 + 2), P.in[16] + l * D, xout, xb, st + (size_t)ST_X2 * T * 16, ep);
            __syncthreads();
        }
        xcd_barrier(xbar);

        if (STOP == 6) { return; }
        if (PHASES & 256) for (int t = vb; t < 128 * 8; t += G) {
            const int tid = opq(threadIdx.x), lane = tid & 63, wave = __builtin_amdgcn_readfirstlane(tid >> 6), wm = wave >> 1, wn = wave & 1, fm = lane & 31, hi = lane >> 5; (void)wm; (void)wn; (void)fm; (void)hi; (void)wave; (void)lane;
            const int panel = t >> 3, ct = t & 7, row0 = panel * 128, col0 = ct * 128;
            if (tid < 128) ep[tid] = rsqrtf(sum_slots(st + ((size_t)ST_X2 * T + row0 + tid) * 16, 8) * (1.0f / 1024.0f) + EPS);
            f32x16 acc[2][2];
            gemm_mainloop<false>(xb + (size_t)row0 * D, D, WG + (size_t)col0 * D, D, D, lds, acc);
#pragma unroll
            for (int mt = 0; mt < 2; ++mt) {
                float rs[16];
#pragma unroll
                for (int r = 0; r < 16; ++r) rs[r] = ep[wm * 64 + mt * 32 + crow(r, hi)];
#pragma unroll
                for (int nt = 0; nt < 2; ++nt) {
                    const int col = col0 + wn * 64 + nt * 32 + fm;
#pragma unroll
                    for (int r = 0; r < 16; ++r) {
                        const float gte = 1.0f / (1.0f + __expf(-acc[mt][nt][r] * rs[r]));
                        acc[mt][nt][r] = gte * bf2f(ebuf[(size_t)(row0 + wm * 64 + mt * 32 + crow(r, hi)) * D + col]);
                    }
                }
            }
            exch_epilogue(acc, row0, col0, gran + (size_t)2 * T * 16, (unsigned)(l * 4 + 3), P.in[20] + l * D, (l == NL - 1) ? xout : nullptr, xb, st + (size_t)ST_X0 * T * 16, ep);
            __syncthreads();
        }
        if (STOP == 7) return;
        if (l + 1 < NL) xcd_barrier(xbar);
    }
}

extern "C" void kernel_launch(void* const* d_in, const int* in_sizes, int n_in, void* d_out, int out_size, void* d_ws, size_t ws_size, hipStream_t stream) {
    static int grid = 0;
    if (grid == 0) {
        if (n_in != 21 || out_size != T * D || ws_size < WS_END) { fprintf(stderr, "kernel_launch: unexpected problem (n_in %d out %d ws %zu)\n", n_in, out_size, ws_size); grid = -1; return; }
        int dev = 0, cus = 0, per_cu = 0;
        hipGetDevice(&dev);
        hipDeviceGetAttribute(&cus, hipDeviceAttributeMultiprocessorCount, dev);
        if (hipFuncSetAttribute((const void*)mega, hipFuncAttributeMaxDynamicSharedMemorySize, LDS_BYTES) != hipSuccess) { fprintf(stderr, "hipFuncSetAttribute failed\n"); grid = -1; return; }
        if (hipOccupancyMaxActiveBlocksPerMultiprocessor(&per_cu, (const void*)mega, 256, LDS_BYTES) != hipSuccess || per_cu < 1) { fprintf(stderr, "occupancy query failed (%d)\n", per_cu); per_cu = 1; }
        if (per_cu > 2) per_cu = 2;
        grid = (cus * per_cu) & ~7;
        fprintf(stderr, "kernel_launch: cus %d per_cu %d grid %d\n", cus, per_cu, grid);
    }
    if (grid < 0) return;
    if (hipMemsetAsync((char*)d_ws + WS_CNT + 8192 * 4, 0, XCD_BAR_WORDS * 4, stream) != hipSuccess) { fprintf(stderr, "kernel_launch: memset of the barrier words failed\n"); return; }
    Params p{};
    for (int i = 0; i < 21; ++i) p.in[i] = (const float*)d_in[i];
    p.out = (float*)d_out; p.ws = (unsigned char*)d_ws;
    void* args[] = {&p};
    hipError_t e = hipLaunchCooperativeKernel((const void*)mega, dim3(grid), dim3(256), args, LDS_BYTES, stream);
    if (e != hipSuccess) fprintf(stderr, "cooperative launch failed: %s (grid %d)\n", hipGetErrorString(e), grid);
}
```

```cpp
#include <hip/hip_runtime.h>
#include <hip/hip_cooperative_groups.h>
#include <cstdio>
#include <cstdint>
namespace cg = cooperative_groups;

typedef unsigned short bf16_t;
typedef short bf16x8 __attribute__((ext_vector_type(8)));
typedef float f32x16 __attribute__((ext_vector_type(16)));
typedef float f32x4 __attribute__((ext_vector_type(4)));
typedef unsigned u32x4 __attribute__((ext_vector_type(4)));
typedef unsigned u32x2 __attribute__((ext_vector_type(2)));

constexpr int T = 16384, S = 4096, D = 1024, NL = 4, NH = 8, ZW = 2304, FF = 4096;
constexpr float EPS = 1e-6f;
constexpr float QSCALE = 0.10206207261596575f * 1.4426950408889634f;

constexpr size_t MiB = (size_t)1 << 20;
constexpr size_t WS_STAT = 0;
constexpr size_t WS_CNT = 8 * MiB;
constexpr size_t WS_ROPE = 9 * MiB;
constexpr size_t WS_W = 10 * MiB;
constexpr size_t WL_BYTES = 27328512;
constexpr size_t OW_IN = 0, OW_QB = 4718592, OW_KVB = 5308416, OW_OUT = 5832704, OW_UP = 7929856, OW_DOWN = 16318464, OW_G = 24707072, OW_P = 26804224;
constexpr size_t WS_XB = 115 * MiB;
constexpr size_t WS_MIX = 147 * MiB;
constexpr size_t WS_Z = 179 * MiB;
constexpr size_t WS_Q = 251 * MiB;
constexpr size_t WS_K = 275 * MiB;
constexpr size_t WS_VT = 299 * MiB;
constexpr size_t WS_U = 179 * MiB;
constexpr size_t WS_GRAN = 315 * MiB;
constexpr size_t WS_END = 321 * MiB;

enum { ST_X0 = 0, ST_QA = 1, ST_KVA = 2, ST_Y1 = 3, ST_X1 = 4, ST_F = 5, ST_X2 = 6, ST_T = 7 };

constexpr int LROW = 144;
constexpr int TILE_BYTES = 128 * LROW;
constexpr int EP_OFF = 4 * TILE_BYTES;
constexpr int XB_OFF = EP_OFF + 1024;
constexpr int LDS_BYTES = XB_OFF + 64;
constexpr int KROW = 208, VROW = 144;
constexpr int KT_BYTES = 64 * KROW, VT_BYTES = 64 * VROW;

#ifndef PHASES
#define PHASES 511
#endif
#ifndef REPG
#define REPG 1
#endif
#ifndef REPA
#define REPA 1
#endif
#ifndef REPP
#define REPP 1
#endif
#ifndef STOP
#define STOP 0
#endif
struct Params { const float* in[21]; float* out; unsigned char* ws; };

typedef float f32x2_t __attribute__((ext_vector_type(2)));
typedef __bf16 bf16x2_t __attribute__((ext_vector_type(2)));
__device__ __forceinline__ unsigned pk2(float lo, float hi) { const f32x2_t v = {lo, hi}; const bf16x2_t b = __builtin_convertvector(v, bf16x2_t); return __builtin_bit_cast(unsigned, b); }
__device__ __forceinline__ bf16_t f2bf(float f) { return (bf16_t)(pk2(f, 0.f) & 0xffffu); }
__device__ __forceinline__ float bf2f(bf16_t b) { return __uint_as_float(((unsigned)b) << 16); }
__device__ __forceinline__ float bflo(unsigned w) { return __uint_as_float(w << 16); }
__device__ __forceinline__ float bfhi(unsigned w) { return __uint_as_float(w & 0xffff0000u); }
__device__ __forceinline__ int opq(int v) { asm volatile("" : "+v"(v)); return v; }
__device__ __forceinline__ int crow(int r, int hi) { return (r & 3) + 8 * (r >> 2) + 4 * hi; }
__device__ __forceinline__ int vblock() { const int G = gridDim.x, b = blockIdx.x; return (G % 8 == 0) ? (b % 8) * (G / 8) + b / 8 : b; }
__device__ __forceinline__ void st_wt(float* p, float v) { __hip_atomic_store(p, v, __ATOMIC_RELAXED, __HIP_MEMORY_SCOPE_AGENT); }
__device__ __forceinline__ float atomic_ldf(const float* p) { return __hip_atomic_load(p, __ATOMIC_RELAXED, __HIP_MEMORY_SCOPE_AGENT); }
__device__ __forceinline__ float sum_slots(const float* p, int nslot) {
    const f32x4* q = (const f32x4*)p; float s = 0.f;
    for (int i = 0; i < (nslot >> 2); ++i) { const f32x4 a = q[i]; s += (a[0] + a[1]) + (a[2] + a[3]); }
    for (int i = nslot & ~3; i < nslot; ++i) s += p[i];
    return s;
}

__device__ __forceinline__ float rowsum32(const float (&s)[16], int lane) {
    const bool b4 = lane & 16, b3 = lane & 8, b2 = lane & 4, b1 = lane & 2;
    float a[8], b[4], c[2], d;
#pragma unroll
    for (int i = 0; i < 8; ++i) { const float keep = b4 ? s[8 + i] : s[i], send = b4 ? s[i] : s[8 + i]; a[i] = keep + __shfl_xor(send, 16); }
#pragma unroll
    for (int i = 0; i < 4; ++i) { const float keep = b3 ? a[4 + i] : a[i], send = b3 ? a[i] : a[4 + i]; b[i] = keep + __shfl_xor(send, 8); }
#pragma unroll
    for (int i = 0; i < 2; ++i) { const float keep = b2 ? b[2 + i] : b[i], send = b2 ? b[i] : b[2 + i]; c[i] = keep + __shfl_xor(send, 4); }
    { const float keep = b1 ? c[1] : c[0], send = b1 ? c[0] : c[1]; d = keep + __shfl_xor(send, 2); }
    d += __shfl_xor(d, 1);
    return d;
}

template <bool AF32>
__device__ __forceinline__ void gemm_mainloop(const void* __restrict__ Ap, int lda, const bf16_t* __restrict__ Bt, int ldb, int K,
                                              unsigned char* smem, f32x16 (&acc)[2][2]) {
    const int tid = opq(threadIdx.x), lane = tid & 63, wave = __builtin_amdgcn_readfirstlane(tid >> 6), wm = wave >> 1, wn = wave & 1, fm = lane & 31, hi = lane >> 5;
    const int srow = tid >> 3, skc = tid & 7;
    u32x4 ra0[4], rb0[4], ra1[4], rb1[4];
    u32x4 rx0[AF32 ? 4 : 1], rx1[AF32 ? 4 : 1];
#pragma unroll
    for (int i = 0; i < 2; ++i)
#pragma unroll
        for (int j = 0; j < 2; ++j)
#pragma unroll
            for (int r = 0; r < 16; ++r) acc[i][j][r] = 0.f;
    const int aoff = (wm * 64 + fm) * LROW + hi * 16, boff = (wn * 64 + fm) * LROW + hi * 16;
    const int soff = srow * LROW + skc * 16;
    const unsigned la = (unsigned)(srow * lda + skc * 8), lb = (unsigned)(srow * ldb + skc * 8);
    auto loadt = [&](int k0, u32x4 (&ra)[4], u32x4 (&rx)[AF32 ? 4 : 1], u32x4 (&rb)[4]) __attribute__((always_inline)) {
#pragma unroll
        for (int i = 0; i < 4; ++i) {
            if (AF32) {
                const float* ap = (const float*)Ap + (size_t)(32 * i) * lda + k0;
                ra[i] = *(const u32x4*)(ap + la); rx[i] = *(const u32x4*)(ap + la + 4);
            } else {
                const bf16_t* ap = (const bf16_t*)Ap + (size_t)(32 * i) * lda + k0;
                ra[i] = *(const u32x4*)(ap + la);
            }
            const bf16_t* bp = Bt + (size_t)(32 * i) * ldb + k0;
            rb[i] = *(const u32x4*)(bp + lb);
        }
    };
    auto storet = [&](int buf, const u32x4 (&ra)[4], const u32x4 (&rx)[AF32 ? 4 : 1], const u32x4 (&rb)[4]) __attribute__((always_inline)) {
        unsigned char* a = smem + buf * 2 * TILE_BYTES;
        unsigned char* b = a + TILE_BYTES;
#pragma unroll
        for (int i = 0; i < 4; ++i) {
            u32x4 av = ra[i];
            if (AF32) av = (u32x4){pk2(__uint_as_float(ra[i][0]), __uint_as_float(ra[i][1])), pk2(__uint_as_float(ra[i][2]), __uint_as_float(ra[i][3])),
                                   pk2(__uint_as_float(rx[i][0]), __uint_as_float(rx[i][1])), pk2(__uint_as_float(rx[i][2]), __uint_as_float(rx[i][3]))};
            *(u32x4*)(a + soff + i * 32 * LROW) = av; *(u32x4*)(b + soff + i * 32 * LROW) = rb[i];
        }
    };
    auto compute = [&](int buf) __attribute__((always_inline)) {
        const unsigned char* a = smem + buf * 2 * TILE_BYTES;
        const unsigned char* b = a + TILE_BYTES;
        __builtin_amdgcn_s_setprio(1);
#pragma unroll
        for (int kk = 0; kk < 4; ++kk) {
            const bf16x8 a0 = *(const bf16x8*)(a + aoff + kk * 32), a1 = *(const bf16x8*)(a + aoff + 32 * LROW + kk * 32);
            const bf16x8 b0 = *(const bf16x8*)(b + boff + kk * 32), b1 = *(const bf16x8*)(b + boff + 32 * LROW + kk * 32);
            acc[0][0] = __builtin_amdgcn_mfma_f32_32x32x16_bf16(a0, b0, acc[0][0], 0, 0, 0);
            acc[0][1] = __builtin_amdgcn_mfma_f32_32x32x16_bf16(a0, b1, acc[0][1], 0, 0, 0);
            acc[1][0] = __builtin_amdgcn_mfma_f32_32x32x16_bf16(a1, b0, acc[1][0], 0, 0, 0);
            acc[1][1] = __builtin_amdgcn_mfma_f32_32x32x16_bf16(a1, b1, acc[1][1], 0, 0, 0);
        }
        __builtin_amdgcn_s_setprio(0);
    };
    const int nk = K >> 6;
    for (int rep = 0; rep < REPG; ++rep) {
    if (rep) {
#pragma unroll
        for (int i = 0; i < 2; ++i)
#pragma unroll
            for (int j = 0; j < 2; ++j)
#pragma unroll
                for (int r = 0; r < 16; ++r) acc[i][j][r] = 0.f;
    }
    loadt(0, ra0, rx0, rb0);
    if (nk > 1) loadt(64, ra1, rx1, rb1);
    storet(0, ra0, rx0, rb0); __syncthreads();
    for (int kt = 0; kt < nk; kt += 2) {
        if (kt + 2 < nk) loadt((kt + 2) << 6, ra0, rx0, rb0);
        __builtin_amdgcn_sched_barrier(0);
        compute(0);
        if (kt + 1 < nk) storet(1, ra1, rx1, rb1);
        __syncthreads();
        if (kt + 1 < nk) {
            if (kt + 3 < nk) loadt((kt + 3) << 6, ra1, rx1, rb1);
            __builtin_amdgcn_sched_barrier(0);
            compute(1);
            if (kt + 2 < nk) storet(0, ra0, rx0, rb0);
            __syncthreads();
        }
    }
    }
}

constexpr int LROW2 = 80;
constexpr int A2_BYTES = 128 * LROW2, B2_BYTES = 256 * LROW2, STAGE2 = A2_BYTES + B2_BYTES;
__device__ __forceinline__ void gemm_mainloop_w(const bf16_t* __restrict__ Ap, int lda, const bf16_t* __restrict__ Bt, int ldb, int K,
                                                unsigned char* smem, f32x16 (&acc)[2][4]) {
    const int tid = opq(threadIdx.x), lane = tid & 63, wave = __builtin_amdgcn_readfirstlane(tid >> 6), wm = wave >> 1, wn = wave & 1, fm = lane & 31, hi = lane >> 5;
    const int srow = tid >> 2, skc = tid & 3;
    u32x4 ra0[2], rb0[4], ra1[2], rb1[4];
#pragma unroll
    for (int i = 0; i < 2; ++i)
#pragma unroll
        for (int j = 0; j < 4; ++j)
#pragma unroll
            for (int r = 0; r < 16; ++r) acc[i][j][r] = 0.f;
    const int aoff = (wm * 64 + fm) * LROW2 + hi * 16, boff = A2_BYTES + (wn * 128 + fm) * LROW2 + hi * 16;
    const int soff = srow * LROW2 + skc * 16;
    const unsigned la = (unsigned)(srow * lda + skc * 8), lb = (unsigned)(srow * ldb + skc * 8);
    auto loadt = [&](int k0, u32x4 (&ra)[2], u32x4 (&rb)[4]) __attribute__((always_inline)) {
#pragma unroll
        for (int i = 0; i < 2; ++i) { const bf16_t* ap = Ap + (size_t)(64 * i) * lda + k0; ra[i] = *(const u32x4*)(ap + la); }
#pragma unroll
        for (int i = 0; i < 4; ++i) { const bf16_t* bp = Bt + (size_t)(64 * i) * ldb + k0; rb[i] = *(const u32x4*)(bp + lb); }
    };
    auto storet = [&](int buf, const u32x4 (&ra)[2], const u32x4 (&rb)[4]) __attribute__((always_inline)) {
        unsigned char* a = smem + buf * STAGE2;
#pragma unroll
        for (int i = 0; i < 2; ++i) *(u32x4*)(a + soff + i * 64 * LROW2) = ra[i];
#pragma unroll
        for (int i = 0; i < 4; ++i) *(u32x4*)(a + A2_BYTES + soff + i * 64 * LROW2) = rb[i];
    };
    auto compute = [&](int buf) __attribute__((always_inline)) {
        const unsigned char* s = smem + buf * STAGE2;
        bf16x8 a[2][2], b[2][4];
#pragma unroll
        for (int kk = 0; kk < 2; ++kk) {
            a[kk][0] = *(const bf16x8*)(s + aoff + kk * 32); a[kk][1] = *(const bf16x8*)(s + aoff + 32 * LROW2 + kk * 32);
#pragma unroll
            for (int nt = 0; nt < 4; ++nt) b[kk][nt] = *(const bf16x8*)(s + boff + nt * 32 * LROW2 + kk * 32);
        }
        __builtin_amdgcn_sched_barrier(0);
        __builtin_amdgcn_s_setprio(1);
#pragma unroll
        for (int kk = 0; kk < 2; ++kk)
#pragma unroll
            for (int nt = 0; nt < 4; ++nt) {
                acc[0][nt] = __builtin_amdgcn_mfma_f32_32x32x16_bf16(a[kk][0], b[kk][nt], acc[0][nt], 0, 0, 0);
                acc[1][nt] = __builtin_amdgcn_mfma_f32_32x32x16_bf16(a[kk][1], b[kk][nt], acc[1][nt], 0, 0, 0);
            }
        __builtin_amdgcn_s_setprio(0);
    };
    const int nk = K >> 5;
    loadt(0, ra0, rb0);
    if (nk > 1) loadt(32, ra1, rb1);
    storet(0, ra0, rb0); __syncthreads();
    for (int kt = 0; kt < nk; kt += 2) {
        if (kt + 2 < nk) loadt((kt + 2) << 5, ra0, rb0);
        __builtin_amdgcn_sched_barrier(0);
        compute(0);
        if (kt + 1 < nk) storet(1, ra1, rb1);
        __syncthreads();
        if (kt + 1 < nk) {
            if (kt + 3 < nk) loadt((kt + 3) << 5, ra1, rb1);
            __builtin_amdgcn_sched_barrier(0);
            compute(1);
            if (kt + 2 < nk) storet(0, ra0, rb0);
            __syncthreads();
        }
    }
}

__device__ __forceinline__ void gemm_mainloop_w3(const bf16_t* __restrict__ Ap, int lda, const bf16_t* __restrict__ Bt, int ldb, int K,
                                                unsigned char* smem, f32x16 (&acc)[2][3]) {
    const int tid = opq(threadIdx.x), lane = tid & 63, wave = __builtin_amdgcn_readfirstlane(tid >> 6), wm = wave >> 1, wn = wave & 1, fm = lane & 31, hi = lane >> 5;
    const int srow = tid >> 2, skc = tid & 3;
    u32x4 ra0[2], rb0[3], ra1[2], rb1[3];
#pragma unroll
    for (int i = 0; i < 2; ++i)
#pragma unroll
        for (int j = 0; j < 3; ++j)
#pragma unroll
            for (int r = 0; r < 16; ++r) acc[i][j][r] = 0.f;
    const int aoff = (wm * 64 + fm) * LROW2 + hi * 16, boff = A2_BYTES + (wn * 96 + fm) * LROW2 + hi * 16;
    const int soff = srow * LROW2 + skc * 16;
    const unsigned la = (unsigned)(srow * lda + skc * 8), lb = (unsigned)(srow * ldb + skc * 8);
    auto loadt = [&](int k0, u32x4 (&ra)[2], u32x4 (&rb)[3]) __attribute__((always_inline)) {
#pragma unroll
        for (int i = 0; i < 2; ++i) { const bf16_t* ap = Ap + (size_t)(64 * i) * lda + k0; ra[i] = *(const u32x4*)(ap + la); }
#pragma unroll
        for (int i = 0; i < 3; ++i) { const bf16_t* bp = Bt + (size_t)(64 * i) * ldb + k0; rb[i] = *(const u32x4*)(bp + lb); }
    };
    auto storet = [&](int buf, const u32x4 (&ra)[2], const u32x4 (&rb)[3]) __attribute__((always_inline)) {
        unsigned char* a = smem + buf * STAGE2;
#pragma unroll
        for (int i = 0; i < 2; ++i) *(u32x4*)(a + soff + i * 64 * LROW2) = ra[i];
#pragma unroll
        for (int i = 0; i < 3; ++i) *(u32x4*)(a + A2_BYTES + soff + i * 64 * LROW2) = rb[i];
    };
    auto compute = [&](int buf) __attribute__((always_inline)) {
        const unsigned char* s = smem + buf * STAGE2;
        bf16x8 a[2][2], b[2][3];
#pragma unroll
        for (int kk = 0; kk < 2; ++kk) {
            a[kk][0] = *(const bf16x8*)(s + aoff + kk * 32); a[kk][1] = *(const bf16x8*)(s + aoff + 32 * LROW2 + kk * 32);
#pragma unroll
            for (int nt = 0; nt < 3; ++nt) b[kk][nt] = *(const bf16x8*)(s + boff + nt * 32 * LROW2 + kk * 32);
        }
        __builtin_amdgcn_sched_barrier(0);
        __builtin_amdgcn_s_setprio(1);
#pragma unroll
        for (int kk = 0; kk < 2; ++kk)
#pragma unroll
            for (int nt = 0; nt < 3; ++nt) {
                acc[0][nt] = __builtin_amdgcn_mfma_f32_32x32x16_bf16(a[kk][0], b[kk][nt], acc[0][nt], 0, 0, 0);
                acc[1][nt] = __builtin_amdgcn_mfma_f32_32x32x16_bf16(a[kk][1], b[kk][nt], acc[1][nt], 0, 0, 0);
            }
        __builtin_amdgcn_s_setprio(0);
    };
    const int nk = K >> 5;
    loadt(0, ra0, rb0);
    if (nk > 1) loadt(32, ra1, rb1);
    storet(0, ra0, rb0); __syncthreads();
    for (int kt = 0; kt < nk; kt += 2) {
        if (kt + 2 < nk) loadt((kt + 2) << 5, ra0, rb0);
        __builtin_amdgcn_sched_barrier(0);
        compute(0);
        if (kt + 1 < nk) storet(1, ra1, rb1);
        __syncthreads();
        if (kt + 1 < nk) {
            if (kt + 3 < nk) loadt((kt + 3) << 5, ra1, rb1);
            __builtin_amdgcn_sched_barrier(0);
            compute(1);
            if (kt + 2 < nk) storet(0, ra0, rb0);
            __syncthreads();
        }
    }
}

__device__ __forceinline__ void exch_epilogue(f32x16 (&v)[2][2], int row0, int col0, unsigned long long* gran, unsigned tag, const float* __restrict__ gain,
                                              float* xout, bf16_t* xb, float* part_next, float* ep) {
    const int tid = opq(threadIdx.x), lane = tid & 63, wave = __builtin_amdgcn_readfirstlane(tid >> 6), wm = wave >> 1, wn = wave & 1, fm = lane & 31, hi = lane >> 5;
    const int slot = (col0 >> 7) * 2 + wn;
    float xo[2][2][16];
#pragma unroll
    for (int mt = 0; mt < 2; ++mt)
#pragma unroll
        for (int nt = 0; nt < 2; ++nt) {
            const bf16_t* xp = xb + (size_t)(row0 + wm * 64 + mt * 32 + 4 * hi) * D + col0 + wn * 64 + nt * 32 + fm;
#pragma unroll
            for (int r = 0; r < 16; ++r) xo[mt][nt][r] = bf2f(xp[((r & 3) + 8 * (r >> 2)) * D]);
        }
#pragma unroll
    for (int mt = 0; mt < 2; ++mt) {
        float ss[16];
#pragma unroll
        for (int r = 0; r < 16; ++r) ss[r] = v[mt][0][r] * v[mt][0][r] + v[mt][1][r] * v[mt][1][r];
        const float tot = rowsum32(ss, lane);
        if ((lane & 1) == 0) __hip_atomic_store(gran + (size_t)(row0 + wm * 64 + mt * 32 + crow((lane >> 1) & 15, hi)) * 16 + slot, ((unsigned long long)tag << 32) | (unsigned long long)__float_as_uint(tot), __ATOMIC_RELAXED, __HIP_MEMORY_SCOPE_AGENT);
    }
    if (tid < 128) {
        const unsigned long long* g = gran + (size_t)(row0 + tid) * 16;
        float s;
        for (;;) {
            s = 0.f; bool ok = true;
#pragma unroll
            for (int i = 0; i < 16; ++i) { const unsigned long long x = __hip_atomic_load(g + i, __ATOMIC_RELAXED, __HIP_MEMORY_SCOPE_AGENT); ok &= ((unsigned)(x >> 32) == tag); s += __uint_as_float((unsigned)x); }
            if (ok) break;
            __builtin_amdgcn_s_sleep(1);
        }
        ep[128 + tid] = rsqrtf(s * (1.0f / 1024.0f) + EPS);
    }
    __syncthreads();
#pragma unroll
    for (int mt = 0; mt < 2; ++mt) {
        float ss[16], rs[16];
#pragma unroll
        for (int r = 0; r < 16; ++r) { ss[r] = 0.f; rs[r] = ep[128 + wm * 64 + mt * 32 + crow(r, hi)]; }
#pragma unroll
        for (int nt = 0; nt < 2; ++nt) {
            const int col = col0 + wn * 64 + nt * 32 + fm;
            const float g = gain[col];
            float* xp = xout + (size_t)(row0 + wm * 64 + mt * 32 + 4 * hi) * D + col;
            bf16_t* bp = xb + (size_t)(row0 + wm * 64 + mt * 32 + 4 * hi) * D + col;
#pragma unroll
            for (int g4 = 0; g4 < 4; ++g4) {
#pragma unroll
                for (int i = 0; i < 4; ++i) {
                    const int r = 4 * g4 + i, off = (8 * g4 + i) * D;
                    const float xf = xo[mt][nt][r] + v[mt][nt][r] * rs[r] * g;
                    const bf16_t xq = f2bf(xf);
                    const float xn = bf2f(xq);
                    bp[off] = xq; if (xout) xp[off] = xf; ss[r] += xn * xn;
                }
                asm volatile("" ::: "memory");
            }
        }
        const float tot = rowsum32(ss, lane);
        if ((lane & 1) == 0) part_next[(size_t)(row0 + wm * 64 + mt * 32 + crow((lane >> 1) & 15, hi)) * 16 + slot] = tot;
    }
}

__device__ __forceinline__ void exch_epilogue_w(f32x16 (&v)[2][4], int row0, int col0, unsigned long long* gran, unsigned tag, const float* __restrict__ gain,
                                                float* xout, bf16_t* xb, float* part_next, float* ep) {
    const int tid = opq(threadIdx.x), lane = tid & 63, wave = __builtin_amdgcn_readfirstlane(tid >> 6), wm = wave >> 1, wn = wave & 1, fm = lane & 31, hi = lane >> 5;
    const int slot = (col0 >> 8) * 2 + wn;
    float xs[2][16];
    auto ldx = [&](int u, float (&x)[16]) __attribute__((always_inline)) {
        const int lo = opq((4 * hi) * D + fm);
        const bf16_t* xp = xb + (size_t)(row0 + wm * 64 + (u >> 2) * 32) * D + col0 + wn * 128 + (u & 3) * 32 + lo;
#pragma unroll
        for (int r = 0; r < 16; ++r) x[r] = bf2f(xp[((r & 3) + 8 * (r >> 2)) * D]);
    };
    ldx(0, xs[0]);
#pragma unroll
    for (int mt = 0; mt < 2; ++mt) {
        float ss[16];
#pragma unroll
        for (int r = 0; r < 16; ++r) ss[r] = (v[mt][0][r] * v[mt][0][r] + v[mt][1][r] * v[mt][1][r]) + (v[mt][2][r] * v[mt][2][r] + v[mt][3][r] * v[mt][3][r]);
        const float tot = rowsum32(ss, lane);
        if ((lane & 1) == 0) __hip_atomic_store(gran + (size_t)(row0 + wm * 64 + mt * 32 + crow((lane >> 1) & 15, hi)) * 16 + slot, ((unsigned long long)tag << 32) | (unsigned long long)__float_as_uint(tot), __ATOMIC_RELAXED, __HIP_MEMORY_SCOPE_AGENT);
    }
    if (tid < 128) {
        const unsigned long long* g = gran + (size_t)(row0 + tid) * 16;
        float s;
        for (;;) {
            s = 0.f; bool ok = true;
#pragma unroll
            for (int i = 0; i < 8; ++i) { const unsigned long long x = __hip_atomic_load(g + i, __ATOMIC_RELAXED, __HIP_MEMORY_SCOPE_AGENT); ok &= ((unsigned)(x >> 32) == tag); s += __uint_as_float((unsigned)x); }
            if (ok) break;
            __builtin_amdgcn_s_sleep(1);
        }
        ep[128 + tid] = rsqrtf(s * (1.0f / 1024.0f) + EPS);
    }
    __syncthreads();
    float ss[16];
#pragma unroll
    for (int u = 0; u < 8; ++u) {
        const int mt = u >> 2, nt = u & 3;
        if (nt == 0) {
#pragma unroll
            for (int r = 0; r < 16; ++r) ss[r] = 0.f;
        }
        if (u + 1 < 8) ldx(u + 1, xs[(u + 1) & 1]);
        const int fmo = opq(fm), hio = opq(hi);
        const int col = col0 + wn * 128 + nt * 32 + fmo;
        const float g = gain[col];
        bf16_t* bp = xb + (size_t)(row0 + wm * 64 + mt * 32 + 4 * hio) * D + col;
#pragma unroll
        for (int g4 = 0; g4 < 4; ++g4) {
            const f32x4 rs4 = *(const f32x4*)(ep + 128 + wm * 64 + mt * 32 + 8 * g4 + 4 * hio);
#pragma unroll
            for (int i = 0; i < 4; ++i) {
                const int r = 4 * g4 + i, off = (8 * g4 + i) * D;
                const bf16_t xq = f2bf(xs[u & 1][r] + v[mt][nt][r] * rs4[i] * g);
                const float xn = bf2f(xq);
                bp[off] = xq; ss[r] += xn * xn;
            }
        }
        asm volatile("" ::: "memory");
        if (nt == 3) {
            const float tot = rowsum32(ss, lane);
            if ((lane & 1) == 0) part_next[(size_t)(row0 + wm * 64 + mt * 32 + crow((lane >> 1) & 15, hi)) * 16 + slot] = tot;
        }
    }
}

__device__ __forceinline__ void gbar(unsigned* ctr, unsigned& epoch, unsigned G) {
    asm volatile("s_waitcnt vmcnt(0)" ::: "memory");
    __syncthreads();
    epoch += 1u;
    if (threadIdx.x == 0) {
        __builtin_amdgcn_fence(__ATOMIC_RELEASE, "agent");
        asm volatile("s_waitcnt vmcnt(0)" ::: "memory");
        __hip_atomic_fetch_add(ctr, 1u, __ATOMIC_RELAXED, __HIP_MEMORY_SCOPE_AGENT);
        const unsigned target = epoch * G;
        while (__hip_atomic_load(ctr, __ATOMIC_RELAXED, __HIP_MEMORY_SCOPE_AGENT) < target) __builtin_amdgcn_s_sleep(1);
        __builtin_amdgcn_fence(__ATOMIC_ACQUIRE, "agent");
        asm volatile("s_waitcnt vmcnt(0)" ::: "memory");
    }
    __syncthreads();
}

#define LAS __attribute__((address_space(3)))
#define XB_TMO      128
#define XB_XCNT(j)  (256  + 64 * (j))
#define XB_XSUB(j)  (1280 + 64 * (j))
#define XB_XGEN(j)  (2304 + 64 * (j))
#define XB_TOP      3328
#define XB_TOPGEN   3392
#define XCD_BAR_WORDS 3456
#define XB_SPIN_CAP (1u << 22)
__device__ __forceinline__ unsigned xb_ld(unsigned* p)              { return __hip_atomic_load(p, __ATOMIC_RELAXED, __HIP_MEMORY_SCOPE_AGENT); }
__device__ __forceinline__ unsigned xb_add(unsigned* p, unsigned v) { return __hip_atomic_fetch_add(p, v, __ATOMIC_RELAXED, __HIP_MEMORY_SCOPE_AGENT); }
__device__ __forceinline__ unsigned xb_xcc_id() { return (unsigned)__builtin_amdgcn_s_getreg((3 << 11) | 20) & 0xFu; }
#define XB_SPIN(cond, bar) do { unsigned _sp = 0; while (cond) { __builtin_amdgcn_s_sleep(1); \
    if ((++_sp & 255u) == 0u) { if (xb_ld(&(bar)[XB_TMO])) break; if (_sp > XB_SPIN_CAP) { atomicAdd(&(bar)[XB_TMO], 1u); break; } } } } while (0)
struct XcdBarrier { unsigned* bar; unsigned x; volatile LAS unsigned* st; };
__device__ __forceinline__ XcdBarrier xcd_barrier_post(unsigned* bar, volatile LAS unsigned* st) {
    XcdBarrier b; b.bar = bar; b.x = xb_xcc_id(); b.st = st;
    if (threadIdx.x == 0) (void)xb_add(&bar[XB_XCNT(b.x)], 1u);
    return b;
}
__device__ __forceinline__ void xcd_barrier_complete(unsigned* bar, unsigned x, unsigned& nloc, unsigned& nx) {
    const unsigned G = gridDim.x * gridDim.y * gridDim.z;
    unsigned sum, cnt, mine, sp = 0u;
    for (;;) {
        sum = 0u; cnt = 0u; mine = 0u;
#pragma unroll
        for (unsigned j = 0; j < 16; ++j) { const unsigned c = xb_ld(&bar[XB_XCNT(j)]); sum += c; cnt += (c > 0u) ? 1u : 0u; mine = (j == x) ? c : mine; }
        if (sum == G) break;
        __builtin_amdgcn_s_sleep(1);
        if ((++sp & 255u) == 0u) { if (xb_ld(&bar[XB_TMO])) break; if (sp > XB_SPIN_CAP) { atomicAdd(&bar[XB_TMO], 1u); break; } }
    }
    nloc = mine > 0u ? mine : 1u; nx = cnt > 0u ? cnt : 1u;
}
__device__ __forceinline__ void xcd_barrier(const XcdBarrier& b) {
    asm volatile("s_waitcnt vmcnt(0)" ::: "memory");
    __syncthreads();
    if (threadIdx.x == 0) {
        unsigned* bar = b.bar;
        __builtin_amdgcn_s_waitcnt(0);
        unsigned nloc = b.st[0], nx = b.st[1];
        if (nloc == 0u) { xcd_barrier_complete(bar, b.x, nloc, nx); b.st[0] = nloc; b.st[1] = nx; }
        const unsigned old = xb_add(&bar[XB_XSUB(b.x)], 1u);
        const unsigned gen = old / nloc;
        if (old + 1u == (gen + 1u) * nloc) {
            __builtin_amdgcn_fence(__ATOMIC_RELEASE, "agent");
            asm volatile("s_waitcnt vmcnt(0)" ::: "memory");
            const unsigned og = xb_add(&bar[XB_TOP], 1u);
            const unsigned tg = og / nx;
            if (og + 1u == (tg + 1u) * nx) xb_add(&bar[XB_TOPGEN], 1u);
            else XB_SPIN(xb_ld(&bar[XB_TOPGEN]) == tg, bar);
            __builtin_amdgcn_fence(__ATOMIC_ACQUIRE, "agent");
            xb_add(&bar[XB_XGEN(b.x)], 1u);
            asm volatile("s_waitcnt vmcnt(0)" ::: "memory");
        } else {
            XB_SPIN(xb_ld(&bar[XB_XGEN(b.x)]) == gen, bar);
            __builtin_amdgcn_fence(__ATOMIC_ACQUIRE, "agent");
            asm volatile("s_waitcnt vmcnt(0)" ::: "memory");
        }
    }
    __syncthreads();
}

__global__ void __launch_bounds__(256, 2) mega(Params P) {
    extern __shared__ __attribute__((aligned(16))) unsigned char lds[];
    cg::grid_group grid = cg::this_grid();
    const int tid = threadIdx.x, lane = tid & 63, wave = __builtin_amdgcn_readfirstlane(tid >> 6), wm = wave >> 1, wn = wave & 1, fm = lane & 31, hi = lane >> 5;
    const int G = gridDim.x, vb = vblock();
    unsigned char* ws = P.ws;
    float* stat = (float*)(ws + WS_STAT);
    unsigned* cnts = (unsigned*)(ws + WS_CNT);
    float* cosT = (float*)(ws + WS_ROPE);
    float* sinT = cosT + S * 16;
    bf16_t* xb = (bf16_t*)(ws + WS_XB);
    bf16_t* mix = (bf16_t*)(ws + WS_MIX);
    bf16_t* ebuf = mix;
    bf16_t* zb = (bf16_t*)(ws + WS_Z);
    bf16_t* Qb = (bf16_t*)(ws + WS_Q);
    bf16_t* Kb = (bf16_t*)(ws + WS_K);
    bf16_t* Vt = (bf16_t*)(ws + WS_VT);
    bf16_t* ub = (bf16_t*)(ws + WS_U);
    float* xout = P.out;
    float* ep = (float*)(lds + EP_OFF);
    unsigned long long* gran = (unsigned long long*)(ws + WS_GRAN);
    unsigned* gctr = cnts + 4096;
    unsigned gepoch = 0u; (void)gepoch; (void)gctr;
    volatile LAS unsigned* xst = (volatile LAS unsigned*)((LAS unsigned char*)lds + XB_OFF);
    if (tid == 0) { xst[0] = 0u; xst[1] = 0u; }
    const XcdBarrier xbar = xcd_barrier_post(cnts + 8192, xst);

    auto dump_bf = [&](const bf16_t* buf, int pitch) {
        grid.sync();
        for (int i = vb * 256 + tid; i < T * D; i += G * 256) { const int row = i >> 10, col = i & 1023; xout[i] = bf2f(buf[(size_t)row * pitch + col]); }
    };
    if (PHASES & 1) for (int rep = 0; rep < REPP; ++rep) {
        float* tl = (float*)lds;
        for (int t = vb; t < NL * 3336; t += G) {
            const int l = t / 3336; int r = t % 3336;
            const float* src; const float* gA = nullptr; const float* gB = nullptr; int K, N, Np; size_t off;
            if (r < 576) { src = P.in[3] + (size_t)l * 1024 * 2208; gA = P.in[2] + l * 1024; gB = gA + 512; K = 1024; N = 2208; Np = 2304; off = OW_IN; }
            else if ((r -= 576) < 72) { src = P.in[5] + (size_t)l * 384 * 768; gA = P.in[4] + l * 384; gB = gA + 512; K = 384; N = 768; Np = 768; off = OW_QB; }
            else if ((r -= 72) < 64) { src = P.in[7] + (size_t)l * 256 * 1024; gA = P.in[6] + l * 256; gB = gA + 512; K = 256; N = 1024; Np = 1024; off = OW_KVB; }
            else if ((r -= 64) < 256) { src = P.in[11] + (size_t)l * 1024 * 1024; gA = P.in[9] + l * 512; gB = P.in[10] + l * 512; K = 1024; N = 1024; Np = 1024; off = OW_OUT; }
            else if ((r -= 256) < 1024) { src = P.in[14] + (size_t)l * 1024 * 4096; gA = P.in[13] + l * 1024; gB = gA + 512; K = 1024; N = 4096; Np = 4096; off = OW_UP; }
            else if ((r -= 1024) < 1024) { src = P.in[15] + (size_t)l * 4096 * 1024; K = 4096; N = 1024; Np = 1024; off = OW_DOWN; }
            else if ((r -= 1024) < 256) { src = P.in[18] + (size_t)l * 1024 * 1024; gA = P.in[17] + l * 1024; gB = gA + 512; K = 1024; N = 1024; Np = 1024; off = OW_G; }
            else { r -= 256; src = P.in[19] + (size_t)l * 256 * 1024; K = 256; N = 1024; Np = 1024; off = OW_P; }
            bf16_t* dst = (bf16_t*)(ws + WS_W + (size_t)l * WL_BYTES + off);
            const int nct = Np / 64, k0 = (r / nct) * 64, n0 = (r % nct) * 64;
#pragma unroll
            for (int j = 0; j < 4; ++j) {
                const int kr = (tid >> 4) + 16 * j, n4 = (tid & 15) * 4, k = k0 + kr;
                f32x4 v = (f32x4){0.f, 0.f, 0.f, 0.f};
                if (n0 + n4 < N) v = *(const f32x4*)(src + (size_t)k * N + n0 + n4);
                float g = 1.f;
                if (gA) g = (k < 512) ? gA[k] : gB[k - 512];
                tl[kr * 65 + n4 + 0] = v[0] * g; tl[kr * 65 + n4 + 1] = v[1] * g; tl[kr * 65 + n4 + 2] = v[2] * g; tl[kr * 65 + n4 + 3] = v[3] * g;
            }
            __syncthreads();
            {
                const int n = tid >> 2, kq = (tid & 3) * 16;
                unsigned w[8];
#pragma unroll
                for (int i = 0; i < 8; ++i) w[i] = pk2(tl[(kq + 2 * i) * 65 + n], tl[(kq + 2 * i + 1) * 65 + n]);
                bf16_t* dp = dst + (size_t)(n0 + n) * K + k0 + kq;
                *(u32x4*)dp = (u32x4){w[0], w[1], w[2], w[3]};
                *(u32x4*)(dp + 8) = (u32x4){w[4], w[5], w[6], w[7]};
            }
            __syncthreads();
        }
        const float* x = P.in[0];
        for (int row = vb * 4 + wave; row < T; row += G * 4) {
            float ss = 0.f;
#pragma unroll
            for (int j = 0; j < 4; ++j) {
                const size_t idx = (size_t)row * D + j * 256 + lane * 4;
                const f32x4 v = *(const f32x4*)(x + idx);
                *(u32x2*)(xb + idx) = (u32x2){pk2(v[0], v[1]), pk2(v[2], v[3])};
                ss += v[0] * v[0] + v[1] * v[1] + v[2] * v[2] + v[3] * v[3];
            }
            ss += __shfl_xor(ss, 32); ss += __shfl_xor(ss, 16); ss += __shfl_xor(ss, 8); ss += __shfl_xor(ss, 4); ss += __shfl_xor(ss, 2); ss += __shfl_xor(ss, 1);
            if (lane < 16) stat[((size_t)ST_X0 * T + row) * 16 + lane] = (lane == 0) ? ss : 0.f;
        }
        for (int idx = vb * 256 + tid; idx < NL * 3 * 128; idx += G * 256) cnts[idx] = 0u;
        if (blockIdx.x == 0 && tid == 0) *gctr = 0u;
        for (int idx = vb * 256 + tid; idx < 3 * T * 16 / 2; idx += G * 256) ((u32x4*)gran)[idx] = (u32x4){0u, 0u, 0u, 0u};
        for (int idx = vb * 256 + tid; idx < S * 16; idx += G * 256) {
            const int s = idx >> 4, j = idx & 15;
            const double base = sqrt(sqrt(sqrt(sqrt(10000.0))));
            double pw = 1.0;
            for (int q = 0; q < j; ++q) pw *= base;
            const float pwf = (float)pw;
            const float inv_freq = 1.0f / pwf;
            const float angf = (float)s * inv_freq;
            const double a = (double)angf;
            const double n = rint(a * 0.15915494309189535);
            const double rr = a - n * 6.283185307179586;
            const double r2 = rr * rr;
            double sn = 0.0, term = rr;
            for (int k = 0; k < 16; ++k) { sn += term; term *= -r2 / (double)((2 * k + 2) * (2 * k + 3)); }
            double cs = 0.0; term = 1.0;
            for (int k = 0; k < 16; ++k) { cs += term; term *= -r2 / (double)((2 * k + 1) * (2 * k + 2)); }
            cosT[idx] = (float)cs; sinT[idx] = (float)sn;
        }
    }
    xcd_barrier(xbar);
    if (P.ws == nullptr) grid.sync();

    for (int l = 0; l < NL; ++l) {
        const unsigned char* wl = ws + WS_W + (size_t)l * WL_BYTES;
        const bf16_t* WIN = (const bf16_t*)(wl + OW_IN);
        const bf16_t* WQB = (const bf16_t*)(wl + OW_QB);
        const bf16_t* WKVB = (const bf16_t*)(wl + OW_KVB);
        const bf16_t* WOUT = (const bf16_t*)(wl + OW_OUT);
        const bf16_t* WUP = (const bf16_t*)(wl + OW_UP);
        const bf16_t* WDOWN = (const bf16_t*)(wl + OW_DOWN);
        const bf16_t* WG = (const bf16_t*)(wl + OW_G);
        const bf16_t* WP = (const bf16_t*)(wl + OW_P);
        float* st = stat;

        if (PHASES & 2) for (int t = vb; t < 128 * 12; t += G) {
            const int tid = opq(threadIdx.x), lane = tid & 63, wave = __builtin_amdgcn_readfirstlane(tid >> 6), wm = wave >> 1, wn = wave & 1, fm = lane & 31, hi = lane >> 5;
            int panel = t / 12, ct = t % 12;
            if (G == 512) { const int M = (t >> 9) * 8 + (vb >> 6), q = vb & 63; panel = (M / 3) * 16 + (q >> 2); ct = (M % 3) * 4 + (q & 3); }
            const int row0 = panel * 128, col0 = ct * 192;
            if (tid < 128) ep[tid] = rsqrtf(sum_slots(st + ((size_t)ST_X0 * T + row0 + tid) * 16, 16) * (1.0f / 1024.0f) + EPS);
            f32x16 acc[2][3];
            gemm_mainloop_w3(xb + (size_t)row0 * D, D, WIN + (size_t)col0 * D, D, D, lds, acc);
            const int grp = 2 * ct + wn;
#pragma unroll
            for (int mt = 0; mt < 2; ++mt) {
                float ss[16], rs[16];
#pragma unroll
                for (int r = 0; r < 16; ++r) { ss[r] = 0.f; rs[r] = ep[wm * 64 + mt * 32 + crow(r, hi)]; }
#pragma unroll
                for (int nt = 0; nt < 3; ++nt) {
                    const int col = col0 + wn * 96 + nt * 32 + fm;
                    const bool cnt = (grp < 6) || (nt < 2);
#pragma unroll
                    for (int r = 0; r < 16; ++r) {
                        const float v = acc[mt][nt][r] * rs[r];
                        zb[(size_t)(row0 + wm * 64 + mt * 32 + crow(r, hi)) * ZW + col] = f2bf(v);
                        if (cnt) ss[r] += v * v;
                    }
                }
                if (grp < 7) {
                    const float tot = rowsum32(ss, lane);
                    float* pp = st + ((size_t)(grp < 4 ? ST_QA : ST_KVA) * T + row0 + wm * 64 + mt * 32 + crow((lane >> 1) & 15, hi)) * 16 + (grp < 4 ? grp : grp - 4);
                    if ((lane & 1) == 0) *pp = tot;
                }
            }
            __syncthreads();
        }
        xcd_barrier(xbar);

        if (STOP == 1) { dump_bf(zb, ZW); return; }
        if (PHASES & 4) for (int t = vb; t < 1024; t += G) {
            const int tid = opq(threadIdx.x), lane = tid & 63, wave = __builtin_amdgcn_readfirstlane(tid >> 6), wm = wave >> 1, wn = wave & 1, fm = lane & 31, hi = lane >> 5; (void)lane;
            if (t < 512) {
                const int panel = t >> 2, ct = t & 3, row0 = panel * 128, col0 = ct * 192;
                if (tid < 128) ep[tid] = rsqrtf(sum_slots(st + ((size_t)ST_QA * T + row0 + tid) * 16, 4) * (1.0f / 384.0f) + EPS);
                f32x16 acc[2][3];
                gemm_mainloop_w3(zb + (size_t)row0 * ZW, ZW, WQB + (size_t)col0 * 384, 384, 384, lds, acc);
                const int h = 2 * ct + wn;
#pragma unroll
                for (int mt = 0; mt < 2; ++mt) {
                    float rs[16];
#pragma unroll
                    for (int r = 0; r < 16; ++r) rs[r] = ep[wm * 64 + mt * 32 + crow(r, hi)] * QSCALE;
#pragma unroll
                    for (int nt = 0; nt < 3; ++nt) {
#pragma unroll
                        for (int r = 0; r < 16; ++r) {
                            const int row = row0 + wm * 64 + mt * 32 + crow(r, hi);
                            const int b = row >> 12, s = row & 4095;
                            float v = acc[mt][nt][r] * rs[r];
                            if (nt == 2) {
                                const float pr = __shfl_xor(v, 16);
                                const float c = cosT[s * 16 + (fm & 15)], sn = sinT[s * 16 + (fm & 15)];
                                v = (fm < 16) ? (v * c - pr * sn) : (v * c + pr * sn);
                            }
                            Qb[((size_t)(b * NH + h) * S + s) * 96 + nt * 32 + fm] = f2bf(v);
                        }
                    }
                }
            } else {
                const int t2 = t - 512;
                const int panel = t2 >> 2, ct = t2 & 3, row0 = panel * 128, col0 = ct * 256;
                if (tid < 128) ep[tid] = rsqrtf(sum_slots(st + ((size_t)ST_KVA * T + row0 + tid) * 16, 3) * (1.0f / 256.0f) + EPS);
                f32x16 acc[2][4];
                gemm_mainloop_w(zb + (size_t)row0 * ZW + 384, ZW, WKVB + (size_t)col0 * 256, 256, 256, lds, acc);
                const int h = 2 * ct + wn;
#pragma unroll
                for (int mt = 0; mt < 2; ++mt) {
                    float rs[16];
#pragma unroll
                    for (int r = 0; r < 16; ++r) rs[r] = ep[wm * 64 + mt * 32 + crow(r, hi)];
                    const int rbase = row0 + wm * 64 + mt * 32;
                    const int b = rbase >> 12;
#pragma unroll
                    for (int nt = 0; nt < 4; ++nt) {
                        if (nt < 2) {
                            const int d = nt * 32 + fm;
#pragma unroll
                            for (int r = 0; r < 16; ++r) {
                                const int s = (rbase + crow(r, hi)) & 4095;
                                Kb[((size_t)(b * NH + h) * S + s) * 96 + d] = f2bf(acc[mt][nt][r] * rs[r]);
                            }
                        } else {
                            const int d = (nt - 2) * 32 + fm;
#pragma unroll
                            for (int g = 0; g < 4; ++g) {
                                const int s = (rbase + 8 * g + 4 * hi) & 4095;
                                const u32x2 w = (u32x2){pk2(acc[mt][nt][4 * g] * rs[4 * g], acc[mt][nt][4 * g + 1] * rs[4 * g + 1]),
                                                         pk2(acc[mt][nt][4 * g + 2] * rs[4 * g + 2], acc[mt][nt][4 * g + 3] * rs[4 * g + 3])};
                                *(u32x2*)(Vt + ((size_t)(b * NH + h) * 64 + d) * S + s) = w;
                            }
                        }
                    }
                }
            }
            __syncthreads();
        }
        if (PHASES & 8) {
            const float* wc = P.in[8] + (size_t)l * 3 * 512;
            for (int row = vb * 4 + wave; row < T; row += G * 4) {
                const int tid = opq(threadIdx.x), lane = tid & 63, wave_ = 0, wm = 0, wn = 0, fm = lane & 31, hi = lane >> 5; (void)wm; (void)wn; (void)fm; (void)hi; (void)wave_; (void)lane;
                const int s = row & 4095, b = row >> 12;
                const bf16_t* zr = zb + (size_t)row * ZW;
                const int c0 = 8 * lane;
                const u32x4 gbv = *(const u32x4*)(zr + 672 + c0);
                const u32x4 gc1 = *(const u32x4*)(zr + 1184 + c0), ci1 = *(const u32x4*)(zr + 1696 + c0);
                u32x4 gc0 = (u32x4){0, 0, 0, 0}, ci0 = gc0, gc2 = gc0, ci2 = gc0;
                if (s > 0) { gc0 = *(const u32x4*)(zr - ZW + 1184 + c0); ci0 = *(const u32x4*)(zr - ZW + 1696 + c0); }
                if (s < S - 1) { gc2 = *(const u32x4*)(zr + ZW + 1184 + c0); ci2 = *(const u32x4*)(zr + ZW + 1696 + c0); }
                const f32x4 w0a = *(const f32x4*)(wc + c0), w0b = *(const f32x4*)(wc + c0 + 4);
                const f32x4 w1a = *(const f32x4*)(wc + 512 + c0), w1b = *(const f32x4*)(wc + 512 + c0 + 4);
                const f32x4 w2a = *(const f32x4*)(wc + 1024 + c0), w2b = *(const f32x4*)(wc + 1024 + c0 + 4);
                float cv[8]; float ss = 0.f;
#pragma unroll
                for (int i = 0; i < 4; ++i) {
                    const unsigned a0 = gc0[i], a1 = gc1[i], a2 = gc2[i], d0 = ci0[i], d1 = ci1[i], d2 = ci2[i], gw = gbv[i];
                    const float wlo0 = (i < 2) ? w0a[2 * i] : w0b[2 * i - 4], whi0 = (i < 2) ? w0a[2 * i + 1] : w0b[2 * i - 3];
                    const float wlo1 = (i < 2) ? w1a[2 * i] : w1b[2 * i - 4], whi1 = (i < 2) ? w1a[2 * i + 1] : w1b[2 * i - 3];
                    const float wlo2 = (i < 2) ? w2a[2 * i] : w2b[2 * i - 4], whi2 = (i < 2) ? w2a[2 * i + 1] : w2b[2 * i - 3];
                    const float lo = bflo(gw) * (wlo0 * bflo(a0) * bflo(d0) + wlo1 * bflo(a1) * bflo(d1) + wlo2 * bflo(a2) * bflo(d2));
                    const float hv = bfhi(gw) * (whi0 * bfhi(a0) * bfhi(d0) + whi1 * bfhi(a1) * bfhi(d1) + whi2 * bfhi(a2) * bfhi(d2));
                    cv[2 * i] = lo; cv[2 * i + 1] = hv; ss += lo * lo + hv * hv;
                }
                ss += __shfl_xor(ss, 1); ss += __shfl_xor(ss, 2); ss += __shfl_xor(ss, 4);
                const float rn = rsqrtf(ss * (1.0f / 64.0f) + EPS);
                *(u32x4*)(mix + (size_t)row * D + 512 + c0) = (u32x4){pk2(cv[0] * rn, cv[1] * rn), pk2(cv[2] * rn, cv[3] * rn), pk2(cv[4] * rn, cv[5] * rn), pk2(cv[6] * rn, cv[7] * rn)};
                if (lane < 16) {
                    const float a = bf2f(zr[640 + lane]), bb = bf2f(zr[656 + lane]);
                    const float c = cosT[s * 16 + lane], sn = sinT[s * 16 + lane];
                    const bf16_t o1 = f2bf(a * c - bb * sn), o2 = f2bf(bb * c + a * sn);
#pragma unroll
                    for (int h = 0; h < NH; ++h) {
                        bf16_t* kp = Kb + ((size_t)(b * NH + h) * S + s) * 96;
                        kp[64 + lane] = o1; kp[80 + lane] = o2;
                    }
                }
            }
        }
        xcd_barrier(xbar);

        if (STOP == 2) { dump_bf(Qb, 768); return; }
        if (STOP == 12) { dump_bf(Kb, 768); return; }
        if (STOP == 22) { dump_bf(Vt, 512); return; }
        if (STOP == 32) { dump_bf(mix, 1024); return; }
        if (PHASES & 16) for (int rep = 0; rep < REPA; ++rep) for (int it = vb; it < 32 * 16; it += G) {
            const int tid = opq(threadIdx.x), lane = tid & 63, wave = __builtin_amdgcn_readfirstlane(tid >> 6), fm = lane & 31, hi = lane >> 5;
            const int bh = it >> 4, qb = it & 15, b = bh >> 3, h = bh & 7;
            const bf16_t* Qp = Qb + ((size_t)bh * S + qb * 256 + wave * 64 + fm) * 96 + hi * 8;
            const bf16_t* Kp = Kb + (size_t)bh * S * 96;
            const bf16_t* Vp = Vt + (size_t)bh * 64 * S;
            bf16x8 qf[2][6];
#pragma unroll
            for (int u = 0; u < 2; ++u)
#pragma unroll
                for (int d0 = 0; d0 < 6; ++d0) qf[u][d0] = *(const bf16x8*)(Qp + (size_t)u * 32 * 96 + d0 * 16);
            f32x16 o[2][2];
#pragma unroll
            for (int u = 0; u < 2; ++u)
#pragma unroll
                for (int r = 0; r < 16; ++r) { o[u][0][r] = 0.f; o[u][1][r] = 0.f; }
            float mhat[2] = {0.f, 0.f}, lrun[2] = {0.f, 0.f};
            u32x4 kr[3], vr[2];
            const int pim = (fm & ~12) | ((fm & 4) << 1) | ((fm & 8) >> 1);
            const int koff = pim * KROW + hi * 16, voff = fm * VROW + hi * 16;
            auto loadkv = [&](int kv0) __attribute__((always_inline)) {
#pragma unroll
                for (int i = 0; i < 3; ++i) kr[i] = *(const u32x4*)(Kp + (size_t)kv0 * 96 + (tid + 256 * i) * 8);
#pragma unroll
                for (int i = 0; i < 2; ++i) { const int c = tid + 256 * i; vr[i] = *(const u32x4*)(Vp + (size_t)(c >> 3) * S + kv0 + (c & 7) * 8); }
            };
            auto storekv = [&](int buf) __attribute__((always_inline)) {
                unsigned char* kb = lds + buf * (KT_BYTES + VT_BYTES);
                unsigned char* vbp = kb + KT_BYTES;
#pragma unroll
                for (int i = 0; i < 3; ++i) { const int c = tid + 256 * i; *(u32x4*)(kb + (c / 12) * KROW + (c % 12) * 16) = kr[i]; }
#pragma unroll
                for (int i = 0; i < 2; ++i) { const int c = tid + 256 * i; *(u32x4*)(vbp + (c >> 3) * VROW + (c & 7) * 16) = vr[i]; }
            };
            loadkv(0); storekv(0); __syncthreads();
            for (int kt = 0; kt < 64; ++kt) {
                if (kt + 1 < 64) loadkv((kt + 1) * 64);
                __builtin_amdgcn_sched_barrier(0);
                const unsigned char* kb = lds + (kt & 1) * (KT_BYTES + VT_BYTES);
                const unsigned char* vbp = kb + KT_BYTES;
                f32x16 p[2][2];
#pragma unroll
                for (int d0 = 0; d0 < 6; ++d0) {
                    const bf16x8 k0 = *(const bf16x8*)(kb + koff + d0 * 32), k1 = *(const bf16x8*)(kb + koff + 32 * KROW + d0 * 32);
#pragma unroll
                    for (int u = 0; u < 2; ++u) {
                        if (d0 == 0) {
                            p[u][0] = __builtin_amdgcn_mfma_f32_32x32x16_bf16(k0, qf[u][0], (f32x16){0.f,0.f,0.f,0.f,0.f,0.f,0.f,0.f,0.f,0.f,0.f,0.f,0.f,0.f,0.f,0.f}, 0, 0, 0);
                            p[u][1] = __builtin_amdgcn_mfma_f32_32x32x16_bf16(k1, qf[u][0], (f32x16){0.f,0.f,0.f,0.f,0.f,0.f,0.f,0.f,0.f,0.f,0.f,0.f,0.f,0.f,0.f,0.f}, 0, 0, 0);
                        } else {
                            p[u][0] = __builtin_amdgcn_mfma_f32_32x32x16_bf16(k0, qf[u][d0], p[u][0], 0, 0, 0);
                            p[u][1] = __builtin_amdgcn_mfma_f32_32x32x16_bf16(k1, qf[u][d0], p[u][1], 0, 0, 0);
                        }
                    }
                }
#pragma unroll
                for (int u = 0; u < 2; ++u) {
                    float mx = p[u][0][0];
#pragma unroll
                    for (int r = 0; r < 16; ++r) mx = fmaxf(fmaxf(mx, p[u][0][r]), p[u][1][r]);
                    mx = fmaxf(mx, __shfl_xor(mx, 32));
                    if (kt == 0 || __any(mx - mhat[u] > 8.0f)) {
                        const float nm = (kt == 0) ? mx : fmaxf(mx, mhat[u]);
                        const float f = (kt == 0) ? 1.0f : __builtin_amdgcn_exp2f(mhat[u] - nm);
                        mhat[u] = nm; lrun[u] *= f;
#pragma unroll
                        for (int r = 0; r < 16; ++r) { o[u][0][r] *= f; o[u][1][r] *= f; }
                    }
                }
                auto soft = [&](int u, bf16x8 (&pfu)[4]) __attribute__((always_inline)) {
                    const float mh = mhat[u];
#pragma unroll
                    for (int r = 0; r < 16; ++r) { p[u][0][r] = __builtin_amdgcn_exp2f(p[u][0][r] - mh); p[u][1][r] = __builtin_amdgcn_exp2f(p[u][1][r] - mh); }
                    {
                        const f32x16 t = p[u][0] + p[u][1];
                        float rsum = ((t[0] + t[1]) + (t[2] + t[3])) + ((t[4] + t[5]) + (t[6] + t[7]));
                        rsum += ((t[8] + t[9]) + (t[10] + t[11])) + ((t[12] + t[13]) + (t[14] + t[15]));
                        lrun[u] += rsum;
                    }
#pragma unroll
                    for (int c = 0; c < 4; ++c) {
                        const int mt = c >> 1, r0 = (c & 1) * 8;
                        const u32x4 w = (u32x4){pk2(p[u][mt][r0], p[u][mt][r0 + 1]), pk2(p[u][mt][r0 + 2], p[u][mt][r0 + 3]), pk2(p[u][mt][r0 + 4], p[u][mt][r0 + 5]), pk2(p[u][mt][r0 + 6], p[u][mt][r0 + 7])};
                        pfu[c] = __builtin_bit_cast(bf16x8, w);
                    }
                };
                auto pvm = [&](int u, const bf16x8 (&pfu)[4]) __attribute__((always_inline)) {
#pragma unroll
                    for (int c = 0; c < 4; ++c) {
                        const bf16x8 v0 = *(const bf16x8*)(vbp + voff + c * 32), v1 = *(const bf16x8*)(vbp + voff + 32 * VROW + c * 32);
                        o[u][0] = __builtin_amdgcn_mfma_f32_32x32x16_bf16(v0, pfu[c], o[u][0], 0, 0, 0);
                        o[u][1] = __builtin_amdgcn_mfma_f32_32x32x16_bf16(v1, pfu[c], o[u][1], 0, 0, 0);
                    }
                };
                bf16x8 pfa[4], pfb[4];
                soft(0, pfa);
                pvm(0, pfa);
                soft(1, pfb);
#pragma unroll
                for (int i = 0; i < 8; ++i) { __builtin_amdgcn_sched_group_barrier(0x008, 1, 0); __builtin_amdgcn_sched_group_barrier(0x002, 10, 0); }
                pvm(1, pfb);
                if (kt + 1 < 64) storekv((kt + 1) & 1);
                __syncthreads();
            }
#pragma unroll
            for (int u = 0; u < 2; ++u) {
                const float ltot = lrun[u] + __shfl_xor(lrun[u], 32);
                const float inv = 1.0f / ltot;
                float ss = 0.f;
#pragma unroll
                for (int r = 0; r < 16; ++r) { o[u][0][r] *= inv; o[u][1][r] *= inv; ss += o[u][0][r] * o[u][0][r] + o[u][1][r] * o[u][1][r]; }
                ss += __shfl_xor(ss, 32);
                const float rn = rsqrtf(ss * (1.0f / 64.0f) + EPS);
                bf16_t* mp = mix + (size_t)(b * S + qb * 256 + wave * 64 + u * 32 + fm) * D + h * 64 + 4 * hi;
#pragma unroll
                for (int d0 = 0; d0 < 2; ++d0)
#pragma unroll
                    for (int g = 0; g < 4; ++g)
                        *(u32x2*)(mp + d0 * 32 + 8 * g) = (u32x2){pk2(o[u][d0][4 * g] * rn, o[u][d0][4 * g + 1] * rn), pk2(o[u][d0][4 * g + 2] * rn, o[u][d0][4 * g + 3] * rn)};
            }
        }
        xcd_barrier(xbar);

        if (STOP == 3) { dump_bf(mix, 1024); return; }
        if (PHASES & 32) for (int t = vb; t < 128 * 4; t += G) {
            const int panel = t >> 2, ct = t & 3, row0 = panel * 128, col0 = ct * 256;
            f32x16 acc[2][4];
            gemm_mainloop_w(mix + (size_t)row0 * D, D, WOUT + (size_t)col0 * D, D, D, lds, acc);
            exch_epilogue_w(acc, row0, col0, gran + (size_t)0 * T * 16, (unsigned)(l * 4 + 1), P.in[12] + l * D, xout, xb, st + (size_t)ST_X1 * T * 16, ep);
            __syncthreads();
        }
        xcd_barrier(xbar);

        if (STOP == 4) { return; }
        if (PHASES & 64) for (int t = vb; t < 2048; t += G) {
            const int tid = opq(threadIdx.x), lane = tid & 63, wave = __builtin_amdgcn_readfirstlane(tid >> 6), wm = wave >> 1, wn = wave & 1, fm = lane & 31, hi = lane >> 5; (void)lane;
            if (t < 2048) {
                int panel = t >> 4, ct = t & 15;
                if (G == 512) { const int M = (t >> 9) * 8 + (vb >> 6), q = vb & 63; panel = (M >> 1) * 8 + (q >> 3); ct = (M & 1) * 8 + (q & 7); }
                const int row0 = panel * 128, col0 = ct * 256;
                if (tid < 128) ep[tid] = rsqrtf(sum_slots(st + ((size_t)ST_X1 * T + row0 + tid) * 16, 8) * (1.0f / 1024.0f) + EPS);
                f32x16 acc[2][4];
                gemm_mainloop_w(xb + (size_t)row0 * D, D, WUP + (size_t)col0 * D, D, D, lds, acc);
#pragma unroll
                for (int mt = 0; mt < 2; ++mt) {
                    float rs[16];
#pragma unroll
                    for (int r = 0; r < 16; ++r) rs[r] = ep[wm * 64 + mt * 32 + crow(r, hi)];
#pragma unroll
                    for (int nt = 0; nt < 4; ++nt) {
                        const int col = col0 + wn * 128 + nt * 32 + fm;
#pragma unroll
                        for (int r = 0; r < 16; ++r) {
                            const float v = fmaxf(acc[mt][nt][r] * rs[r], 0.f);
                            ub[(size_t)(row0 + wm * 64 + mt * 32 + crow(r, hi)) * FF + col] = f2bf(v * v);
                        }
                    }
                }
            } else {
                const int t2 = t - 2048;
                const int panel = t2 >> 3, ct = t2 & 7, row0 = panel * 128, col0 = ct * 128;
                f32x16 acc[2][2];
                gemm_mainloop<true>(P.in[1] + ((size_t)l * T + row0) * 256, 256, WP + (size_t)col0 * 256, 256, 256, lds, acc);
#pragma unroll
                for (int mt = 0; mt < 2; ++mt)
#pragma unroll
                    for (int nt = 0; nt < 2; ++nt) {
                        const int col = col0 + wn * 64 + nt * 32 + fm;
#pragma unroll
                        for (int r = 0; r < 16; ++r) ebuf[(size_t)(row0 + wm * 64 + mt * 32 + crow(r, hi)) * D + col] = f2bf(acc[mt][nt][r]);
                    }
            }
            __syncthreads();
        }
        xcd_barrier(xbar);

        if (STOP == 5) { dump_bf(ub, 4096); return; }
        if (STOP == 15) { dump_bf(ebuf, 1024); return; }
        if (PHASES & 128) for (int t = vb; t < 128 * 4; t += G) {
            const int panel = t >> 2, ct = t & 3, row0 = panel * 128, col0 = ct * 256;
            f32x16 acc[2][4];
            gemm_mainloop_w(ub + (size_t)row0 * FF, FF, WDOWN + (size_t)col0 * FF, FF, FF, lds, acc);
            exch_epilogue_w(acc, row0, col0, gran + (size_t)1 * T * 16, (unsigned)(l * 4 + 2), P.in[16] + l * D, xout, xb, st + (size_t)ST_X2 * T * 16, ep);
            __syncthreads();
        }
        xcd_barrier(xbar);

        if (STOP == 6) { return; }
        if (PHASES & 256) for (int t = vb; t < 128 * 8; t += G) {
            const int tid = opq(threadIdx.x), lane = tid & 63, wave = __builtin_amdgcn_readfirstlane(tid >> 6), wm = wave >> 1, wn = wave & 1, fm = lane & 31, hi = lane >> 5; (void)lane; (void)fm; (void)wn;
            const int panel = t >> 3, ct = t & 7, row0 = panel * 128, col0 = ct * 128;
            if (tid < 128) ep[tid] = rsqrtf(sum_slots(st + ((size_t)ST_X2 * T + row0 + tid) * 16, 8) * (1.0f / 1024.0f) + EPS);
            f32x16 acce[2][2];
            gemm_mainloop<true>(P.in[1] + ((size_t)l * T + row0) * 256, 256, WP + (size_t)col0 * 256, 256, 256, lds, acce);
            f32x16 acc[2][2];
            gemm_mainloop<false>(xb + (size_t)row0 * D, D, WG + (size_t)col0 * D, D, D, lds, acc);
#pragma unroll
            for (int mt = 0; mt < 2; ++mt) {
                float rs[16];
#pragma unroll
                for (int r = 0; r < 16; ++r) rs[r] = ep[wm * 64 + mt * 32 + crow(r, hi)];
#pragma unroll
                for (int nt = 0; nt < 2; ++nt) {
#pragma unroll
                    for (int r = 0; r < 16; ++r) {
                        const float gte = __builtin_amdgcn_rcpf(1.0f + __builtin_amdgcn_exp2f(-1.4426950408889634f * (acc[mt][nt][r] * rs[r])));
                        acc[mt][nt][r] = gte * acce[mt][nt][r];
                    }
                }
            }
            exch_epilogue(acc, row0, col0, gran + (size_t)2 * T * 16, (unsigned)(l * 4 + 3), P.in[20] + l * D, (l == NL - 1) ? xout : nullptr, xb, st + (size_t)ST_X0 * T * 16, ep);
            __syncthreads();
        }
        if (STOP == 7) return;
        if (l + 1 < NL) xcd_barrier(xbar);
    }
}

extern "C" void kernel_launch(void* const* d_in, const int* in_sizes, int n_in, void* d_out, int out_size, void* d_ws, size_t ws_size, hipStream_t stream) {
    static int grid = 0;
    if (grid == 0) {
        if (n_in != 21 || out_size != T * D || ws_size < WS_END) { fprintf(stderr, "kernel_launch: unexpected problem (n_in %d out %d ws %zu)\n", n_in, out_size, ws_size); grid = -1; return; }
        int dev = 0, cus = 0, per_cu = 0;
        hipGetDevice(&dev);
        hipDeviceGetAttribute(&cus, hipDeviceAttributeMultiprocessorCount, dev);
        if (hipFuncSetAttribute((const void*)mega, hipFuncAttributeMaxDynamicSharedMemorySize, LDS_BYTES) != hipSuccess) { fprintf(stderr, "hipFuncSetAttribute failed\n"); grid = -1; return; }
        if (hipOccupancyMaxActiveBlocksPerMultiprocessor(&per_cu, (const void*)mega, 256, LDS_BYTES) != hipSuccess || per_cu < 1) { fprintf(stderr, "occupancy query failed (%d)\n", per_cu); per_cu = 1; }
        if (per_cu > 2) per_cu = 2;
        grid = (cus * per_cu) & ~7;
        fprintf(stderr, "kernel_launch: cus %d per_cu %d grid %d\n", cus, per_cu, grid);
    }
    if (grid < 0) return;
    if (hipMemsetAsync((char*)d_ws + WS_CNT + 8192 * 4, 0, XCD_BAR_WORDS * 4, stream) != hipSuccess) { fprintf(stderr, "kernel_launch: memset of the barrier words failed\n"); return; }
    Params p{};
    for (int i = 0; i < 21; ++i) p.in[i] = (const float*)d_in[i];
    p.out = (float*)d_out; p.ws = (unsigned char*)d_ws;
    void* args[] = {&p};
    hipError_t e = hipLaunchCooperativeKernel((const void*)mega, dim3(grid), dim3(256), args, LDS_BYTES, stream);
    if (e != hipSuccess) fprintf(stderr, "cooperative launch failed: %s (grid %d)\n", hipGetErrorString(e), grid);
}
```

```cpp
#include <hip/hip_runtime.h>
#include <hip/hip_cooperative_groups.h>
#include <cstdio>
#include <cstdint>
namespace cg = cooperative_groups;

typedef unsigned short bf16_t;
typedef short bf16x8 __attribute__((ext_vector_type(8)));
typedef float f32x16 __attribute__((ext_vector_type(16)));
typedef float f32x4 __attribute__((ext_vector_type(4)));
typedef unsigned u32x4 __attribute__((ext_vector_type(4)));
typedef unsigned u32x2 __attribute__((ext_vector_type(2)));

constexpr int T = 16384, S = 4096, D = 1024, NL = 4, NH = 8, ZW = 2304, FF = 4096;
constexpr float EPS = 1e-6f;
constexpr float QSCALE = 0.10206207261596575f * 1.4426950408889634f;

constexpr size_t MiB = (size_t)1 << 20;
constexpr size_t WS_STAT = 0;
constexpr size_t WS_CNT = 8 * MiB;
constexpr size_t WS_ROPE = 9 * MiB;
constexpr size_t WS_W = 10 * MiB;
constexpr size_t WL_BYTES = 27328512;
constexpr size_t OW_IN = 0, OW_QB = 4718592, OW_KVB = 5308416, OW_OUT = 5832704, OW_UP = 7929856, OW_DOWN = 16318464, OW_G = 24707072, OW_P = 26804224;
constexpr size_t WS_XB = 115 * MiB;
constexpr size_t WS_MIX = 147 * MiB;
constexpr size_t WS_Z = 179 * MiB;
constexpr size_t WS_Q = 251 * MiB;
constexpr size_t WS_K = 275 * MiB;
constexpr size_t WS_VT = 299 * MiB;
constexpr size_t WS_U = 179 * MiB;
constexpr size_t WS_GRAN = 315 * MiB;
constexpr size_t WS_END = 321 * MiB;

enum { ST_X0 = 0, ST_QA = 1, ST_KVA = 2, ST_Y1 = 3, ST_X1 = 4, ST_F = 5, ST_X2 = 6, ST_T = 7 };

constexpr int LROW = 144;
constexpr int TILE_BYTES = 128 * LROW;
constexpr int EP_OFF = 4 * TILE_BYTES;
constexpr int XB_OFF = EP_OFF + 1024;
constexpr int LDS_BYTES = XB_OFF + 64;
constexpr int KROW = 208, VROW = 144;
constexpr int KT_BYTES = 64 * KROW, VT_BYTES = 64 * VROW;

#ifndef PHASES
#define PHASES 511
#endif
#ifndef REPG
#define REPG 1
#endif
#ifndef REPA
#define REPA 1
#endif
#ifndef REPP
#define REPP 1
#endif
#ifndef STOP
#define STOP 0
#endif
struct Params { const float* in[21]; float* out; unsigned char* ws; };

typedef float f32x2_t __attribute__((ext_vector_type(2)));
typedef __bf16 bf16x2_t __attribute__((ext_vector_type(2)));
__device__ __forceinline__ unsigned pk2(float lo, float hi) { const f32x2_t v = {lo, hi}; const bf16x2_t b = __builtin_convertvector(v, bf16x2_t); return __builtin_bit_cast(unsigned, b); }
__device__ __forceinline__ bf16_t f2bf(float f) { return (bf16_t)(pk2(f, 0.f) & 0xffffu); }
__device__ __forceinline__ float bf2f(bf16_t b) { return __uint_as_float(((unsigned)b) << 16); }
__device__ __forceinline__ float bflo(unsigned w) { return __uint_as_float(w << 16); }
__device__ __forceinline__ float bfhi(unsigned w) { return __uint_as_float(w & 0xffff0000u); }
__device__ __forceinline__ int opq(int v) { asm volatile("" : "+v"(v)); return v; }
__device__ __forceinline__ int crow(int r, int hi) { return (r & 3) + 8 * (r >> 2) + 4 * hi; }
__device__ __forceinline__ int vblock() { const int G = gridDim.x, b = blockIdx.x; return (G % 8 == 0) ? (b % 8) * (G / 8) + b / 8 : b; }
__device__ __forceinline__ void st_wt(float* p, float v) { __hip_atomic_store(p, v, __ATOMIC_RELAXED, __HIP_MEMORY_SCOPE_AGENT); }
__device__ __forceinline__ float atomic_ldf(const float* p) { return __hip_atomic_load(p, __ATOMIC_RELAXED, __HIP_MEMORY_SCOPE_AGENT); }
__device__ __forceinline__ float sum_slots(const float* p, int nslot) {
    const f32x4* q = (const f32x4*)p; float s = 0.f;
    for (int i = 0; i < (nslot >> 2); ++i) { const f32x4 a = q[i]; s += (a[0] + a[1]) + (a[2] + a[3]); }
    for (int i = nslot & ~3; i < nslot; ++i) s += p[i];
    return s;
}

__device__ __forceinline__ float rowsum32(const float (&s)[16], int lane) {
    const bool b4 = lane & 16, b3 = lane & 8, b2 = lane & 4, b1 = lane & 2;
    float a[8], b[4], c[2], d;
#pragma unroll
    for (int i = 0; i < 8; ++i) { const float keep = b4 ? s[8 + i] : s[i], send = b4 ? s[i] : s[8 + i]; a[i] = keep + __shfl_xor(send, 16); }
#pragma unroll
    for (int i = 0; i < 4; ++i) { const float keep = b3 ? a[4 + i] : a[i], send = b3 ? a[i] : a[4 + i]; b[i] = keep + __shfl_xor(send, 8); }
#pragma unroll
    for (int i = 0; i < 2; ++i) { const float keep = b2 ? b[2 + i] : b[i], send = b2 ? b[i] : b[2 + i]; c[i] = keep + __shfl_xor(send, 4); }
    { const float keep = b1 ? c[1] : c[0], send = b1 ? c[0] : c[1]; d = keep + __shfl_xor(send, 2); }
    d += __shfl_xor(d, 1);
    return d;
}

template <bool AF32>
__device__ __forceinline__ void gemm_mainloop(const void* __restrict__ Ap, int lda, const bf16_t* __restrict__ Bt, int ldb, int K,
                                              unsigned char* smem, f32x16 (&acc)[2][2]) {
    const int tid = opq(threadIdx.x), lane = tid & 63, wave = __builtin_amdgcn_readfirstlane(tid >> 6), wm = wave >> 1, wn = wave & 1, fm = lane & 31, hi = lane >> 5;
    const int srow = tid >> 3, skc = tid & 7;
    u32x4 ra0[4], rb0[4], ra1[4], rb1[4];
    u32x4 rx0[AF32 ? 4 : 1], rx1[AF32 ? 4 : 1];
#pragma unroll
    for (int i = 0; i < 2; ++i)
#pragma unroll
        for (int j = 0; j < 2; ++j)
#pragma unroll
            for (int r = 0; r < 16; ++r) acc[i][j][r] = 0.f;
    const int aoff = (wm * 64 + fm) * LROW + hi * 16, boff = (wn * 64 + fm) * LROW + hi * 16;
    const int soff = srow * LROW + skc * 16;
    const unsigned la = (unsigned)(srow * lda + skc * 8), lb = (unsigned)(srow * ldb + skc * 8);
    auto loadt = [&](int k0, u32x4 (&ra)[4], u32x4 (&rx)[AF32 ? 4 : 1], u32x4 (&rb)[4]) __attribute__((always_inline)) {
#pragma unroll
        for (int i = 0; i < 4; ++i) {
            if (AF32) {
                const float* ap = (const float*)Ap + (size_t)(32 * i) * lda + k0;
                ra[i] = *(const u32x4*)(ap + la); rx[i] = *(const u32x4*)(ap + la + 4);
            } else {
                const bf16_t* ap = (const bf16_t*)Ap + (size_t)(32 * i) * lda + k0;
                ra[i] = *(const u32x4*)(ap + la);
            }
            const bf16_t* bp = Bt + (size_t)(32 * i) * ldb + k0;
            rb[i] = *(const u32x4*)(bp + lb);
        }
    };
    auto storet = [&](int buf, const u32x4 (&ra)[4], const u32x4 (&rx)[AF32 ? 4 : 1], const u32x4 (&rb)[4]) __attribute__((always_inline)) {
        unsigned char* a = smem + buf * 2 * TILE_BYTES;
        unsigned char* b = a + TILE_BYTES;
#pragma unroll
        for (int i = 0; i < 4; ++i) {
            u32x4 av = ra[i];
            if (AF32) av = (u32x4){pk2(__uint_as_float(ra[i][0]), __uint_as_float(ra[i][1])), pk2(__uint_as_float(ra[i][2]), __uint_as_float(ra[i][3])),
                                   pk2(__uint_as_float(rx[i][0]), __uint_as_float(rx[i][1])), pk2(__uint_as_float(rx[i][2]), __uint_as_float(rx[i][3]))};
            *(u32x4*)(a + soff + i * 32 * LROW) = av; *(u32x4*)(b + soff + i * 32 * LROW) = rb[i];
        }
    };
    auto compute = [&](int buf) __attribute__((always_inline)) {
        const unsigned char* a = smem + buf * 2 * TILE_BYTES;
        const unsigned char* b = a + TILE_BYTES;
        __builtin_amdgcn_s_setprio(1);
#pragma unroll
        for (int kk = 0; kk < 4; ++kk) {
            const bf16x8 a0 = *(const bf16x8*)(a + aoff + kk * 32), a1 = *(const bf16x8*)(a + aoff + 32 * LROW + kk * 32);
            const bf16x8 b0 = *(const bf16x8*)(b + boff + kk * 32), b1 = *(const bf16x8*)(b + boff + 32 * LROW + kk * 32);
            acc[0][0] = __builtin_amdgcn_mfma_f32_32x32x16_bf16(a0, b0, acc[0][0], 0, 0, 0);
            acc[0][1] = __builtin_amdgcn_mfma_f32_32x32x16_bf16(a0, b1, acc[0][1], 0, 0, 0);
            acc[1][0] = __builtin_amdgcn_mfma_f32_32x32x16_bf16(a1, b0, acc[1][0], 0, 0, 0);
            acc[1][1] = __builtin_amdgcn_mfma_f32_32x32x16_bf16(a1, b1, acc[1][1], 0, 0, 0);
        }
        __builtin_amdgcn_s_setprio(0);
    };
    const int nk = K >> 6;
    for (int rep = 0; rep < REPG; ++rep) {
    if (rep) {
#pragma unroll
        for (int i = 0; i < 2; ++i)
#pragma unroll
            for (int j = 0; j < 2; ++j)
#pragma unroll
                for (int r = 0; r < 16; ++r) acc[i][j][r] = 0.f;
    }
    loadt(0, ra0, rx0, rb0);
    if (nk > 1) loadt(64, ra1, rx1, rb1);
    storet(0, ra0, rx0, rb0); __syncthreads();
    for (int kt = 0; kt < nk; kt += 2) {
        if (kt + 2 < nk) loadt((kt + 2) << 6, ra0, rx0, rb0);
        __builtin_amdgcn_sched_barrier(0);
        compute(0);
        if (kt + 1 < nk) storet(1, ra1, rx1, rb1);
        __syncthreads();
        if (kt + 1 < nk) {
            if (kt + 3 < nk) loadt((kt + 3) << 6, ra1, rx1, rb1);
            __builtin_amdgcn_sched_barrier(0);
            compute(1);
            if (kt + 2 < nk) storet(0, ra0, rx0, rb0);
            __syncthreads();
        }
    }
    }
}

constexpr int LROW2 = 80;
constexpr int A2_BYTES = 128 * LROW2, B2_BYTES = 256 * LROW2, STAGE2 = A2_BYTES + B2_BYTES;
__device__ __forceinline__ void gemm_mainloop_w(const bf16_t* __restrict__ Ap, int lda, const bf16_t* __restrict__ Bt, int ldb, int K,
                                                unsigned char* smem, f32x16 (&acc)[2][4]) {
    const int tid = opq(threadIdx.x), lane = tid & 63, wave = __builtin_amdgcn_readfirstlane(tid >> 6), wm = wave >> 1, wn = wave & 1, fm = lane & 31, hi = lane >> 5;
    const int srow = tid >> 2, skc = tid & 3;
    u32x4 ra0[2], rb0[4], ra1[2], rb1[4];
#pragma unroll
    for (int i = 0; i < 2; ++i)
#pragma unroll
        for (int j = 0; j < 4; ++j)
#pragma unroll
            for (int r = 0; r < 16; ++r) acc[i][j][r] = 0.f;
    const int aoff = (wm * 64 + fm) * LROW2 + hi * 16, boff = A2_BYTES + (wn * 128 + fm) * LROW2 + hi * 16;
    const int soff = srow * LROW2 + skc * 16;
    const unsigned la = (unsigned)(srow * lda + skc * 8), lb = (unsigned)(srow * ldb + skc * 8);
    auto loadt = [&](int k0, u32x4 (&ra)[2], u32x4 (&rb)[4]) __attribute__((always_inline)) {
#pragma unroll
        for (int i = 0; i < 2; ++i) { const bf16_t* ap = Ap + (size_t)(64 * i) * lda + k0; ra[i] = *(const u32x4*)(ap + la); }
#pragma unroll
        for (int i = 0; i < 4; ++i) { const bf16_t* bp = Bt + (size_t)(64 * i) * ldb + k0; rb[i] = *(const u32x4*)(bp + lb); }
    };
    auto storet = [&](int buf, const u32x4 (&ra)[2], const u32x4 (&rb)[4]) __attribute__((always_inline)) {
        unsigned char* a = smem + buf * STAGE2;
#pragma unroll
        for (int i = 0; i < 2; ++i) *(u32x4*)(a + soff + i * 64 * LROW2) = ra[i];
#pragma unroll
        for (int i = 0; i < 4; ++i) *(u32x4*)(a + A2_BYTES + soff + i * 64 * LROW2) = rb[i];
    };
    auto compute = [&](int buf) __attribute__((always_inline)) {
        const unsigned char* s = smem + buf * STAGE2;
        bf16x8 a[2][2], b[2][4];
#pragma unroll
        for (int kk = 0; kk < 2; ++kk) {
            a[kk][0] = *(const bf16x8*)(s + aoff + kk * 32); a[kk][1] = *(const bf16x8*)(s + aoff + 32 * LROW2 + kk * 32);
#pragma unroll
            for (int nt = 0; nt < 4; ++nt) b[kk][nt] = *(const bf16x8*)(s + boff + nt * 32 * LROW2 + kk * 32);
        }
        __builtin_amdgcn_sched_barrier(0);
        __builtin_amdgcn_s_setprio(1);
#pragma unroll
        for (int kk = 0; kk < 2; ++kk)
#pragma unroll
            for (int nt = 0; nt < 4; ++nt) {
                acc[0][nt] = __builtin_amdgcn_mfma_f32_32x32x16_bf16(a[kk][0], b[kk][nt], acc[0][nt], 0, 0, 0);
                acc[1][nt] = __builtin_amdgcn_mfma_f32_32x32x16_bf16(a[kk][1], b[kk][nt], acc[1][nt], 0, 0, 0);
            }
        __builtin_amdgcn_s_setprio(0);
    };
    const int nk = K >> 5;
    loadt(0, ra0, rb0);
    if (nk > 1) loadt(32, ra1, rb1);
    storet(0, ra0, rb0); __syncthreads();
    for (int kt = 0; kt < nk; kt += 2) {
        if (kt + 2 < nk) loadt((kt + 2) << 5, ra0, rb0);
        __builtin_amdgcn_sched_barrier(0);
        compute(0);
        if (kt + 1 < nk) storet(1, ra1, rb1);
        __syncthreads();
        if (kt + 1 < nk) {
            if (kt + 3 < nk) loadt((kt + 3) << 5, ra1, rb1);
            __builtin_amdgcn_sched_barrier(0);
            compute(1);
            if (kt + 2 < nk) storet(0, ra0, rb0);
            __syncthreads();
        }
    }
}

__device__ __forceinline__ void gemm_mainloop_w3(const bf16_t* __restrict__ Ap, int lda, const bf16_t* __restrict__ Bt, int ldb, int K,
                                                unsigned char* smem, f32x16 (&acc)[2][3]) {
    const int tid = opq(threadIdx.x), lane = tid & 63, wave = __builtin_amdgcn_readfirstlane(tid >> 6), wm = wave >> 1, wn = wave & 1, fm = lane & 31, hi = lane >> 5;
    const int srow = tid >> 2, skc = tid & 3;
    u32x4 ra0[2], rb0[3], ra1[2], rb1[3];
#pragma unroll
    for (int i = 0; i < 2; ++i)
#pragma unroll
        for (int j = 0; j < 3; ++j)
#pragma unroll
            for (int r = 0; r < 16; ++r) acc[i][j][r] = 0.f;
    const int aoff = (wm * 64 + fm) * LROW2 + hi * 16, boff = A2_BYTES + (wn * 96 + fm) * LROW2 + hi * 16;
    const int soff = srow * LROW2 + skc * 16;
    const unsigned la = (unsigned)(srow * lda + skc * 8), lb = (unsigned)(srow * ldb + skc * 8);
    auto loadt = [&](int k0, u32x4 (&ra)[2], u32x4 (&rb)[3]) __attribute__((always_inline)) {
#pragma unroll
        for (int i = 0; i < 2; ++i) { const bf16_t* ap = Ap + (size_t)(64 * i) * lda + k0; ra[i] = *(const u32x4*)(ap + la); }
#pragma unroll
        for (int i = 0; i < 3; ++i) { const bf16_t* bp = Bt + (size_t)(64 * i) * ldb + k0; rb[i] = *(const u32x4*)(bp + lb); }
    };
    auto storet = [&](int buf, const u32x4 (&ra)[2], const u32x4 (&rb)[3]) __attribute__((always_inline)) {
        unsigned char* a = smem + buf * STAGE2;
#pragma unroll
        for (int i = 0; i < 2; ++i) *(u32x4*)(a + soff + i * 64 * LROW2) = ra[i];
#pragma unroll
        for (int i = 0; i < 3; ++i) *(u32x4*)(a + A2_BYTES + soff + i * 64 * LROW2) = rb[i];
    };
    auto compute = [&](int buf) __attribute__((always_inline)) {
        const unsigned char* s = smem + buf * STAGE2;
        bf16x8 a[2][2], b[2][3];
#pragma unroll
        for (int kk = 0; kk < 2; ++kk) {
            a[kk][0] = *(const bf16x8*)(s + aoff + kk * 32); a[kk][1] = *(const bf16x8*)(s + aoff + 32 * LROW2 + kk * 32);
#pragma unroll
            for (int nt = 0; nt < 3; ++nt) b[kk][nt] = *(const bf16x8*)(s + boff + nt * 32 * LROW2 + kk * 32);
        }
        __builtin_amdgcn_sched_barrier(0);
        __builtin_amdgcn_s_setprio(1);
#pragma unroll
        for (int kk = 0; kk < 2; ++kk)
#pragma unroll
            for (int nt = 0; nt < 3; ++nt) {
                acc[0][nt] = __builtin_amdgcn_mfma_f32_32x32x16_bf16(a[kk][0], b[kk][nt], acc[0][nt], 0, 0, 0);
                acc[1][nt] = __builtin_amdgcn_mfma_f32_32x32x16_bf16(a[kk][1], b[kk][nt], acc[1][nt], 0, 0, 0);
            }
        __builtin_amdgcn_s_setprio(0);
    };
    const int nk = K >> 5;
    loadt(0, ra0, rb0);
    if (nk > 1) loadt(32, ra1, rb1);
    storet(0, ra0, rb0); __syncthreads();
    for (int kt = 0; kt < nk; kt += 2) {
        if (kt + 2 < nk) loadt((kt + 2) << 5, ra0, rb0);
        __builtin_amdgcn_sched_barrier(0);
        compute(0);
        if (kt + 1 < nk) storet(1, ra1, rb1);
        __syncthreads();
        if (kt + 1 < nk) {
            if (kt + 3 < nk) loadt((kt + 3) << 5, ra1, rb1);
            __builtin_amdgcn_sched_barrier(0);
            compute(1);
            if (kt + 2 < nk) storet(0, ra0, rb0);
            __syncthreads();
        }
    }
}

__device__ __forceinline__ void exch_epilogue(f32x16 (&v)[2][2], int row0, int col0, unsigned long long* gran, unsigned tag, const float* __restrict__ gain,
                                              float* xout, bf16_t* xb, float* part_next, float* ep) {
    const int tid = opq(threadIdx.x), lane = tid & 63, wave = __builtin_amdgcn_readfirstlane(tid >> 6), wm = wave >> 1, wn = wave & 1, fm = lane & 31, hi = lane >> 5;
    const int slot = (col0 >> 7) * 2 + wn;
    float xo[2][2][16];
#pragma unroll
    for (int mt = 0; mt < 2; ++mt)
#pragma unroll
        for (int nt = 0; nt < 2; ++nt) {
            const bf16_t* xp = xb + (size_t)(row0 + wm * 64 + mt * 32 + 4 * hi) * D + col0 + wn * 64 + nt * 32 + fm;
#pragma unroll
            for (int r = 0; r < 16; ++r) xo[mt][nt][r] = bf2f(xp[((r & 3) + 8 * (r >> 2)) * D]);
        }
#pragma unroll
    for (int mt = 0; mt < 2; ++mt) {
        float ss[16];
#pragma unroll
        for (int r = 0; r < 16; ++r) ss[r] = v[mt][0][r] * v[mt][0][r] + v[mt][1][r] * v[mt][1][r];
        const float tot = rowsum32(ss, lane);
        if ((lane & 1) == 0) __hip_atomic_store(gran + (size_t)(row0 + wm * 64 + mt * 32 + crow((lane >> 1) & 15, hi)) * 16 + slot, ((unsigned long long)tag << 32) | (unsigned long long)__float_as_uint(tot), __ATOMIC_RELAXED, __HIP_MEMORY_SCOPE_AGENT);
    }
    if (tid < 128) {
        const unsigned long long* g = gran + (size_t)(row0 + tid) * 16;
        float s;
        for (;;) {
            s = 0.f; bool ok = true;
#pragma unroll
            for (int i = 0; i < 16; ++i) { const unsigned long long x = __hip_atomic_load(g + i, __ATOMIC_RELAXED, __HIP_MEMORY_SCOPE_AGENT); ok &= ((unsigned)(x >> 32) == tag); s += __uint_as_float((unsigned)x); }
            if (ok) break;
            __builtin_amdgcn_s_sleep(1);
        }
        ep[128 + tid] = rsqrtf(s * (1.0f / 1024.0f) + EPS);
    }
    __syncthreads();
#pragma unroll
    for (int mt = 0; mt < 2; ++mt) {
        float ss[16], rs[16];
#pragma unroll
        for (int r = 0; r < 16; ++r) { ss[r] = 0.f; rs[r] = ep[128 + wm * 64 + mt * 32 + crow(r, hi)]; }
#pragma unroll
        for (int nt = 0; nt < 2; ++nt) {
            const int col = col0 + wn * 64 + nt * 32 + fm;
            const float g = gain[col];
            float* xp = xout + (size_t)(row0 + wm * 64 + mt * 32 + 4 * hi) * D + col;
            bf16_t* bp = xb + (size_t)(row0 + wm * 64 + mt * 32 + 4 * hi) * D + col;
#pragma unroll
            for (int g4 = 0; g4 < 4; ++g4) {
#pragma unroll
                for (int i = 0; i < 4; ++i) {
                    const int r = 4 * g4 + i, off = (8 * g4 + i) * D;
                    const float xf = xo[mt][nt][r] + v[mt][nt][r] * rs[r] * g;
                    const bf16_t xq = f2bf(xf);
                    const float xn = bf2f(xq);
                    bp[off] = xq; if (xout) xp[off] = xf; ss[r] += xn * xn;
                }
                asm volatile("" ::: "memory");
            }
        }
        const float tot = rowsum32(ss, lane);
        if ((lane & 1) == 0) part_next[(size_t)(row0 + wm * 64 + mt * 32 + crow((lane >> 1) & 15, hi)) * 16 + slot] = tot;
    }
}

__device__ __forceinline__ void exch_epilogue_w(f32x16 (&v)[2][4], int row0, int col0, unsigned long long* gran, unsigned tag, const float* __restrict__ gain,
                                                float* xout, bf16_t* xb, float* part_next, float* ep) {
    const int tid = opq(threadIdx.x), lane = tid & 63, wave = __builtin_amdgcn_readfirstlane(tid >> 6), wm = wave >> 1, wn = wave & 1, fm = lane & 31, hi = lane >> 5;
    const int slot = (col0 >> 8) * 2 + wn;
    float xs[2][16];
    auto ldx = [&](int u, float (&x)[16]) __attribute__((always_inline)) {
        const int lo = opq((4 * hi) * D + fm);
        const bf16_t* xp = xb + (size_t)(row0 + wm * 64 + (u >> 2) * 32) * D + col0 + wn * 128 + (u & 3) * 32 + lo;
#pragma unroll
        for (int r = 0; r < 16; ++r) x[r] = bf2f(xp[((r & 3) + 8 * (r >> 2)) * D]);
    };
    ldx(0, xs[0]);
#pragma unroll
    for (int mt = 0; mt < 2; ++mt) {
        float ss[16];
#pragma unroll
        for (int r = 0; r < 16; ++r) ss[r] = (v[mt][0][r] * v[mt][0][r] + v[mt][1][r] * v[mt][1][r]) + (v[mt][2][r] * v[mt][2][r] + v[mt][3][r] * v[mt][3][r]);
        const float tot = rowsum32(ss, lane);
        if ((lane & 1) == 0) __hip_atomic_store(gran + (size_t)(row0 + wm * 64 + mt * 32 + crow((lane >> 1) & 15, hi)) * 16 + slot, ((unsigned long long)tag << 32) | (unsigned long long)__float_as_uint(tot), __ATOMIC_RELAXED, __HIP_MEMORY_SCOPE_AGENT);
    }
    if (tid < 128) {
        const unsigned long long* g = gran + (size_t)(row0 + tid) * 16;
        float s;
        for (;;) {
            s = 0.f; bool ok = true;
#pragma unroll
            for (int i = 0; i < 8; ++i) { const unsigned long long x = __hip_atomic_load(g + i, __ATOMIC_RELAXED, __HIP_MEMORY_SCOPE_AGENT); ok &= ((unsigned)(x >> 32) == tag); s += __uint_as_float((unsigned)x); }
            if (ok) break;
            __builtin_amdgcn_s_sleep(1);
        }
        ep[128 + tid] = rsqrtf(s * (1.0f / 1024.0f) + EPS);
    }
    __syncthreads();
    float ss[16];
#pragma unroll
    for (int u = 0; u < 8; ++u) {
        const int mt = u >> 2, nt = u & 3;
        if (nt == 0) {
#pragma unroll
            for (int r = 0; r < 16; ++r) ss[r] = 0.f;
        }
        if (u + 1 < 8) ldx(u + 1, xs[(u + 1) & 1]);
        const int fmo = opq(fm), hio = opq(hi);
        const int col = col0 + wn * 128 + nt * 32 + fmo;
        const float g = gain[col];
        bf16_t* bp = xb + (size_t)(row0 + wm * 64 + mt * 32 + 4 * hio) * D + col;
#pragma unroll
        for (int g4 = 0; g4 < 4; ++g4) {
            const f32x4 rs4 = *(const f32x4*)(ep + 128 + wm * 64 + mt * 32 + 8 * g4 + 4 * hio);
#pragma unroll
            for (int i = 0; i < 4; ++i) {
                const int r = 4 * g4 + i, off = (8 * g4 + i) * D;
                const bf16_t xq = f2bf(xs[u & 1][r] + v[mt][nt][r] * rs4[i] * g);
                const float xn = bf2f(xq);
                bp[off] = xq; ss[r] += xn * xn;
            }
        }
        asm volatile("" ::: "memory");
        if (nt == 3) {
            const float tot = rowsum32(ss, lane);
            if ((lane & 1) == 0) part_next[(size_t)(row0 + wm * 64 + mt * 32 + crow((lane >> 1) & 15, hi)) * 16 + slot] = tot;
        }
    }
}

__device__ __forceinline__ void gbar(unsigned* ctr, unsigned& epoch, unsigned G) {
    asm volatile("s_waitcnt vmcnt(0)" ::: "memory");
    __syncthreads();
    epoch += 1u;
    if (threadIdx.x == 0) {
        __builtin_amdgcn_fence(__ATOMIC_RELEASE, "agent");
        asm volatile("s_waitcnt vmcnt(0)" ::: "memory");
        __hip_atomic_fetch_add(ctr, 1u, __ATOMIC_RELAXED, __HIP_MEMORY_SCOPE_AGENT);
        const unsigned target = epoch * G;
        while (__hip_atomic_load(ctr, __ATOMIC_RELAXED, __HIP_MEMORY_SCOPE_AGENT) < target) __builtin_amdgcn_s_sleep(1);
        __builtin_amdgcn_fence(__ATOMIC_ACQUIRE, "agent");
        asm volatile("s_waitcnt vmcnt(0)" ::: "memory");
    }
    __syncthreads();
}

#define LAS __attribute__((address_space(3)))
#define XB_TMO      128
#define XB_XCNT(j)  (256  + 64 * (j))
#define XB_XSUB(j)  (1280 + 64 * (j))
#define XB_XGEN(j)  (2304 + 64 * (j))
#define XB_TOP      3328
#define XB_TOPGEN   3392
#define XCD_BAR_WORDS 3456
#define XB_SPIN_CAP (1u << 22)
__device__ __forceinline__ unsigned xb_ld(unsigned* p)              { return __hip_atomic_load(p, __ATOMIC_RELAXED, __HIP_MEMORY_SCOPE_AGENT); }
__device__ __forceinline__ unsigned xb_add(unsigned* p, unsigned v) { return __hip_atomic_fetch_add(p, v, __ATOMIC_RELAXED, __HIP_MEMORY_SCOPE_AGENT); }
__device__ __forceinline__ unsigned xb_xcc_id() { return (unsigned)__builtin_amdgcn_s_getreg((3 << 11) | 20) & 0xFu; }
#define XB_SPIN(cond, bar) do { unsigned _sp = 0; while (cond) { __builtin_amdgcn_s_sleep(0); \
    if ((++_sp & 255u) == 0u) { if (xb_ld(&(bar)[XB_TMO])) break; if (_sp > XB_SPIN_CAP) { atomicAdd(&(bar)[XB_TMO], 1u); break; } } } } while (0)
struct XcdBarrier { unsigned* bar; unsigned x; volatile LAS unsigned* st; };
__device__ __forceinline__ XcdBarrier xcd_barrier_post(unsigned* bar, volatile LAS unsigned* st) {
    XcdBarrier b; b.bar = bar; b.x = xb_xcc_id(); b.st = st;
    if (threadIdx.x == 0) (void)xb_add(&bar[XB_XCNT(b.x)], 1u);
    return b;
}
__device__ __forceinline__ void xcd_barrier_complete(unsigned* bar, unsigned x, unsigned& nloc, unsigned& nx) {
    const unsigned G = gridDim.x * gridDim.y * gridDim.z;
    unsigned sum, cnt, mine, sp = 0u;
    for (;;) {
        sum = 0u; cnt = 0u; mine = 0u;
#pragma unroll
        for (unsigned j = 0; j < 16; ++j) { const unsigned c = xb_ld(&bar[XB_XCNT(j)]); sum += c; cnt += (c > 0u) ? 1u : 0u; mine = (j == x) ? c : mine; }
        if (sum == G) break;
        __builtin_amdgcn_s_sleep(1);
        if ((++sp & 255u) == 0u) { if (xb_ld(&bar[XB_TMO])) break; if (sp > XB_SPIN_CAP) { atomicAdd(&bar[XB_TMO], 1u); break; } }
    }
    nloc = mine > 0u ? mine : 1u; nx = cnt > 0u ? cnt : 1u;
}
__device__ __forceinline__ void xcd_barrier(const XcdBarrier& b) {
    asm volatile("s_waitcnt vmcnt(0)" ::: "memory");
    __syncthreads();
    if (threadIdx.x == 0) {
        unsigned* bar = b.bar;
        __builtin_amdgcn_s_waitcnt(0);
        unsigned nloc = b.st[0], nx = b.st[1];
        if (nloc == 0u) { xcd_barrier_complete(bar, b.x, nloc, nx); b.st[0] = nloc; b.st[1] = nx; }
        const unsigned old = xb_add(&bar[XB_XSUB(b.x)], 1u);
        const unsigned gen = old / nloc;
        if (old + 1u == (gen + 1u) * nloc) {
            __builtin_amdgcn_fence(__ATOMIC_RELEASE, "agent");
            asm volatile("s_waitcnt vmcnt(0)" ::: "memory");
            const unsigned og = xb_add(&bar[XB_TOP], 1u);
            const unsigned tg = og / nx;
            if (og + 1u == (tg + 1u) * nx) xb_add(&bar[XB_TOPGEN], 1u);
            else XB_SPIN(xb_ld(&bar[XB_TOPGEN]) == tg, bar);
            __builtin_amdgcn_fence(__ATOMIC_ACQUIRE, "agent");
            xb_add(&bar[XB_XGEN(b.x)], 1u);
            asm volatile("s_waitcnt vmcnt(0)" ::: "memory");
        } else {
            XB_SPIN(xb_ld(&bar[XB_XGEN(b.x)]) == gen, bar);
            __builtin_amdgcn_fence(__ATOMIC_ACQUIRE, "agent");
            asm volatile("s_waitcnt vmcnt(0)" ::: "memory");
        }
    }
    __syncthreads();
}

__global__ void __launch_bounds__(256, 2) mega(Params P) {
    extern __shared__ __attribute__((aligned(16))) unsigned char lds[];
    cg::grid_group grid = cg::this_grid();
    const int tid = threadIdx.x, lane = tid & 63, wave = __builtin_amdgcn_readfirstlane(tid >> 6), wm = wave >> 1, wn = wave & 1, fm = lane & 31, hi = lane >> 5;
    const int G = gridDim.x, vb = vblock();
    unsigned char* ws = P.ws;
    float* stat = (float*)(ws + WS_STAT);
    unsigned* cnts = (unsigned*)(ws + WS_CNT);
    float* cosT = (float*)(ws + WS_ROPE);
    float* sinT = cosT + S * 16;
    bf16_t* xb = (bf16_t*)(ws + WS_XB);
    bf16_t* mix = (bf16_t*)(ws + WS_MIX);
    bf16_t* ebuf = mix;
    bf16_t* zb = (bf16_t*)(ws + WS_Z);
    bf16_t* Qb = (bf16_t*)(ws + WS_Q);
    bf16_t* Kb = (bf16_t*)(ws + WS_K);
    bf16_t* Vt = (bf16_t*)(ws + WS_VT);
    bf16_t* ub = (bf16_t*)(ws + WS_U);
    float* xout = P.out;
    float* ep = (float*)(lds + EP_OFF);
    unsigned long long* gran = (unsigned long long*)(ws + WS_GRAN);
    unsigned* gctr = cnts + 4096;
    unsigned gepoch = 0u; (void)gepoch; (void)gctr;
    volatile LAS unsigned* xst = (volatile LAS unsigned*)((LAS unsigned char*)lds + XB_OFF);
    if (tid == 0) { xst[0] = 0u; xst[1] = 0u; }
    const XcdBarrier xbar = xcd_barrier_post(cnts + 8192, xst);

    auto dump_bf = [&](const bf16_t* buf, int pitch) {
        grid.sync();
        for (int i = vb * 256 + tid; i < T * D; i += G * 256) { const int row = i >> 10, col = i & 1023; xout[i] = bf2f(buf[(size_t)row * pitch + col]); }
    };
    if (PHASES & 1) for (int rep = 0; rep < REPP; ++rep) {
        float* tl = (float*)lds;
        for (int t = vb; t < NL * 3336; t += G) {
            const int l = t / 3336; int r = t % 3336;
            const float* src; const float* gA = nullptr; const float* gB = nullptr; int K, N, Np; size_t off;
            if (r < 576) { src = P.in[3] + (size_t)l * 1024 * 2208; gA = P.in[2] + l * 1024; gB = gA + 512; K = 1024; N = 2208; Np = 2304; off = OW_IN; }
            else if ((r -= 576) < 72) { src = P.in[5] + (size_t)l * 384 * 768; gA = P.in[4] + l * 384; gB = gA + 512; K = 384; N = 768; Np = 768; off = OW_QB; }
            else if ((r -= 72) < 64) { src = P.in[7] + (size_t)l * 256 * 1024; gA = P.in[6] + l * 256; gB = gA + 512; K = 256; N = 1024; Np = 1024; off = OW_KVB; }
            else if ((r -= 64) < 256) { src = P.in[11] + (size_t)l * 1024 * 1024; gA = P.in[9] + l * 512; gB = P.in[10] + l * 512; K = 1024; N = 1024; Np = 1024; off = OW_OUT; }
            else if ((r -= 256) < 1024) { src = P.in[14] + (size_t)l * 1024 * 4096; gA = P.in[13] + l * 1024; gB = gA + 512; K = 1024; N = 4096; Np = 4096; off = OW_UP; }
            else if ((r -= 1024) < 1024) { src = P.in[15] + (size_t)l * 4096 * 1024; K = 4096; N = 1024; Np = 1024; off = OW_DOWN; }
            else if ((r -= 1024) < 256) { src = P.in[18] + (size_t)l * 1024 * 1024; gA = P.in[17] + l * 1024; gB = gA + 512; K = 1024; N = 1024; Np = 1024; off = OW_G; }
            else { r -= 256; src = P.in[19] + (size_t)l * 256 * 1024; K = 256; N = 1024; Np = 1024; off = OW_P; }
            bf16_t* dst = (bf16_t*)(ws + WS_W + (size_t)l * WL_BYTES + off);
            const int nct = Np / 64, k0 = (r / nct) * 64, n0 = (r % nct) * 64;
#pragma unroll
            for (int j = 0; j < 4; ++j) {
                const int kr = (tid >> 4) + 16 * j, n4 = (tid & 15) * 4, k = k0 + kr;
                f32x4 v = (f32x4){0.f, 0.f, 0.f, 0.f};
                if (n0 + n4 < N) v = *(const f32x4*)(src + (size_t)k * N + n0 + n4);
                float g = 1.f;
                if (gA) g = (k < 512) ? gA[k] : gB[k - 512];
                tl[kr * 65 + n4 + 0] = v[0] * g; tl[kr * 65 + n4 + 1] = v[1] * g; tl[kr * 65 + n4 + 2] = v[2] * g; tl[kr * 65 + n4 + 3] = v[3] * g;
            }
            __syncthreads();
            {
                const int n = tid >> 2, kq = (tid & 3) * 16;
                unsigned w[8];
#pragma unroll
                for (int i = 0; i < 8; ++i) w[i] = pk2(tl[(kq + 2 * i) * 65 + n], tl[(kq + 2 * i + 1) * 65 + n]);
                bf16_t* dp = dst + (size_t)(n0 + n) * K + k0 + kq;
                *(u32x4*)dp = (u32x4){w[0], w[1], w[2], w[3]};
                *(u32x4*)(dp + 8) = (u32x4){w[4], w[5], w[6], w[7]};
            }
            __syncthreads();
        }
        const float* x = P.in[0];
        for (int row = vb * 4 + wave; row < T; row += G * 4) {
            float ss = 0.f;
#pragma unroll
            for (int j = 0; j < 4; ++j) {
                const size_t idx = (size_t)row * D + j * 256 + lane * 4;
                const f32x4 v = *(const f32x4*)(x + idx);
                *(u32x2*)(xb + idx) = (u32x2){pk2(v[0], v[1]), pk2(v[2], v[3])};
                ss += v[0] * v[0] + v[1] * v[1] + v[2] * v[2] + v[3] * v[3];
            }
            ss += __shfl_xor(ss, 32); ss += __shfl_xor(ss, 16); ss += __shfl_xor(ss, 8); ss += __shfl_xor(ss, 4); ss += __shfl_xor(ss, 2); ss += __shfl_xor(ss, 1);
            if (lane < 16) stat[((size_t)ST_X0 * T + row) * 16 + lane] = (lane == 0) ? ss : 0.f;
        }
        for (int idx = vb * 256 + tid; idx < NL * 3 * 128; idx += G * 256) cnts[idx] = 0u;
        if (blockIdx.x == 0 && tid == 0) *gctr = 0u;
        for (int idx = vb * 256 + tid; idx < 3 * T * 16 / 2; idx += G * 256) ((u32x4*)gran)[idx] = (u32x4){0u, 0u, 0u, 0u};
        for (int idx = vb * 256 + tid; idx < S * 16; idx += G * 256) {
            const int s = idx >> 4, j = idx & 15;
            const double base = sqrt(sqrt(sqrt(sqrt(10000.0))));
            double pw = 1.0;
            for (int q = 0; q < j; ++q) pw *= base;
            const float pwf = (float)pw;
            const float inv_freq = 1.0f / pwf;
            const float angf = (float)s * inv_freq;
            const double a = (double)angf;
            const double n = rint(a * 0.15915494309189535);
            const double rr = a - n * 6.283185307179586;
            const double r2 = rr * rr;
            double sn = 0.0, term = rr;
            for (int k = 0; k < 16; ++k) { sn += term; term *= -r2 / (double)((2 * k + 2) * (2 * k + 3)); }
            double cs = 0.0; term = 1.0;
            for (int k = 0; k < 16; ++k) { cs += term; term *= -r2 / (double)((2 * k + 1) * (2 * k + 2)); }
            cosT[idx] = (float)cs; sinT[idx] = (float)sn;
        }
    }
    xcd_barrier(xbar);
    if (P.ws == nullptr) grid.sync();

    for (int l = 0; l < NL; ++l) {
        const unsigned char* wl = ws + WS_W + (size_t)l * WL_BYTES;
        const bf16_t* WIN = (const bf16_t*)(wl + OW_IN);
        const bf16_t* WQB = (const bf16_t*)(wl + OW_QB);
        const bf16_t* WKVB = (const bf16_t*)(wl + OW_KVB);
        const bf16_t* WOUT = (const bf16_t*)(wl + OW_OUT);
        const bf16_t* WUP = (const bf16_t*)(wl + OW_UP);
        const bf16_t* WDOWN = (const bf16_t*)(wl + OW_DOWN);
        const bf16_t* WG = (const bf16_t*)(wl + OW_G);
        const bf16_t* WP = (const bf16_t*)(wl + OW_P);
        float* st = stat;

        if (PHASES & 2) for (int t = vb; t < 128 * 12; t += G) {
            const int tid = opq(threadIdx.x), lane = tid & 63, wave = __builtin_amdgcn_readfirstlane(tid >> 6), wm = wave >> 1, wn = wave & 1, fm = lane & 31, hi = lane >> 5;
            int panel = t / 12, ct = t % 12;
            if (G == 512) { const int M = (t >> 9) * 8 + (vb >> 6), q = vb & 63; panel = (M / 3) * 16 + (q >> 2); ct = (M % 3) * 4 + (q & 3); }
            const int row0 = panel * 128, col0 = ct * 192;
            if (tid < 128) ep[tid] = rsqrtf(sum_slots(st + ((size_t)ST_X0 * T + row0 + tid) * 16, 16) * (1.0f / 1024.0f) + EPS);
            f32x16 acc[2][3];
            gemm_mainloop_w3(xb + (size_t)row0 * D, D, WIN + (size_t)col0 * D, D, D, lds, acc);
            const int grp = 2 * ct + wn;
#pragma unroll
            for (int mt = 0; mt < 2; ++mt) {
                float ss[16], rs[16];
#pragma unroll
                for (int r = 0; r < 16; ++r) { ss[r] = 0.f; rs[r] = ep[wm * 64 + mt * 32 + crow(r, hi)]; }
#pragma unroll
                for (int nt = 0; nt < 3; ++nt) {
                    const int col = col0 + wn * 96 + nt * 32 + fm;
                    const bool cnt = (grp < 6) || (nt < 2);
#pragma unroll
                    for (int r = 0; r < 16; ++r) {
                        const float v = acc[mt][nt][r] * rs[r];
                        zb[(size_t)(row0 + wm * 64 + mt * 32 + crow(r, hi)) * ZW + col] = f2bf(v);
                        if (cnt) ss[r] += v * v;
                    }
                }
                if (grp < 7) {
                    const float tot = rowsum32(ss, lane);
                    float* pp = st + ((size_t)(grp < 4 ? ST_QA : ST_KVA) * T + row0 + wm * 64 + mt * 32 + crow((lane >> 1) & 15, hi)) * 16 + (grp < 4 ? grp : grp - 4);
                    if ((lane & 1) == 0) *pp = tot;
                }
            }
            __syncthreads();
        }
        xcd_barrier(xbar);

        if (STOP == 1) { dump_bf(zb, ZW); return; }
        if (PHASES & 4) for (int t = vb; t < 1024; t += G) {
            const int tid = opq(threadIdx.x), lane = tid & 63, wave = __builtin_amdgcn_readfirstlane(tid >> 6), wm = wave >> 1, wn = wave & 1, fm = lane & 31, hi = lane >> 5; (void)lane;
            if (t < 512) {
                const int panel = t >> 2, ct = t & 3, row0 = panel * 128, col0 = ct * 192;
                if (tid < 128) ep[tid] = rsqrtf(sum_slots(st + ((size_t)ST_QA * T + row0 + tid) * 16, 4) * (1.0f / 384.0f) + EPS);
                f32x16 acc[2][3];
                gemm_mainloop_w3(zb + (size_t)row0 * ZW, ZW, WQB + (size_t)col0 * 384, 384, 384, lds, acc);
                const int h = 2 * ct + wn;
#pragma unroll
                for (int mt = 0; mt < 2; ++mt) {
                    float rs[16];
#pragma unroll
                    for (int r = 0; r < 16; ++r) rs[r] = ep[wm * 64 + mt * 32 + crow(r, hi)] * QSCALE;
#pragma unroll
                    for (int nt = 0; nt < 3; ++nt) {
#pragma unroll
                        for (int r = 0; r < 16; ++r) {
                            const int row = row0 + wm * 64 + mt * 32 + crow(r, hi);
                            const int b = row >> 12, s = row & 4095;
                            float v = acc[mt][nt][r] * rs[r];
                            if (nt == 2) {
                                const float pr = __shfl_xor(v, 16);
                                const float c = cosT[s * 16 + (fm & 15)], sn = sinT[s * 16 + (fm & 15)];
                                v = (fm < 16) ? (v * c - pr * sn) : (v * c + pr * sn);
                            }
                            Qb[((size_t)(b * NH + h) * S + s) * 96 + nt * 32 + fm] = f2bf(v);
                        }
                    }
                }
            } else {
                const int t2 = t - 512;
                const int panel = t2 >> 2, ct = t2 & 3, row0 = panel * 128, col0 = ct * 256;
                if (tid < 128) ep[tid] = rsqrtf(sum_slots(st + ((size_t)ST_KVA * T + row0 + tid) * 16, 3) * (1.0f / 256.0f) + EPS);
                f32x16 acc[2][4];
                gemm_mainloop_w(zb + (size_t)row0 * ZW + 384, ZW, WKVB + (size_t)col0 * 256, 256, 256, lds, acc);
                const int h = 2 * ct + wn;
#pragma unroll
                for (int mt = 0; mt < 2; ++mt) {
                    float rs[16];
#pragma unroll
                    for (int r = 0; r < 16; ++r) rs[r] = ep[wm * 64 + mt * 32 + crow(r, hi)];
                    const int rbase = row0 + wm * 64 + mt * 32;
                    const int b = rbase >> 12;
#pragma unroll
                    for (int nt = 0; nt < 4; ++nt) {
                        if (nt < 2) {
                            const int d = nt * 32 + fm;
#pragma unroll
                            for (int r = 0; r < 16; ++r) {
                                const int s = (rbase + crow(r, hi)) & 4095;
                                Kb[((size_t)(b * NH + h) * S + s) * 96 + d] = f2bf(acc[mt][nt][r] * rs[r]);
                            }
                        } else {
                            const int d = (nt - 2) * 32 + fm;
#pragma unroll
                            for (int g = 0; g < 4; ++g) {
                                const int s = (rbase + 8 * g + 4 * hi) & 4095;
                                const u32x2 w = (u32x2){pk2(acc[mt][nt][4 * g] * rs[4 * g], acc[mt][nt][4 * g + 1] * rs[4 * g + 1]),
                                                         pk2(acc[mt][nt][4 * g + 2] * rs[4 * g + 2], acc[mt][nt][4 * g + 3] * rs[4 * g + 3])};
                                *(u32x2*)(Vt + ((size_t)(b * NH + h) * 64 + d) * S + s) = w;
                            }
                        }
                    }
                }
            }
            __syncthreads();
        }
        if (PHASES & 8) {
            const float* wc = P.in[8] + (size_t)l * 3 * 512;
            for (int row = vb * 4 + wave; row < T; row += G * 4) {
                const int tid = opq(threadIdx.x), lane = tid & 63, wave_ = 0, wm = 0, wn = 0, fm = lane & 31, hi = lane >> 5; (void)wm; (void)wn; (void)fm; (void)hi; (void)wave_; (void)lane;
                const int s = row & 4095, b = row >> 12;
                const bf16_t* zr = zb + (size_t)row * ZW;
                const int c0 = 8 * lane;
                const u32x4 gbv = *(const u32x4*)(zr + 672 + c0);
                const u32x4 gc1 = *(const u32x4*)(zr + 1184 + c0), ci1 = *(const u32x4*)(zr + 1696 + c0);
                u32x4 gc0 = (u32x4){0, 0, 0, 0}, ci0 = gc0, gc2 = gc0, ci2 = gc0;
                if (s > 0) { gc0 = *(const u32x4*)(zr - ZW + 1184 + c0); ci0 = *(const u32x4*)(zr - ZW + 1696 + c0); }
                if (s < S - 1) { gc2 = *(const u32x4*)(zr + ZW + 1184 + c0); ci2 = *(const u32x4*)(zr + ZW + 1696 + c0); }
                const f32x4 w0a = *(const f32x4*)(wc + c0), w0b = *(const f32x4*)(wc + c0 + 4);
                const f32x4 w1a = *(const f32x4*)(wc + 512 + c0), w1b = *(const f32x4*)(wc + 512 + c0 + 4);
                const f32x4 w2a = *(const f32x4*)(wc + 1024 + c0), w2b = *(const f32x4*)(wc + 1024 + c0 + 4);
                float cv[8]; float ss = 0.f;
#pragma unroll
                for (int i = 0; i < 4; ++i) {
                    const unsigned a0 = gc0[i], a1 = gc1[i], a2 = gc2[i], d0 = ci0[i], d1 = ci1[i], d2 = ci2[i], gw = gbv[i];
                    const float wlo0 = (i < 2) ? w0a[2 * i] : w0b[2 * i - 4], whi0 = (i < 2) ? w0a[2 * i + 1] : w0b[2 * i - 3];
                    const float wlo1 = (i < 2) ? w1a[2 * i] : w1b[2 * i - 4], whi1 = (i < 2) ? w1a[2 * i + 1] : w1b[2 * i - 3];
                    const float wlo2 = (i < 2) ? w2a[2 * i] : w2b[2 * i - 4], whi2 = (i < 2) ? w2a[2 * i + 1] : w2b[2 * i - 3];
                    const float lo = bflo(gw) * (wlo0 * bflo(a0) * bflo(d0) + wlo1 * bflo(a1) * bflo(d1) + wlo2 * bflo(a2) * bflo(d2));
                    const float hv = bfhi(gw) * (whi0 * bfhi(a0) * bfhi(d0) + whi1 * bfhi(a1) * bfhi(d1) + whi2 * bfhi(a2) * bfhi(d2));
                    cv[2 * i] = lo; cv[2 * i + 1] = hv; ss += lo * lo + hv * hv;
                }
                ss += __shfl_xor(ss, 1); ss += __shfl_xor(ss, 2); ss += __shfl_xor(ss, 4);
                const float rn = rsqrtf(ss * (1.0f / 64.0f) + EPS);
                *(u32x4*)(mix + (size_t)row * D + 512 + c0) = (u32x4){pk2(cv[0] * rn, cv[1] * rn), pk2(cv[2] * rn, cv[3] * rn), pk2(cv[4] * rn, cv[5] * rn), pk2(cv[6] * rn, cv[7] * rn)};
                if (lane < 16) {
                    const float a = bf2f(zr[640 + lane]), bb = bf2f(zr[656 + lane]);
                    const float c = cosT[s * 16 + lane], sn = sinT[s * 16 + lane];
                    const bf16_t o1 = f2bf(a * c - bb * sn), o2 = f2bf(bb * c + a * sn);
#pragma unroll
                    for (int h = 0; h < NH; ++h) {
                        bf16_t* kp = Kb + ((size_t)(b * NH + h) * S + s) * 96;
                        kp[64 + lane] = o1; kp[80 + lane] = o2;
                    }
                }
            }
        }
        xcd_barrier(xbar);

        if (STOP == 2) { dump_bf(Qb, 768); return; }
        if (STOP == 12) { dump_bf(Kb, 768); return; }
        if (STOP == 22) { dump_bf(Vt, 512); return; }
        if (STOP == 32) { dump_bf(mix, 1024); return; }
        if (PHASES & 16) for (int rep = 0; rep < REPA; ++rep) for (int it = vb; it < 32 * 16; it += G) {
            const int tid = opq(threadIdx.x), lane = tid & 63, wave = __builtin_amdgcn_readfirstlane(tid >> 6), fm = lane & 31, hi = lane >> 5;
            const int bh = it >> 4, qb = it & 15, b = bh >> 3, h = bh & 7;
            const bf16_t* Qp = Qb + ((size_t)bh * S + qb * 256 + wave * 64 + fm) * 96 + hi * 8;
            const bf16_t* Kp = Kb + (size_t)bh * S * 96;
            const bf16_t* Vp = Vt + (size_t)bh * 64 * S;
            bf16x8 qf[2][6];
#pragma unroll
            for (int u = 0; u < 2; ++u)
#pragma unroll
                for (int d0 = 0; d0 < 6; ++d0) qf[u][d0] = *(const bf16x8*)(Qp + (size_t)u * 32 * 96 + d0 * 16);
            f32x16 o[2][2];
#pragma unroll
            for (int u = 0; u < 2; ++u)
#pragma unroll
                for (int r = 0; r < 16; ++r) { o[u][0][r] = 0.f; o[u][1][r] = 0.f; }
            float mhat[2] = {0.f, 0.f}, lrun[2] = {0.f, 0.f};
            u32x4 kr[3], vr[2];
            const int pim = (fm & ~12) | ((fm & 4) << 1) | ((fm & 8) >> 1);
            const int koff = pim * KROW + hi * 16, voff = fm * VROW + hi * 16;
            auto loadkv = [&](int kv0) __attribute__((always_inline)) {
#pragma unroll
                for (int i = 0; i < 3; ++i) kr[i] = *(const u32x4*)(Kp + (size_t)kv0 * 96 + (tid + 256 * i) * 8);
#pragma unroll
                for (int i = 0; i < 2; ++i) { const int c = tid + 256 * i; vr[i] = *(const u32x4*)(Vp + (size_t)(c >> 3) * S + kv0 + (c & 7) * 8); }
            };
            auto storekv = [&](int buf) __attribute__((always_inline)) {
                unsigned char* kb = lds + buf * (KT_BYTES + VT_BYTES);
                unsigned char* vbp = kb + KT_BYTES;
#pragma unroll
                for (int i = 0; i < 3; ++i) { const int c = tid + 256 * i; *(u32x4*)(kb + (c / 12) * KROW + (c % 12) * 16) = kr[i]; }
#pragma unroll
                for (int i = 0; i < 2; ++i) { const int c = tid + 256 * i; *(u32x4*)(vbp + (c >> 3) * VROW + (c & 7) * 16) = vr[i]; }
            };
            loadkv(0); storekv(0); __syncthreads();
            for (int kt = 0; kt < 64; ++kt) {
                if (kt + 1 < 64) loadkv((kt + 1) * 64);
                __builtin_amdgcn_sched_barrier(0);
                const unsigned char* kb = lds + (kt & 1) * (KT_BYTES + VT_BYTES);
                const unsigned char* vbp = kb + KT_BYTES;
                f32x16 p[2][2];
#pragma unroll
                for (int d0 = 0; d0 < 6; ++d0) {
                    const bf16x8 k0 = *(const bf16x8*)(kb + koff + d0 * 32), k1 = *(const bf16x8*)(kb + koff + 32 * KROW + d0 * 32);
#pragma unroll
                    for (int u = 0; u < 2; ++u) {
                        if (d0 == 0) {
                            p[u][0] = __builtin_amdgcn_mfma_f32_32x32x16_bf16(k0, qf[u][0], (f32x16){0.f,0.f,0.f,0.f,0.f,0.f,0.f,0.f,0.f,0.f,0.f,0.f,0.f,0.f,0.f,0.f}, 0, 0, 0);
                            p[u][1] = __builtin_amdgcn_mfma_f32_32x32x16_bf16(k1, qf[u][0], (f32x16){0.f,0.f,0.f,0.f,0.f,0.f,0.f,0.f,0.f,0.f,0.f,0.f,0.f,0.f,0.f,0.f}, 0, 0, 0);
                        } else {
                            p[u][0] = __builtin_amdgcn_mfma_f32_32x32x16_bf16(k0, qf[u][d0], p[u][0], 0, 0, 0);
                            p[u][1] = __builtin_amdgcn_mfma_f32_32x32x16_bf16(k1, qf[u][d0], p[u][1], 0, 0, 0);
                        }
                    }
                }
#pragma unroll
                for (int u = 0; u < 2; ++u) {
                    float mx = p[u][0][0];
#pragma unroll
                    for (int r = 0; r < 16; ++r) mx = fmaxf(fmaxf(mx, p[u][0][r]), p[u][1][r]);
                    mx = fmaxf(mx, __shfl_xor(mx, 32));
                    if (kt == 0 || __any(mx - mhat[u] > 8.0f)) {
                        const float nm = (kt == 0) ? mx : fmaxf(mx, mhat[u]);
                        const float f = (kt == 0) ? 1.0f : __builtin_amdgcn_exp2f(mhat[u] - nm);
                        mhat[u] = nm; lrun[u] *= f;
#pragma unroll
                        for (int r = 0; r < 16; ++r) { o[u][0][r] *= f; o[u][1][r] *= f; }
                    }
                }
                auto soft = [&](int u, bf16x8 (&pfu)[4]) __attribute__((always_inline)) {
                    const float mh = mhat[u];
#pragma unroll
                    for (int r = 0; r < 16; ++r) { p[u][0][r] = __builtin_amdgcn_exp2f(p[u][0][r] - mh); p[u][1][r] = __builtin_amdgcn_exp2f(p[u][1][r] - mh); }
                    {
                        const f32x16 t = p[u][0] + p[u][1];
                        float rsum = ((t[0] + t[1]) + (t[2] + t[3])) + ((t[4] + t[5]) + (t[6] + t[7]));
                        rsum += ((t[8] + t[9]) + (t[10] + t[11])) + ((t[12] + t[13]) + (t[14] + t[15]));
                        lrun[u] += rsum;
                    }
#pragma unroll
                    for (int c = 0; c < 4; ++c) {
                        const int mt = c >> 1, r0 = (c & 1) * 8;
                        const u32x4 w = (u32x4){pk2(p[u][mt][r0], p[u][mt][r0 + 1]), pk2(p[u][mt][r0 + 2], p[u][mt][r0 + 3]), pk2(p[u][mt][r0 + 4], p[u][mt][r0 + 5]), pk2(p[u][mt][r0 + 6], p[u][mt][r0 + 7])};
                        pfu[c] = __builtin_bit_cast(bf16x8, w);
                    }
                };
                auto pvm = [&](int u, const bf16x8 (&pfu)[4]) __attribute__((always_inline)) {
#pragma unroll
                    for (int c = 0; c < 4; ++c) {
                        const bf16x8 v0 = *(const bf16x8*)(vbp + voff + c * 32), v1 = *(const bf16x8*)(vbp + voff + 32 * VROW + c * 32);
                        o[u][0] = __builtin_amdgcn_mfma_f32_32x32x16_bf16(v0, pfu[c], o[u][0], 0, 0, 0);
                        o[u][1] = __builtin_amdgcn_mfma_f32_32x32x16_bf16(v1, pfu[c], o[u][1], 0, 0, 0);
                    }
                };
                bf16x8 pfa[4], pfb[4];
                soft(0, pfa);
                pvm(0, pfa);
                soft(1, pfb);
#pragma unroll
                for (int i = 0; i < 8; ++i) { __builtin_amdgcn_sched_group_barrier(0x008, 1, 0); __builtin_amdgcn_sched_group_barrier(0x002, 10, 0); }
                pvm(1, pfb);
                if (kt + 1 < 64) storekv((kt + 1) & 1);
                __syncthreads();
            }
#pragma unroll
            for (int u = 0; u < 2; ++u) {
                const float ltot = lrun[u] + __shfl_xor(lrun[u], 32);
                const float inv = 1.0f / ltot;
                float ss = 0.f;
#pragma unroll
                for (int r = 0; r < 16; ++r) { o[u][0][r] *= inv; o[u][1][r] *= inv; ss += o[u][0][r] * o[u][0][r] + o[u][1][r] * o[u][1][r]; }
                ss += __shfl_xor(ss, 32);
                const float rn = rsqrtf(ss * (1.0f / 64.0f) + EPS);
                bf16_t* mp = mix + (size_t)(b * S + qb * 256 + wave * 64 + u * 32 + fm) * D + h * 64 + 4 * hi;
#pragma unroll
                for (int d0 = 0; d0 < 2; ++d0)
#pragma unroll
                    for (int g = 0; g < 4; ++g)
                        *(u32x2*)(mp + d0 * 32 + 8 * g) = (u32x2){pk2(o[u][d0][4 * g] * rn, o[u][d0][4 * g + 1] * rn), pk2(o[u][d0][4 * g + 2] * rn, o[u][d0][4 * g + 3] * rn)};
            }
        }
        xcd_barrier(xbar);

        if (STOP == 3) { dump_bf(mix, 1024); return; }
        if (PHASES & 32) for (int t = vb; t < 128 * 4; t += G) {
            const int panel = t >> 2, ct = t & 3, row0 = panel * 128, col0 = ct * 256;
            f32x16 acc[2][4];
            gemm_mainloop_w(mix + (size_t)row0 * D, D, WOUT + (size_t)col0 * D, D, D, lds, acc);
            exch_epilogue_w(acc, row0, col0, gran + (size_t)0 * T * 16, (unsigned)(l * 4 + 1), P.in[12] + l * D, xout, xb, st + (size_t)ST_X1 * T * 16, ep);
            __syncthreads();
        }
        xcd_barrier(xbar);

        if (STOP == 4) { return; }
        if (PHASES & 64) for (int t = vb; t < 2048; t += G) {
            const int tid = opq(threadIdx.x), lane = tid & 63, wave = __builtin_amdgcn_readfirstlane(tid >> 6), wm = wave >> 1, wn = wave & 1, fm = lane & 31, hi = lane >> 5; (void)lane;
            if (t < 2048) {
                int panel = t >> 4, ct = t & 15;
                if (G == 512) { const int M = (t >> 9) * 8 + (vb >> 6), q = vb & 63; panel = (M >> 1) * 8 + (q >> 3); ct = (M & 1) * 8 + (q & 7); }
                const int row0 = panel * 128, col0 = ct * 256;
                if (tid < 128) ep[tid] = rsqrtf(sum_slots(st + ((size_t)ST_X1 * T + row0 + tid) * 16, 8) * (1.0f / 1024.0f) + EPS);
                f32x16 acc[2][4];
                gemm_mainloop_w(xb + (size_t)row0 * D, D, WUP + (size_t)col0 * D, D, D, lds, acc);
#pragma unroll
                for (int mt = 0; mt < 2; ++mt) {
                    float rs[16];
#pragma unroll
                    for (int r = 0; r < 16; ++r) rs[r] = ep[wm * 64 + mt * 32 + crow(r, hi)];
#pragma unroll
                    for (int nt = 0; nt < 4; ++nt) {
                        const int col = col0 + wn * 128 + nt * 32 + fm;
#pragma unroll
                        for (int r = 0; r < 16; ++r) {
                            const float v = fmaxf(acc[mt][nt][r] * rs[r], 0.f);
                            ub[(size_t)(row0 + wm * 64 + mt * 32 + crow(r, hi)) * FF + col] = f2bf(v * v);
                        }
                    }
                }
            } else {
                const int t2 = t - 2048;
                const int panel = t2 >> 3, ct = t2 & 7, row0 = panel * 128, col0 = ct * 128;
                f32x16 acc[2][2];
                gemm_mainloop<true>(P.in[1] + ((size_t)l * T + row0) * 256, 256, WP + (size_t)col0 * 256, 256, 256, lds, acc);
#pragma unroll
                for (int mt = 0; mt < 2; ++mt)
#pragma unroll
                    for (int nt = 0; nt < 2; ++nt) {
                        const int col = col0 + wn * 64 + nt * 32 + fm;
#pragma unroll
                        for (int r = 0; r < 16; ++r) ebuf[(size_t)(row0 + wm * 64 + mt * 32 + crow(r, hi)) * D + col] = f2bf(acc[mt][nt][r]);
                    }
            }
            __syncthreads();
        }
        xcd_barrier(xbar);

        if (STOP == 5) { dump_bf(ub, 4096); return; }
        if (STOP == 15) { dump_bf(ebuf, 1024); return; }
        if (PHASES & 128) for (int t = vb; t < 128 * 4; t += G) {
            const int panel = t >> 2, ct = t & 3, row0 = panel * 128, col0 = ct * 256;
            f32x16 acc[2][4];
            gemm_mainloop_w(ub + (size_t)row0 * FF, FF, WDOWN + (size_t)col0 * FF, FF, FF, lds, acc);
            exch_epilogue_w(acc, row0, col0, gran + (size_t)1 * T * 16, (unsigned)(l * 4 + 2), P.in[16] + l * D, xout, xb, st + (size_t)ST_X2 * T * 16, ep);
            __syncthreads();
        }
        xcd_barrier(xbar);

        if (STOP == 6) { return; }
        if (PHASES & 256) for (int t = vb; t < 128 * 8; t += G) {
            const int tid = opq(threadIdx.x), lane = tid & 63, wave = __builtin_amdgcn_readfirstlane(tid >> 6), wm = wave >> 1, wn = wave & 1, fm = lane & 31, hi = lane >> 5; (void)lane; (void)fm; (void)wn;
            const int panel = t >> 3, ct = t & 7, row0 = panel * 128, col0 = ct * 128;
            if (tid < 128) ep[tid] = rsqrtf(sum_slots(st + ((size_t)ST_X2 * T + row0 + tid) * 16, 8) * (1.0f / 1024.0f) + EPS);
            f32x16 acce[2][2];
            gemm_mainloop<true>(P.in[1] + ((size_t)l * T + row0) * 256, 256, WP + (size_t)col0 * 256, 256, 256, lds, acce);
            f32x16 acc[2][2];
            gemm_mainloop<false>(xb + (size_t)row0 * D, D, WG + (size_t)col0 * D, D, D, lds, acc);
#pragma unroll
            for (int mt = 0; mt < 2; ++mt) {
                float rs[16];
#pragma unroll
                for (int r = 0; r < 16; ++r) rs[r] = ep[wm * 64 + mt * 32 + crow(r, hi)];
#pragma unroll
                for (int nt = 0; nt < 2; ++nt) {
#pragma unroll
                    for (int r = 0; r < 16; ++r) {
                        const float gte = __builtin_amdgcn_rcpf(1.0f + __builtin_amdgcn_exp2f(-1.4426950408889634f * (acc[mt][nt][r] * rs[r])));
                        acc[mt][nt][r] = gte * acce[mt][nt][r];
                    }
                }
            }
            exch_epilogue(acc, row0, col0, gran + (size_t)2 * T * 16, (unsigned)(l * 4 + 3), P.in[20] + l * D, (l == NL - 1) ? xout : nullptr, xb, st + (size_t)ST_X0 * T * 16, ep);
            __syncthreads();
        }
        if (STOP == 7) return;
        if (l + 1 < NL) xcd_barrier(xbar);
    }
}

extern "C" void kernel_launch(void* const* d_in, const int* in_sizes, int n_in, void* d_out, int out_size, void* d_ws, size_t ws_size, hipStream_t stream) {
    static int grid = 0;
    if (grid == 0) {
        if (n_in != 21 || out_size != T * D || ws_size < WS_END) { fprintf(stderr, "kernel_launch: unexpected problem (n_in %d out %d ws %zu)\n", n_in, out_size, ws_size); grid = -1; return; }
        int dev = 0, cus = 0, per_cu = 0;
        hipGetDevice(&dev);
        hipDeviceGetAttribute(&cus, hipDeviceAttributeMultiprocessorCount, dev);
        if (hipFuncSetAttribute((const void*)mega, hipFuncAttributeMaxDynamicSharedMemorySize, LDS_BYTES) != hipSuccess) { fprintf(stderr, "hipFuncSetAttribute failed\n"); grid = -1; return; }
        if (hipOccupancyMaxActiveBlocksPerMultiprocessor(&per_cu, (const void*)mega, 256, LDS_BYTES) != hipSuccess || per_cu < 1) { fprintf(stderr, "occupancy query failed (%d)\n", per_cu); per_cu = 1; }
        if (per_cu > 2) per_cu = 2;
        grid = (cus * per_cu) & ~7;
        fprintf(stderr, "kernel_launch: cus %d per_cu %d grid %d\n", cus, per_cu, grid);
    }
    if (grid < 0) return;
    if (hipMemsetAsync((char*)d_ws + WS_CNT + 8192 * 4, 0, XCD_BAR_WORDS * 4, stream) != hipSuccess) { fprintf(stderr, "kernel_launch: memset of the barrier words failed\n"); return; }
    Params p{};
    for (int i = 0; i < 21; ++i) p.in[i] = (const float*)d_in[i];
    p.out = (float*)d_out; p.ws = (unsigned char*)d_ws;
    void* args[] = {&p};
    hipError_t e = hipLaunchCooperativeKernel((const void*)mega, dim3(grid), dim3(256), args, LDS_BYTES, stream);
    if (e != hipSuccess) fprintf(stderr, "cooperative launch failed: %s (grid %d)\n", hipGetErrorString(e), grid);
}
```
